# Optimizing an MI355X kernel written in HIP

```python
import jax, jax.numpy as jnp
from jax import lax
import numpy as np

D_MODEL = 1024
BATCH = 2
SEQ = 8192
DEPTH = 4

N_EVEN = (DEPTH + 1) // 2
N_ODD = DEPTH // 2

ROPE_THETA = 10000.0
NORM_EPS = 1e-6

MLA_HEADS = 8
MLA_Q_LORA = 384
MLA_KV_LORA = 256
MLA_NOPE = 64
MLA_ROPE = 32
MLA_V = 64
ATTN_Q_BLOCK = 128

MOBA_HEADS = 8
MOBA_HEAD_DIM = 64
MOBA_BLOCK = 256
MOBA_TOPK = 3
MOBA_Q_CHUNK = 32

MOBA_QKV = 3 * MOBA_HEADS * MOBA_HEAD_DIM
SPLIT_POINTS = (MLA_Q_LORA, MLA_Q_LORA + MLA_KV_LORA, MLA_Q_LORA + MLA_KV_LORA + MLA_ROPE)
D_IN_PROJ = MLA_Q_LORA + MLA_KV_LORA + MLA_ROPE + MOBA_QKV
D_MIX = MLA_HEADS * MLA_V + MOBA_HEADS * MOBA_HEAD_DIM

CONV_WIDTH = 31

PEER_HEADS = 8
PEER_N_KEYS = 128
PEER_N_EXPERTS = PEER_N_KEYS * PEER_N_KEYS
PEER_D_KEY = 256
PEER_D_HALF = PEER_D_KEY // 2
PEER_TOPK = 16
PEER_TOKEN_CHUNK = 128

kernel_name = "hybrid_mla_moba_conformer_peer"


def rms_norm(x, g):
    xf = x.astype(jnp.float32)
    y = xf * lax.rsqrt(jnp.mean(xf * xf, axis=-1, keepdims=True) + NORM_EPS)
    return (y * g.astype(jnp.float32)).astype(x.dtype)


def layer_norm(x, g, b):
    xf = x.astype(jnp.float32)
    mu = jnp.mean(xf, axis=-1, keepdims=True)
    var = jnp.mean(jnp.square(xf - mu), axis=-1, keepdims=True)
    y = (xf - mu) * lax.rsqrt(var + NORM_EPS)
    return (y * g.astype(jnp.float32) + b.astype(jnp.float32)).astype(x.dtype)


def rope_angles(positions, dim):
    inv = 1.0 / (ROPE_THETA ** (jnp.arange(0, dim, 2, dtype=jnp.float32) / dim))
    ang = positions.astype(jnp.float32)[..., None] * inv
    return jnp.cos(ang), jnp.sin(ang)


def apply_rope(x, cos, sin):
    d2 = x.shape[-1] // 2
    x1, x2 = x[..., :d2], x[..., d2:]
    c = cos[:, :, None, :].astype(x.dtype)
    s = sin[:, :, None, :].astype(x.dtype)
    return jnp.concatenate([x1 * c - x2 * s, x2 * c + x1 * s], axis=-1)


def causal_attention_swept(q, k, v, scale):
    B, S, H, dk = q.shape
    nq = S // ATTN_Q_BLOCK
    qb = q.reshape(B, nq, ATTN_Q_BLOCK, H, dk).transpose(1, 0, 2, 3, 4)
    kpos = jnp.arange(S)

    def one_block(args):
        i, qi = args
        s = jnp.einsum('bqhd,bkhd->bhqk', qi, k, preferred_element_type=jnp.float32) * scale
        qpos = i * ATTN_Q_BLOCK + jnp.arange(ATTN_Q_BLOCK)
        s = jnp.where(kpos[None, :] <= qpos[:, None], s, -jnp.inf)
        p = jax.nn.softmax(s, axis=-1).astype(v.dtype)
        return jnp.einsum('bhqk,bkhd->bqhd', p, v)

    o = lax.map(one_block, (jnp.arange(nq), qb))
    return o.transpose(1, 0, 2, 3, 4).reshape(B, S, H, v.shape[-1])


def moba_attention(q, k, v):
    B, S, H, d = q.shape
    nb = -(-S // MOBA_BLOCK)
    pad = nb * MOBA_BLOCK - S
    kp = jnp.pad(k, ((0, 0), (0, pad), (0, 0), (0, 0)))
    vp = jnp.pad(v, ((0, 0), (0, pad), (0, 0), (0, 0)))
    k_blocks = kp.reshape(B, nb, MOBA_BLOCK, H, d).transpose(0, 3, 1, 2, 4)
    v_blocks = vp.reshape(B, nb, MOBA_BLOCK, H, d).transpose(0, 3, 1, 2, 4)
    counts = jnp.minimum(MOBA_BLOCK, S - jnp.arange(nb) * MOBA_BLOCK).astype(jnp.float32)
    k_mean = (k_blocks.astype(jnp.float32).sum(axis=3) / counts[None, None, :, None]).astype(k.dtype)
    topk = min(MOBA_TOPK, nb)
    scale = d ** -0.5
    nc = S // MOBA_Q_CHUNK
    qc = q.reshape(B, nc, MOBA_Q_CHUNK, H, d).transpose(1, 0, 2, 3, 4)
    bidx = jnp.arange(B)[:, None, None, None]
    hidx = jnp.arange(H)[None, :, None, None]
    blk_ids = jnp.arange(nb)

    def one_chunk(args):
        c, qi = args
        qpos = c * MOBA_Q_CHUNK + jnp.arange(MOBA_Q_CHUNK)
        own = (c * MOBA_Q_CHUNK) // MOBA_BLOCK
        gate = jnp.einsum('bqhd,bhnd->bhqn', qi, k_mean, preferred_element_type=jnp.float32)
        gate = jnp.where(blk_ids < own, gate, -jnp.inf)
        _, sel = lax.top_k(gate, topk)
        slot_ok = jnp.arange(topk) < own
        kg = k_blocks[bidx, hidx, sel]
        vg = v_blocks[bidx, hidx, sel]
        s_sel = jnp.einsum('bqhd,bhqjkd->bhqjk', qi, kg, preferred_element_type=jnp.float32) * scale
        s_sel = jnp.where(slot_ok[None, None, None, :, None], s_sel, -jnp.inf)
        ko = lax.dynamic_slice_in_dim(k_blocks, own, 1, axis=2)[:, :, 0]
        vo = lax.dynamic_slice_in_dim(v_blocks, own, 1, axis=2)[:, :, 0]
        s_own = jnp.einsum('bqhd,bhkd->bhqk', qi, ko, preferred_element_type=jnp.float32) * scale
        kpos_own = own * MOBA_BLOCK + jnp.arange(MOBA_BLOCK)
        s_own = jnp.where(kpos_own[None, :] <= qpos[:, None], s_own, -jnp.inf)
        s_all = jnp.concatenate([s_sel.reshape(B, H, MOBA_Q_CHUNK, topk * MOBA_BLOCK), s_own], axis=-1)
        p = jax.nn.softmax(s_all, axis=-1).astype(v.dtype)
        p_sel = p[..., :topk * MOBA_BLOCK].reshape(B, H, MOBA_Q_CHUNK, topk, MOBA_BLOCK)
        p_own = p[..., topk * MOBA_BLOCK:]
        return (jnp.einsum('bhqjk,bhqjkd->bqhd', p_sel, vg)
                + jnp.einsum('bhqk,bhkd->bqhd', p_own, vo))

    o = lax.map(one_chunk, (jnp.arange(nc), qc))
    return o.transpose(1, 0, 2, 3, 4).reshape(B, S, H, d)


def hybrid_attention(hn, w_in, q_norm, w_uq, kv_norm, w_ukv, w_out, cos_r, sin_r, cos_m, sin_m):
    B, S, _ = hn.shape
    proj = hn @ w_in
    c_q, c_kv, k_rope, moba_qkv = jnp.split(proj, SPLIT_POINTS, axis=-1)
    q = (rms_norm(c_q, q_norm) @ w_uq).reshape(B, S, MLA_HEADS, MLA_NOPE + MLA_ROPE)
    q_nope, q_pe = q[..., :MLA_NOPE], q[..., MLA_NOPE:]
    q_pe = apply_rope(q_pe, cos_r, sin_r)
    kv = (rms_norm(c_kv, kv_norm) @ w_ukv).reshape(B, S, MLA_HEADS, MLA_NOPE + MLA_V)
    k_nope, v_mla = kv[..., :MLA_NOPE], kv[..., MLA_NOPE:]
    k_pe = apply_rope(k_rope[:, :, None, :], cos_r, sin_r)
    q_full = jnp.concatenate([q_nope, q_pe], axis=-1)
    k_full = jnp.concatenate([k_nope, jnp.broadcast_to(k_pe, (B, S, MLA_HEADS, MLA_ROPE))], axis=-1)
    o_mla = causal_attention_swept(q_full, k_full, v_mla, (MLA_NOPE + MLA_ROPE) ** -0.5)
    mq, mk, mv = jnp.split(moba_qkv, 3, axis=-1)
    mq = apply_rope(mq.reshape(B, S, MOBA_HEADS, MOBA_HEAD_DIM), cos_m, sin_m)
    mk = apply_rope(mk.reshape(B, S, MOBA_HEADS, MOBA_HEAD_DIM), cos_m, sin_m)
    mv = mv.reshape(B, S, MOBA_HEADS, MOBA_HEAD_DIM)
    o_moba = moba_attention(mq, mk, mv)
    o = jnp.concatenate([o_mla.reshape(B, S, MLA_HEADS * MLA_V),
                         o_moba.reshape(B, S, MOBA_HEADS * MOBA_HEAD_DIM)], axis=-1)
    return o @ w_out


def conformer_conv(hn, w_in, b_in, w_dw, b_dw, ln_g, ln_b, w_out, b_out):
    a = hn @ w_in + b_in
    u, gate = jnp.split(a, 2, axis=-1)
    u = u * jax.nn.sigmoid(gate)
    u = lax.conv_general_dilated(u, w_dw[:, None, :], window_strides=(1,),
                                 padding=((CONV_WIDTH - 1, 0),),
                                 dimension_numbers=('NWC', 'WIO', 'NWC'),
                                 feature_group_count=D_MODEL) + b_dw
    u = jax.nn.silu(layer_norm(u, ln_g, ln_b))
    return u @ w_out + b_out


def peer_ffn(hn, w_q, subkeys, u_tab, v_tab):
    B, S, D = hn.shape
    T = B * S
    xt = hn.reshape(T // PEER_TOKEN_CHUNK, PEER_TOKEN_CHUNK, D)

    def one_chunk(xc):
        q = (xc @ w_q).reshape(PEER_TOKEN_CHUNK, PEER_HEADS, 2, PEER_D_HALF)
        s = jnp.einsum('thcd,hcnd->thcn', q, subkeys, preferred_element_type=jnp.float32)
        s_top, i_top = lax.top_k(s, PEER_TOPK)
        cand = s_top[:, :, 0, :, None] + s_top[:, :, 1, None, :]
        cand_idx = i_top[:, :, 0, :, None] * PEER_N_KEYS + i_top[:, :, 1, None, :]
        best, pos = lax.top_k(cand.reshape(PEER_TOKEN_CHUNK, PEER_HEADS, PEER_TOPK * PEER_TOPK), PEER_TOPK)
        idx = jnp.take_along_axis(cand_idx.reshape(PEER_TOKEN_CHUNK, PEER_HEADS, PEER_TOPK * PEER_TOPK), pos, axis=-1)
        g = jax.nn.softmax(best, axis=-1)
        u = u_tab[idx]
        act = jax.nn.gelu(jnp.einsum('td,thkd->thk', xc, u), approximate=False)
        v = v_tab[idx]
        return jnp.einsum('thk,thkd->td', (g * act).astype(v_tab.dtype), v)

    return lax.map(one_chunk, xt).reshape(B, S, D)


def setup_inputs(seed: int = 0) -> dict:
    key = jax.random.key(seed)
    ks = jax.random.split(key, 24)
    f32 = jnp.float32

    def nrm(k, shape, scale):
        return jax.random.normal(k, shape, f32) * scale

    def gain(k, shape):
        return 1.0 + 0.02 * jax.random.normal(k, shape, f32)

    x = jax.random.normal(ks[0], (BATCH, SEQ, D_MODEL), f32)
    offset = jax.random.randint(ks[1], (BATCH, 1), 0, 4096, dtype=jnp.int32)
    positions = offset + jnp.arange(SEQ, dtype=jnp.int32)[None, :]
    return {
        "x": x,
        "positions": positions,
        "norm_mix": gain(ks[2], (DEPTH, D_MODEL)),
        "norm_ffn": gain(ks[3], (DEPTH, D_MODEL)),
        "norm_final": gain(ks[4], (D_MODEL,)),
        "attn_w_in": nrm(ks[5], (N_EVEN, D_MODEL, D_IN_PROJ), D_MODEL ** -0.5),
        "mla_q_norm": gain(ks[6], (N_EVEN, MLA_Q_LORA)),
        "mla_w_uq": nrm(ks[7], (N_EVEN, MLA_Q_LORA, MLA_HEADS * (MLA_NOPE + MLA_ROPE)), MLA_Q_LORA ** -0.5),
        "mla_kv_norm": gain(ks[8], (N_EVEN, MLA_KV_LORA)),
        "mla_w_ukv": nrm(ks[9], (N_EVEN, MLA_KV_LORA, MLA_HEADS * (MLA_NOPE + MLA_V)), MLA_KV_LORA ** -0.5),
        "attn_w_out": nrm(ks[10], (N_EVEN, D_MIX, D_MODEL), 0.5 * D_MIX ** -0.5),
        "conv_w_in": nrm(ks[11], (N_ODD, D_MODEL, 2 * D_MODEL), D_MODEL ** -0.5),
        "conv_b_in": nrm(ks[12], (N_ODD, 2 * D_MODEL), 0.01),
        "conv_w_dw": nrm(ks[13], (N_ODD, CONV_WIDTH, D_MODEL), CONV_WIDTH ** -0.5),
        "conv_b_dw": nrm(ks[14], (N_ODD, D_MODEL), 0.01),
        "conv_ln_g": gain(ks[15], (N_ODD, D_MODEL)),
        "conv_ln_b": nrm(ks[16], (N_ODD, D_MODEL), 0.01),
        "conv_w_out": nrm(ks[17], (N_ODD, D_MODEL, D_MODEL), 0.5 * D_MODEL ** -0.5),
        "conv_b_out": nrm(ks[18], (N_ODD, D_MODEL), 0.01),
        "peer_w_q": nrm(ks[19], (DEPTH, D_MODEL, PEER_HEADS * PEER_D_KEY), D_MODEL ** -0.5),
        "peer_subkeys": nrm(ks[20], (DEPTH, PEER_HEADS, 2, PEER_N_KEYS, PEER_D_HALF), PEER_D_HALF ** -0.5),
        "peer_u": nrm(ks[21], (DEPTH, PEER_N_EXPERTS, D_MODEL), D_MODEL ** -0.5),
        "peer_v": nrm(ks[22], (DEPTH, PEER_N_EXPERTS, D_MODEL), 0.5 * PEER_HEADS ** -0.5),
    }


def reference(x, positions, norm_mix, norm_ffn, norm_final, attn_w_in, mla_q_norm, mla_w_uq,
              mla_kv_norm, mla_w_ukv, attn_w_out, conv_w_in, conv_b_in, conv_w_dw, conv_b_dw,
              conv_ln_g, conv_ln_b, conv_w_out, conv_b_out, peer_w_q, peer_subkeys, peer_u, peer_v):
    cos_r, sin_r = rope_angles(positions, MLA_ROPE)
    cos_m, sin_m = rope_angles(positions, MOBA_HEAD_DIM)
    h = x
    for layer in range(DEPTH):
        hn = rms_norm(h, norm_mix[layer])
        i = layer // 2
        if layer % 2 == 0:
            mix = hybrid_attention(hn, attn_w_in[i], mla_q_norm[i], mla_w_uq[i], mla_kv_norm[i],
                                   mla_w_ukv[i], attn_w_out[i], cos_r, sin_r, cos_m, sin_m)
        else:
            mix = conformer_conv(hn, conv_w_in[i], conv_b_in[i], conv_w_dw[i], conv_b_dw[i],
                                 conv_ln_g[i], conv_ln_b[i], conv_w_out[i], conv_b_out[i])
        h = h + mix
        h = h + peer_ffn(rms_norm(h, norm_ffn[layer]), peer_w_q[layer], peer_subkeys[layer],
                         peer_u[layer], peer_v[layer])
    return rms_norm(h, norm_final)
```

```cpp
#include <hip/hip_runtime.h>
#include <cstdio>
#include <cstdint>
#include <cstring>
#include <cmath>

#ifndef PHMASK
#define PHMASK 0xFFFF
#endif
#define PH_ON(n) ((PHMASK >> (n)) & 1)
#ifndef DBG_SKIP_ATTN
#define DBG_SKIP_ATTN 0
#endif
#ifndef DBG_SKIP_CONV
#define DBG_SKIP_CONV 0
#endif
#ifndef DBG_SKIP_PEER
#define DBG_SKIP_PEER 0
#endif
#ifndef MK_ONE_LAUNCH
#define MK_ONE_LAUNCH 0
#endif

#define LAS __attribute__((address_space(3)))
#define GAS __attribute__((address_space(1)))
typedef unsigned short bf16_t;
typedef short bf16x8 __attribute__((ext_vector_type(8)));
typedef short s16x4 __attribute__((ext_vector_type(4)));
typedef short v4i16_t __attribute__((ext_vector_type(4)));
typedef float f32x2 __attribute__((ext_vector_type(2)));
typedef float f32x4 __attribute__((ext_vector_type(4)));
typedef float f32x16 __attribute__((ext_vector_type(16)));
typedef unsigned u32x2 __attribute__((ext_vector_type(2)));
typedef unsigned u32x4 __attribute__((ext_vector_type(4)));
#define DI __device__ __forceinline__

constexpr int TT = 16384, SEQ = 8192, DM = 1024;
constexpr int NPROJ = 2208, NPROJP = 2304;
constexpr float NORM_EPS = 1e-6f;
constexpr float LOG2E = 1.4426950408889634f;
constexpr int NWAVES = 8, NTHR = 512;

constexpr size_t MiB = 1u << 20;
constexpr size_t WS_CTL = 0, CTL_ZERO_BYTES = 1 * MiB;
constexpr size_t WS_COSR = 2 * MiB, WS_SINR = 3 * MiB, WS_COSM = 4 * MiB, WS_SINM = 6 * MiB;
constexpr size_t WS_KPART = 8 * MiB;
constexpr size_t WS_WIN = 10 * MiB;
constexpr size_t WS_WUQ = 19 * MiB;
constexpr size_t WS_WUKV = 21 * MiB;
constexpr size_t WS_WOUT = 22 * MiB;
constexpr size_t WS_WCIN = 26 * MiB;
constexpr size_t WS_WCOUT = 34 * MiB;
constexpr size_t WS_WPQ = 38 * MiB;
constexpr size_t WS_SUBK = 54 * MiB;
constexpr size_t WS_U16 = 64 * MiB;
constexpr size_t WS_V16 = 192 * MiB;
constexpr size_t WS_H0 = 320 * MiB;
constexpr size_t WS_H1 = 384 * MiB;
constexpr size_t WS_HN = 448 * MiB;
constexpr size_t WS_PROJ = 480 * MiB;
constexpr size_t WS_CQN = 552 * MiB;
constexpr size_t WS_CKVN = 564 * MiB;
constexpr size_t WS_QM = 572 * MiB;
constexpr size_t WS_KM = 596 * MiB;
constexpr size_t WS_VM = 620 * MiB;
constexpr size_t WS_MQ = 636 * MiB;
constexpr size_t WS_MK = 652 * MiB;
constexpr size_t WS_OB = 668 * MiB;
constexpr size_t WS_Q2 = 700 * MiB;
constexpr size_t WS_IDX = 764 * MiB;
constexpr size_t WS_GATE = 772 * MiB;
constexpr size_t WS_UG = 780 * MiB;
constexpr size_t WS_YB = 812 * MiB;
constexpr size_t WS_END = 844 * MiB;
constexpr int CW_BAR = 4096;

constexpr int RING_BYTES = 131072;
constexpr int MISC_OFF = RING_BYTES + 320;
constexpr int LDS_BYTES = 147456;

DI unsigned cvt_pk_bf16(float lo, float hi) { unsigned r; asm volatile("v_cvt_pk_bf16_f32 %0, %1, %2" : "=v"(r) : "v"(lo), "v"(hi)); return r; }
DI float bf_lo(unsigned u) { return __builtin_bit_cast(float, u << 16); }
DI float bf_hi(unsigned u) { return __builtin_bit_cast(float, u & 0xffff0000u); }
DI float bf1(bf16_t b) { return __builtin_bit_cast(float, ((unsigned)b) << 16); }
DI float wave_sum(float v) {
#pragma unroll
    for (int o = 1; o < 64; o <<= 1) v += __shfl_xor(v, o);
    return v;
}
#define LDS_WAIT() asm volatile("s_waitcnt lgkmcnt(0)" ::: "memory")

namespace pg8 {
constexpr int BM = 256, BK = 64, HALF = 128, HTB = HALF * BK * 2, STAGE_BYTES = 8 * HTB, NXCD = 8, WGM = 8;
__host__ __device__ __forceinline__ int lds_byte(int r, int c) { const int st = (r >> 4) * 2 + (c >> 5), rr = r & 15, cc = c & 31, ob = rr * 64 + cc * 2; return st * 1024 + (ob ^ (((ob >> 9) & 1) << 5)); }
__host__ __device__ __forceinline__ void stage_rc(int b, int& R, int& C) { const int st = b / 1024, sb = b % 1024, swz = sb ^ (((sb >> 9) & 1) << 5); R = (st >> 1) * 16 + swz / 64; C = (st & 1) * 32 + (swz % 64) / 2; }
__host__ __device__ __forceinline__ int perm32(int rho) { const int n = rho >> 4, i = rho & 15; return 8 * (i >> 2) + 4 * n + (i & 3); }
struct Unit { int pm, pn; };
struct Gemm { const bf16_t* A; const bf16_t* Bt; int M, N, K; };
struct StaticOrder {
    int nM, nN, nwg, G, c;
    __host__ __device__ void init(int M, int N, int G_, int c_) { nM = M / BM; nN = N / BM; nwg = nM * nN; G = G_; c = c_; }
    __host__ __device__ bool next(int i, Unit& u) const {
        const long L = (long)i * G + c; if (L >= nwg) return false;
        int wgid = (int)L; { const int q = nwg / NXCD, r = nwg % NXCD, xcd = wgid % NXCD, off = wgid / NXCD; wgid = (xcd < r ? xcd * (q + 1) : r * (q + 1) + (xcd - r) * q) + off; }
        const int nig = WGM * nN, gid = wgid / nig, fm = gid * WGM, gsz = (nM - fm) < WGM ? (nM - fm) : WGM;
        u.pm = fm + ((wgid % nig) % gsz); u.pn = (wgid % nig) / gsz; return true;
    }
    __device__ __forceinline__ void a_ready(const Unit&) const {}
    __device__ __forceinline__ void done(const Unit&) const {}
};
template <class Epi, class Sched, bool ALIGN_EPI = false, bool SP2 = false>
__device__ __forceinline__ void gemm_phase(LAS unsigned char* lds, const Gemm g, const Sched& S, const Epi& E) {
    int tid_o = threadIdx.x; asm volatile("" : "+v"(tid_o));
    const int tid = tid_o, wid = __builtin_amdgcn_readfirstlane(tid >> 6), lane = tid & 63, wr = wid >> 2, wc = wid & 3, fr = lane & 15, fq = lane >> 4;
    const int K = g.K, nt = K / BK;
    unsigned voffA[2], voffB[2];
#pragma unroll
    for (int i = 0; i < 2; ++i) { int R, C; stage_rc(tid * 16 + i * 8192, R, C); const int Rb = Epi::PERM ? ((R & ~31) + perm32(R & 31)) : R;
        voffA[i] = (unsigned)(R * K + C) * 2u; voffB[i] = (unsigned)(Rb * K + C) * 2u; }
    const size_t kstep = (size_t)(BK * 2);
    const size_t hstep = (size_t)HALF * K * 2;
    const size_t tstep = 2 * hstep;
    const unsigned ldsw = (unsigned)wid * 1024u;
    const int aoff = lds_byte(wr * 64 + fr, fq * 8), boff = lds_byte(wc * 32 + fr, fq * 8);
#define PG8_SA(b, h) (((b) * 2 + (h)) * HTB)
#define PG8_SB(b, h) ((4 + (b) * 2 + (h)) * HTB)
#define PG8_STAGE(bufoff, gbase, voff) do { _Pragma("unroll") for (int _i = 0; _i < 2; ++_i) \
        __builtin_amdgcn_global_load_lds((const unsigned*)((const char*)(gbase) + (voff)[_i]), (LAS unsigned*)(lds + (bufoff) + ldsw + _i * 8192), 16, 0, 0); } while (0)
#define PG8_LDA(dst, b, h) do { _Pragma("unroll") for (int m = 0; m < 4; ++m) _Pragma("unroll") for (int k = 0; k < 2; ++k) dst[m][k] = *(const LAS bf16x8*)(lds + PG8_SA(b, h) + aoff + m * 2048 + k * 1024); } while (0)
#define PG8_LDB(dst, b, h) do { _Pragma("unroll") for (int n = 0; n < 2; ++n) _Pragma("unroll") for (int k = 0; k < 2; ++k) dst[n][k] = *(const LAS bf16x8*)(lds + PG8_SB(b, h) + boff + n * 2048 + k * 1024); } while (0)
#define PG8_MMA(ai, bj, At, Bt) do { __builtin_amdgcn_s_setprio(1); _Pragma("unroll") for (int m = 0; m < 4; ++m) _Pragma("unroll") for (int n = 0; n < 2; ++n) _Pragma("unroll") for (int k = 0; k < 2; ++k) \
        acc[ai][bj][m][n] = __builtin_amdgcn_mfma_f32_16x16x32_bf16(Bt[n][k], At[m][k], acc[ai][bj][m][n], 0, 0, 0); __builtin_amdgcn_s_setprio(0); } while (0)
#define PG8_WAIT_V(n) asm volatile("s_waitcnt vmcnt(" #n ")" ::: "memory")
#define PG8_WAIT_L(n) asm volatile("s_waitcnt lgkmcnt(" #n ")" ::: "memory")
#define PG8_BAR __builtin_amdgcn_s_barrier()
#define PG8_SCHED __builtin_amdgcn_sched_barrier(0)
    Unit cur, nxt; int ui = 0;
    if (!S.next(0, cur)) return;
    f32x4 acc[2][2][4][2];
#pragma unroll
    for (int a = 0; a < 2; ++a)
#pragma unroll
        for (int b = 0; b < 2; ++b)
#pragma unroll
            for (int m = 0; m < 4; ++m)
#pragma unroll
                for (int n = 0; n < 2; ++n) acc[a][b][m][n] = (f32x4){0.f, 0.f, 0.f, 0.f};
    bf16x8 At[4][2], B0[2][2], B1[2][2];
    const char* cA = (const char*)g.A + (size_t)cur.pm * tstep; const char* cB = (const char*)g.Bt + (size_t)cur.pn * tstep;
    S.a_ready(cur);
    if constexpr (SP2) {
        PG8_STAGE(PG8_SB(0, 0), cB, voffB); PG8_STAGE(PG8_SB(0, 1), cB + hstep, voffB); PG8_STAGE(PG8_SA(0, 0), cA, voffA); PG8_STAGE(PG8_SA(0, 1), cA + hstep, voffA);
        if (wr == 1) PG8_BAR;
        PG8_WAIT_V(2); PG8_BAR;
        PG8_STAGE(PG8_SB(1, 0), cB + kstep, voffB); PG8_STAGE(PG8_SA(1, 0), cA + kstep, voffA); PG8_STAGE(PG8_SB(1, 1), cB + hstep + kstep, voffB);
        PG8_WAIT_V(6); PG8_BAR;
    } else {
        PG8_STAGE(PG8_SB(0, 0), cB, voffB); PG8_STAGE(PG8_SA(0, 0), cA, voffA); PG8_STAGE(PG8_SB(0, 1), cB + hstep, voffB); PG8_STAGE(PG8_SA(0, 1), cA + hstep, voffA);
        if (wr == 1) PG8_BAR;
        PG8_WAIT_V(4); PG8_BAR;
        PG8_STAGE(PG8_SB(1, 0), cB + kstep, voffB); PG8_STAGE(PG8_SA(1, 0), cA + kstep, voffA); PG8_STAGE(PG8_SB(1, 1), cB + hstep + kstep, voffB);
        PG8_WAIT_V(6); PG8_BAR;
    }
    for (;;) {
        const bool has_next = S.next(ui + 1, nxt);
        const char* nA = has_next ? (const char*)g.A + (size_t)nxt.pm * tstep : cA; const char* nB = has_next ? (const char*)g.Bt + (size_t)nxt.pn * tstep : cB;
#pragma nounroll
        for (int t = 0; t < nt; t += 2) {
            const bool last = (t == nt - 2);
            const char* a1 = cA + (size_t)(t + 1) * kstep;
            const char* a2 = last ? nA : cA + (size_t)(t + 2) * kstep; const char* b2 = last ? nB : cB + (size_t)(t + 2) * kstep;
            const char* a3 = a2 + kstep; const char* b3 = b2 + kstep;
            if (last && has_next) S.a_ready(nxt);
            if constexpr (SP2) {
            PG8_LDB(B0, 0, 0); PG8_LDB(B1, 0, 1); PG8_SCHED; PG8_LDA(At, 0, 0); PG8_STAGE(PG8_SA(1, 1), a1 + hstep, voffA);
            PG8_WAIT_V(8); PG8_WAIT_L(0); PG8_BAR; PG8_MMA(0, 0, At, B0); PG8_MMA(0, 1, At, B1); PG8_BAR; PG8_SCHED;
            PG8_LDA(At, 0, 1); PG8_STAGE(PG8_SB(0, 0), b2, voffB); PG8_STAGE(PG8_SB(0, 1), b2 + hstep, voffB); PG8_STAGE(PG8_SA(0, 0), a2, voffA);
            PG8_WAIT_V(8); PG8_WAIT_L(0); PG8_BAR; PG8_MMA(1, 0, At, B0); PG8_MMA(1, 1, At, B1); PG8_BAR; PG8_SCHED;
            PG8_LDB(B0, 1, 0); PG8_LDB(B1, 1, 1); PG8_SCHED; PG8_LDA(At, 1, 0); PG8_STAGE(PG8_SA(0, 1), a2 + hstep, voffA);
            PG8_WAIT_V(8); PG8_WAIT_L(0); PG8_BAR; PG8_MMA(0, 0, At, B0); PG8_MMA(0, 1, At, B1); PG8_BAR; PG8_SCHED;
            PG8_LDA(At, 1, 1); PG8_STAGE(PG8_SB(1, 0), b3, voffB); PG8_STAGE(PG8_SB(1, 1), b3 + hstep, voffB); PG8_STAGE(PG8_SA(1, 0), a3, voffA);
            PG8_WAIT_V(8); PG8_WAIT_L(0); PG8_BAR; PG8_MMA(1, 0, At, B0); PG8_MMA(1, 1, At, B1); PG8_BAR; PG8_SCHED;
            } else {
            PG8_LDB(B0, 0, 0); PG8_SCHED; PG8_LDA(At, 0, 0); PG8_STAGE(PG8_SA(1, 1), a1 + hstep, voffA);
            PG8_WAIT_L(8); PG8_BAR; PG8_WAIT_L(0); PG8_MMA(0, 0, At, B0); PG8_BAR; PG8_SCHED;
            PG8_LDB(B1, 0, 1); PG8_STAGE(PG8_SB(0, 0), b2, voffB);
            PG8_BAR; PG8_WAIT_L(0); PG8_MMA(0, 1, At, B1); PG8_BAR;
            PG8_LDA(At, 0, 1); PG8_STAGE(PG8_SA(0, 0), a2, voffA);
            PG8_BAR; PG8_WAIT_L(0); PG8_MMA(1, 0, At, B0); PG8_BAR; PG8_SCHED;
            PG8_STAGE(PG8_SB(0, 1), b2 + hstep, voffB);
            PG8_WAIT_V(6); PG8_BAR; PG8_MMA(1, 1, At, B1); PG8_BAR;
            PG8_LDB(B0, 1, 0); PG8_SCHED; PG8_LDA(At, 1, 0); PG8_STAGE(PG8_SA(0, 1), a2 + hstep, voffA);
            PG8_WAIT_L(8); PG8_BAR; PG8_WAIT_L(0); PG8_MMA(0, 0, At, B0); PG8_BAR; PG8_SCHED;
            PG8_LDB(B1, 1, 1); PG8_STAGE(PG8_SB(1, 0), b3, voffB);
            PG8_BAR; PG8_WAIT_L(0); PG8_MMA(0, 1, At, B1); PG8_BAR;
            PG8_LDA(At, 1, 1); PG8_STAGE(PG8_SA(1, 0), a3, voffA);
            PG8_BAR; PG8_WAIT_L(0); PG8_MMA(1, 0, At, B0); PG8_BAR; PG8_SCHED;
            PG8_STAGE(PG8_SB(1, 1), b3 + hstep, voffB);
            PG8_WAIT_V(6); PG8_BAR; PG8_MMA(1, 1, At, B1); PG8_BAR;
            }
        }
        if constexpr (ALIGN_EPI) { if (wr == 0) PG8_BAR; }
        E(acc, cur, wr, wc, fr, fq); S.done(cur);
        if (!has_next) break;
#pragma unroll
        for (int a = 0; a < 2; ++a)
#pragma unroll
            for (int b = 0; b < 2; ++b)
#pragma unroll
                for (int m = 0; m < 4; ++m)
#pragma unroll
                    for (int n = 0; n < 2; ++n) acc[a][b][m][n] = (f32x4){0.f, 0.f, 0.f, 0.f};
        cur = nxt; cA = nA; cB = nB; ++ui;
        if constexpr (ALIGN_EPI) { if (wr == 1) PG8_BAR; }
    }
    PG8_WAIT_V(0);
    if constexpr (!ALIGN_EPI) { if (wr == 0) PG8_BAR; }
    PG8_BAR;
#undef PG8_SA
#undef PG8_SB
#undef PG8_STAGE
#undef PG8_LDA
#undef PG8_LDB
#undef PG8_MMA
#undef PG8_WAIT_V
#undef PG8_WAIT_L
#undef PG8_BAR
#undef PG8_SCHED
}
}
typedef f32x4 AccT[2][2][4][2];

struct EpiPlain {
    static constexpr bool PERM = true;
    bf16_t* O; int ldc;
    DI void operator()(const AccT& acc, const pg8::Unit& u, int wr, int wc, int fr, int fq) const {
        const int row0 = u.pm * 256 + wr * 64 + fr, col0 = u.pn * 256 + wc * 32 + 8 * fq;
#pragma unroll
        for (int ai = 0; ai < 2; ++ai)
#pragma unroll
            for (int m = 0; m < 4; ++m) { bf16_t* rowp = O + (size_t)(row0 + ai * 128 + m * 16) * ldc + col0;
#pragma unroll
                for (int bj = 0; bj < 2; ++bj) { const f32x4 v0 = acc[ai][bj][m][0], v1 = acc[ai][bj][m][1];
                    u32x4 w; w.x = cvt_pk_bf16(v0[0], v0[1]); w.y = cvt_pk_bf16(v0[2], v0[3]); w.z = cvt_pk_bf16(v1[0], v1[1]); w.w = cvt_pk_bf16(v1[2], v1[3]);
                    *(u32x4*)(rowp + bj * 128) = w; } }
    }
};
struct EpiResid {
    static constexpr bool PERM = true;
    const float* Hin; float* Hout; const float* bias; int zero;
    DI void operator()(const AccT& acc, const pg8::Unit& u, int wr, int wc, int fr, int fq) const {
        const int row0 = u.pm * 256 + wr * 64 + fr, col0 = u.pn * 256 + wc * 32 + 8 * fq;
        f32x4 bv[2][2];
#pragma unroll
        for (int bj = 0; bj < 2; ++bj)
#pragma unroll
            for (int n = 0; n < 2; ++n) bv[bj][n] = bias ? *(const f32x4*)(bias + col0 + bj * 128 + 4 * n) : (f32x4){0.f, 0.f, 0.f, 0.f};
#pragma unroll
        for (int ai = 0; ai < 2; ++ai)
#pragma unroll
            for (int m = 0; m < 4; ++m) { const size_t ro = (size_t)(row0 + ai * 128 + m * 16) * DM + col0;
#pragma unroll
                for (int bj = 0; bj < 2; ++bj)
#pragma unroll
                    for (int n = 0; n < 2; ++n) { const f32x4 hin = *(const f32x4*)(Hin + ro + bj * 128 + 4 * n);
                        *(f32x4*)(Hout + ro + bj * 128 + 4 * n) = zero ? hin : (hin + acc[ai][bj][m][n] + bv[bj][n]); } }
    }
};
struct EpiGlu {
    static constexpr bool PERM = true;
    bf16_t* O; const float* bias;
    DI void operator()(const AccT& acc, const pg8::Unit& u, int wr, int wc, int fr, int fq) const {
        const int row0 = u.pm * 256 + wr * 64 + fr, col0 = u.pn * 128 + wc * 32 + 8 * fq;
        f32x4 bu[2], bg[2];
#pragma unroll
        for (int n = 0; n < 2; ++n) { bu[n] = *(const f32x4*)(bias + col0 + 4 * n); bg[n] = *(const f32x4*)(bias + 1024 + col0 + 4 * n); }
#pragma unroll
        for (int ai = 0; ai < 2; ++ai)
#pragma unroll
            for (int m = 0; m < 4; ++m) { bf16_t* rowp = O + (size_t)(row0 + ai * 128 + m * 16) * DM + col0;
                float r[8];
#pragma unroll
                for (int n = 0; n < 2; ++n)
#pragma unroll
                    for (int e = 0; e < 4; ++e) { const float uu = acc[ai][0][m][n][e] + bu[n][e], gg = acc[ai][1][m][n][e] + bg[n][e];
                        r[4 * n + e] = uu / (1.f + __expf(-gg)); }
                u32x4 w; w.x = cvt_pk_bf16(r[0], r[1]); w.y = cvt_pk_bf16(r[2], r[3]); w.z = cvt_pk_bf16(r[4], r[5]); w.w = cvt_pk_bf16(r[6], r[7]);
                *(u32x4*)rowp = w; }
    }
};
struct EpiQup {
    static constexpr bool PERM = true;
    bf16_t* O; const float* cosr; const float* sinr; float qscale;
    DI void operator()(const AccT& acc, const pg8::Unit& u, int wr, int wc, int fr, int fq) const {
        const int row0 = u.pm * 256 + wr * 64 + fr;
#pragma unroll
        for (int bj = 0; bj < 2; ++bj) {
            const int c32 = u.pn * 256 + bj * 128 + wc * 32;
            const bool rope = (c32 % 96) == 64;
#pragma unroll
            for (int ai = 0; ai < 2; ++ai)
#pragma unroll
                for (int m = 0; m < 4; ++m) { const int row = row0 + ai * 128 + m * 16;
                    float r[8];
#pragma unroll
                    for (int n = 0; n < 2; ++n)
#pragma unroll
                        for (int e = 0; e < 4; ++e) r[4 * n + e] = acc[ai][bj][m][n][e];
                    if (rope) {
                        const int i0 = 8 * (fq & 1);
                        const f32x4 c0 = *(const f32x4*)(cosr + (size_t)row * 16 + i0), c1 = *(const f32x4*)(cosr + (size_t)row * 16 + i0 + 4);
                        const f32x4 s0 = *(const f32x4*)(sinr + (size_t)row * 16 + i0), s1 = *(const f32x4*)(sinr + (size_t)row * 16 + i0 + 4);
#pragma unroll
                        for (int j = 0; j < 8; ++j) { const float own = r[j], oth = __shfl_xor(own, 32);
                            const float c = j < 4 ? c0[j & 3] : c1[j & 3], s = j < 4 ? s0[j & 3] : s1[j & 3];
                            r[j] = (fq < 2) ? (own * c - oth * s) : (own * c + oth * s); }
                    }
                    u32x4 w; w.x = cvt_pk_bf16(r[0] * qscale, r[1] * qscale); w.y = cvt_pk_bf16(r[2] * qscale, r[3] * qscale);
                    w.z = cvt_pk_bf16(r[4] * qscale, r[5] * qscale); w.w = cvt_pk_bf16(r[6] * qscale, r[7] * qscale);
                    *(u32x4*)(O + (size_t)row * 768 + c32 + 8 * fq) = w;
                    asm volatile("" ::: "memory"); }
        }
    }
};
struct EpiKVup {
    static constexpr bool PERM = true;
    bf16_t* KM; bf16_t* VM;
    DI void operator()(const AccT& acc, const pg8::Unit& u, int wr, int wc, int fr, int fq) const {
        const int row0 = u.pm * 256 + wr * 64 + fr;
#pragma unroll
        for (int bj = 0; bj < 2; ++bj) { const int head = 2 * u.pn + bj;
            bf16_t* base = (wc < 2) ? (KM + head * 96 + wc * 32 + 8 * fq) : (VM + head * 64 + (wc - 2) * 32 + 8 * fq);
            const int pitch = (wc < 2) ? 768 : 512;
#pragma unroll
            for (int ai = 0; ai < 2; ++ai)
#pragma unroll
                for (int m = 0; m < 4; ++m) { const int row = row0 + ai * 128 + m * 16; const f32x4 v0 = acc[ai][bj][m][0], v1 = acc[ai][bj][m][1];
                    u32x4 w; w.x = cvt_pk_bf16(v0[0], v0[1]); w.y = cvt_pk_bf16(v0[2], v0[3]); w.z = cvt_pk_bf16(v1[0], v1[1]); w.w = cvt_pk_bf16(v1[2], v1[3]);
                    *(u32x4*)(base + (size_t)row * pitch) = w; } }
    }
};

#define XB_TMO      128
#define XB_XCNT(j)  (256  + 64 * (j))
#define XB_XSUB(j)  (1280 + 64 * (j))
#define XB_XGEN(j)  (2304 + 64 * (j))
#define XB_TOP      3328
#define XB_TOPGEN   3392
#define XCD_BAR_WORDS 3456
#define XB_SPIN_CAP (1u << 18)
__device__ __forceinline__ unsigned xb_ld(unsigned* p)              { return __hip_atomic_load(p, __ATOMIC_RELAXED, __HIP_MEMORY_SCOPE_AGENT); }
__device__ __forceinline__ unsigned xb_add(unsigned* p, unsigned v) { return __hip_atomic_fetch_add(p, v, __ATOMIC_RELAXED, __HIP_MEMORY_SCOPE_AGENT); }
__device__ __forceinline__ unsigned xb_xcc_id() { return (unsigned)__builtin_amdgcn_s_getreg((3 << 11) | 20) & 0xFu; }
#define XB_SPIN(cond, bar) do { unsigned _sp = 0; while (cond) { __builtin_amdgcn_s_sleep(1); \
    if ((++_sp & 255u) == 0u) { if (xb_ld(&(bar)[XB_TMO])) break; if (_sp > XB_SPIN_CAP) { atomicAdd(&(bar)[XB_TMO], 1u); break; } } } } while (0)
struct XcdBarrier { unsigned* bar; unsigned x; volatile LAS unsigned* st; };
__device__ __forceinline__ XcdBarrier xcd_barrier_post(unsigned* bar, volatile LAS unsigned* st) {
    XcdBarrier b; b.bar = bar; b.x = xb_xcc_id(); b.st = st;
    if (threadIdx.x == 0) (void)xb_add(&bar[XB_XCNT(b.x)], 1u);
    return b;
}
__device__ __forceinline__ void xcd_barrier_complete(unsigned* bar, unsigned x, unsigned& nloc, unsigned& nx) {
    const unsigned G = gridDim.x * gridDim.y * gridDim.z;
    unsigned sum, cnt, mine, sp = 0u;
    for (;;) {
        sum = 0u; cnt = 0u; mine = 0u;
#pragma unroll
        for (unsigned j = 0; j < 16; ++j) { const unsigned c = xb_ld(&bar[XB_XCNT(j)]); sum += c; cnt += (c > 0u) ? 1u : 0u; mine = (j == x) ? c : mine; }
        if (sum == G) break;
        __builtin_amdgcn_s_sleep(1);
        if ((++sp & 255u) == 0u) { if (xb_ld(&bar[XB_TMO])) break; if (sp > XB_SPIN_CAP) { atomicAdd(&bar[XB_TMO], 1u); break; } }
    }
    nloc = mine > 0u ? mine : 1u; nx = cnt > 0u ? cnt : 1u;
}
__device__ __forceinline__ void xcd_barrier(const XcdBarrier& b) {
    asm volatile("s_waitcnt vmcnt(0)" ::: "memory");
    __syncthreads();
    if (threadIdx.x == 0) {
        unsigned* bar = b.bar;
        __builtin_amdgcn_s_waitcnt(0);
        unsigned nloc = b.st[0], nx = b.st[1];
        if (nloc == 0u) { xcd_barrier_complete(bar, b.x, nloc, nx); b.st[0] = nloc; b.st[1] = nx; }
        const unsigned old = xb_add(&bar[XB_XSUB(b.x)], 1u);
        const unsigned gen = old / nloc;
        if (old + 1u == (gen + 1u) * nloc) {
            __builtin_amdgcn_fence(__ATOMIC_RELEASE, "agent");
            asm volatile("s_waitcnt vmcnt(0)" ::: "memory");
            const unsigned og = xb_add(&bar[XB_TOP], 1u);
            const unsigned tg = og / nx;
            if (og + 1u == (tg + 1u) * nx) xb_add(&bar[XB_TOPGEN], 1u);
            else XB_SPIN(xb_ld(&bar[XB_TOPGEN]) == tg, bar);
            __builtin_amdgcn_fence(__ATOMIC_ACQUIRE, "agent");
            xb_add(&bar[XB_XGEN(b.x)], 1u);
            asm volatile("s_waitcnt vmcnt(0)" ::: "memory");
        } else {
            XB_SPIN(xb_ld(&bar[XB_XGEN(b.x)]) == gen, bar);
            __builtin_amdgcn_fence(__ATOMIC_ACQUIRE, "agent");
            asm volatile("s_waitcnt vmcnt(0)" ::: "memory");
        }
    }
    __syncthreads();
}

struct Params {
    const float* in[23];
    float* out;
    unsigned char* ws;
    double inv_r[16];
    double inv_m[32];
    int ph_lo, ph_hi;
};

template <int GLU>
DI void transpose_item(const float* W, int K, int N, bf16_t* WT, LAS float* scr, int item, int lane) {
    const int nblk = N / 32, kb = item / nblk, nb = item % nblk, k0 = 64 * kb, n0 = 32 * nb;
#pragma unroll 8
    for (int i = 0; i < 32; ++i) { const int kk = 2 * i + (lane >> 5); scr[kk * 33 + (lane & 31)] = W[(size_t)(k0 + kk) * N + n0 + (lane & 31)]; }
    LDS_WAIT(); asm volatile("" ::: "memory");
    const int c = lane & 7;
#pragma unroll
    for (int j = 0; j < 4; ++j) { const int n = (lane >> 3) + 8 * j; const LAS float* s = scr + (8 * c) * 33 + n;
        u32x4 o; o.x = cvt_pk_bf16(s[0 * 33], s[1 * 33]); o.y = cvt_pk_bf16(s[2 * 33], s[3 * 33]); o.z = cvt_pk_bf16(s[4 * 33], s[5 * 33]); o.w = cvt_pk_bf16(s[6 * 33], s[7 * 33]);
        int nn = n0 + n;
        if (GLU) nn = (nn < 1024) ? ((nn >> 7) * 256 + (nn & 127)) : (((nn - 1024) >> 7) * 256 + 128 + (nn & 127));
        *(u32x4*)(WT + (size_t)nn * K + k0 + 8 * c) = o; }
    LDS_WAIT(); asm volatile("" ::: "memory");
}
DI void rms_row_to_bf16(const float* xrow, const float* gain, bf16_t* orow, int lane) {
    const f32x4* xr = (const f32x4*)xrow + lane; const f32x4* gr = (const f32x4*)gain + lane;
    f32x4 v[4]; float s = 0.f;
#pragma unroll
    for (int j = 0; j < 4; ++j) { v[j] = xr[64 * j]; s += (v[j].x * v[j].x + v[j].y * v[j].y) + (v[j].z * v[j].z + v[j].w * v[j].w); }
    const float r = rsqrtf(wave_sum(s) * (1.f / DM) + NORM_EPS);
    u32x2* o8 = (u32x2*)orow + lane;
#pragma unroll
    for (int j = 0; j < 4; ++j) { const f32x4 g = gr[64 * j]; u32x2 o; o.x = cvt_pk_bf16(v[j].x * r * g.x, v[j].y * r * g.y); o.y = cvt_pk_bf16(v[j].z * r * g.z, v[j].w * r * g.w); o8[64 * j] = o; }
}

DI void token_prep_unit(LAS unsigned char* lds, int unit, const bf16_t* proj, const float* qn, const float* kvn,
                        const float* cosr, const float* sinr, const float* cosm, const float* sinm,
                        bf16_t* cqn, bf16_t* ckvn, bf16_t* KM, bf16_t* MQ, bf16_t* MK, float* kpart, int wave, int lane) {
    float ks1[4] = {0.f, 0.f, 0.f, 0.f}, ks2[4] = {0.f, 0.f, 0.f, 0.f};
    const float mscale = 0.125f * LOG2E;
    for (int i = 0; i < 8; ++i) {
        const int row = unit * 64 + wave * 8 + i;
        const bf16_t* P = proj + (size_t)row * NPROJP;
        { unsigned w[3]; float ss = 0.f;
#pragma unroll
          for (int j = 0; j < 3; ++j) { w[j] = *(const unsigned*)(P + 2 * lane + 128 * j); const float a = bf_lo(w[j]), b = bf_hi(w[j]); ss += a * a + b * b; }
          const float r = rsqrtf(wave_sum(ss) * (1.f / 384.f) + NORM_EPS);
#pragma unroll
          for (int j = 0; j < 3; ++j) { const f32x2 g = *(const f32x2*)(qn + 2 * lane + 128 * j);
              *(unsigned*)(cqn + (size_t)row * 384 + 2 * lane + 128 * j) = cvt_pk_bf16(bf_lo(w[j]) * r * g.x, bf_hi(w[j]) * r * g.y); } }
        { unsigned w[2]; float ss = 0.f;
#pragma unroll
          for (int j = 0; j < 2; ++j) { w[j] = *(const unsigned*)(P + 384 + 2 * lane + 128 * j); const float a = bf_lo(w[j]), b = bf_hi(w[j]); ss += a * a + b * b; }
          const float r = rsqrtf(wave_sum(ss) * (1.f / 256.f) + NORM_EPS);
#pragma unroll
          for (int j = 0; j < 2; ++j) { const f32x2 g = *(const f32x2*)(kvn + 2 * lane + 128 * j);
              *(unsigned*)(ckvn + (size_t)row * 256 + 2 * lane + 128 * j) = cvt_pk_bf16(bf_lo(w[j]) * r * g.x, bf_hi(w[j]) * r * g.y); } }
        { const int h = lane >> 3, i2 = 2 * (lane & 7);
          const unsigned x1 = *(const unsigned*)(P + 640 + i2), x2 = *(const unsigned*)(P + 656 + i2);
          const f32x2 c = *(const f32x2*)(cosr + (size_t)row * 16 + i2), s = *(const f32x2*)(sinr + (size_t)row * 16 + i2);
          const float a0 = bf_lo(x1), a1 = bf_hi(x1), b0 = bf_lo(x2), b1 = bf_hi(x2);
          *(unsigned*)(KM + (size_t)row * 768 + h * 96 + 64 + i2) = cvt_pk_bf16(a0 * c.x - b0 * s.x, a1 * c.y - b1 * s.y);
          *(unsigned*)(KM + (size_t)row * 768 + h * 96 + 80 + i2) = cvt_pk_bf16(b0 * c.x + a0 * s.x, b1 * c.y + a1 * s.y); }
        { const int hq = lane >> 3, i4 = 4 * (lane & 7);
          const f32x4 c = *(const f32x4*)(cosm + (size_t)row * 32 + i4), s = *(const f32x4*)(sinm + (size_t)row * 32 + i4);
          { const u32x2 x1 = *(const u32x2*)(P + 672 + hq * 64 + i4), x2 = *(const u32x2*)(P + 672 + hq * 64 + 32 + i4);
            const float a[4] = {bf_lo(x1.x), bf_hi(x1.x), bf_lo(x1.y), bf_hi(x1.y)}, b[4] = {bf_lo(x2.x), bf_hi(x2.x), bf_lo(x2.y), bf_hi(x2.y)};
            float y1[4], y2[4];
#pragma unroll
            for (int e = 0; e < 4; ++e) { y1[e] = (a[e] * c[e] - b[e] * s[e]) * mscale; y2[e] = (b[e] * c[e] + a[e] * s[e]) * mscale; }
            u32x2 o1, o2; o1.x = cvt_pk_bf16(y1[0], y1[1]); o1.y = cvt_pk_bf16(y1[2], y1[3]); o2.x = cvt_pk_bf16(y2[0], y2[1]); o2.y = cvt_pk_bf16(y2[2], y2[3]);
            *(u32x2*)(MQ + (size_t)row * 512 + hq * 64 + i4) = o1; *(u32x2*)(MQ + (size_t)row * 512 + hq * 64 + 32 + i4) = o2; }
          { const u32x2 x1 = *(const u32x2*)(P + 1184 + hq * 64 + i4), x2 = *(const u32x2*)(P + 1184 + hq * 64 + 32 + i4);
            const float a[4] = {bf_lo(x1.x), bf_hi(x1.x), bf_lo(x1.y), bf_hi(x1.y)}, b[4] = {bf_lo(x2.x), bf_hi(x2.x), bf_lo(x2.y), bf_hi(x2.y)};
            float y1[4], y2[4];
#pragma unroll
            for (int e = 0; e < 4; ++e) { y1[e] = a[e] * c[e] - b[e] * s[e]; y2[e] = b[e] * c[e] + a[e] * s[e]; ks1[e] += y1[e]; ks2[e] += y2[e]; }
            u32x2 o1, o2; o1.x = cvt_pk_bf16(y1[0], y1[1]); o1.y = cvt_pk_bf16(y1[2], y1[3]); o2.x = cvt_pk_bf16(y2[0], y2[1]); o2.y = cvt_pk_bf16(y2[2], y2[3]);
            *(u32x2*)(MK + (size_t)row * 512 + hq * 64 + i4) = o1; *(u32x2*)(MK + (size_t)row * 512 + hq * 64 + 32 + i4) = o2; } }
    }
    LAS float* red = (LAS float*)lds;
    { const int hq = lane >> 3, i4 = 4 * (lane & 7);
#pragma unroll
      for (int e = 0; e < 4; ++e) { red[wave * 512 + hq * 64 + i4 + e] = ks1[e]; red[wave * 512 + hq * 64 + 32 + i4 + e] = ks2[e]; } }
    __syncthreads();
    { const int tid = wave * 64 + lane; float s = 0.f;
#pragma unroll
      for (int w = 0; w < 8; ++w) s += red[w * 512 + tid];
      const int row0 = unit * 64, b = row0 / SEQ, t0 = row0 % SEQ, n = t0 / 256, part = (t0 % 256) / 64;
      kpart[((size_t)(b * 32 + n) * 4 + part) * 512 + tid] = s; }
    __syncthreads();
}

DI s16x4 vtr(const LAS char* p) { return __builtin_bit_cast(s16x4, __builtin_amdgcn_ds_read_tr16_b64_v4i16((LAS v4i16_t*)p)); }
#define MFMA32(a, b, c) __builtin_amdgcn_mfma_f32_32x32x16_bf16((a), (b), (c), 0, 0, 0)

template <int DK, bool MOBA>
DI void attn_unit(LAS unsigned char* lds, const bf16_t* Qp, int qpitch, const bf16_t* Kp, int kpitch, const bf16_t* Vp, int vpitch,
                  bf16_t* Op, int opitch, int qb, const float* kpart_b  ) {
    constexpr int NKS = DK / 16, KCH = DK / 8, KBYTES = KCH * 1024, VBYTES = 8192;
    constexpr int OFF_K0 = 0, OFF_K1 = KBYTES, OFF_V0 = 2 * KBYTES, OFF_V1 = 2 * KBYTES + VBYTES, OFF_KM = 2 * KBYTES + 2 * VBYTES;
    int tid_o = threadIdx.x; asm volatile("" : "+v"(tid_o));
    const int tid = tid_o, lane = tid & 63, r32 = lane & 31, hi = lane >> 5; const int wid = __builtin_amdgcn_readfirstlane(tid >> 6);
    const int q0 = qb * 256, NT = 4 * qb + 4;
    bf16x8 qf[NKS];
    { const bf16_t* qrow = Qp + (size_t)(q0 + wid * 32 + r32) * qpitch + hi * 8;
#pragma unroll
      for (int ks = 0; ks < NKS; ++ks) qf[ks] = *(const bf16x8*)(qrow + ks * 16); }
    unsigned selmask = 0u;
    if constexpr (MOBA) {
        const int own = qb;
        if (own > 0) {
            LAS float* km = (LAS float*)(lds + OFF_KM);
            for (int e = tid; e < own * 64; e += NTHR) { const int n = e >> 6, d = e & 63; const float* kp = kpart_b + (size_t)n * 4 * 512 + d;
                km[e] = (kp[0] + kp[512] + kp[1024] + kp[1536]) * (1.f / 256.f); }
            __syncthreads();
            float qv[NKS][8];
#pragma unroll
            for (int ks = 0; ks < NKS; ++ks)
#pragma unroll
                for (int j = 0; j < 8; ++j) qv[ks][j] = bf1((bf16_t)qf[ks][j]);
            float v0 = -INFINITY, v1 = -INFINITY, v2 = -INFINITY; int i0 = -1, i1 = -1, i2 = -1;
            for (int n = 0; n < own; ++n) {
                float g = 0.f;
#pragma unroll
                for (int ks = 0; ks < NKS; ++ks) { const f32x4 ka = *(const LAS f32x4*)(km + n * 64 + ks * 16 + hi * 8), kb = *(const LAS f32x4*)(km + n * 64 + ks * 16 + hi * 8 + 4);
                    g += qv[ks][0] * ka[0] + qv[ks][1] * ka[1] + qv[ks][2] * ka[2] + qv[ks][3] * ka[3] + qv[ks][4] * kb[0] + qv[ks][5] * kb[1] + qv[ks][6] * kb[2] + qv[ks][7] * kb[3]; }
                g += __shfl_xor(g, 32);
                if (g > v0) { v2 = v1; i2 = i1; v1 = v0; i1 = i0; v0 = g; i0 = n; }
                else if (g > v1) { v2 = v1; i2 = i1; v1 = g; i1 = n; }
                else if (g > v2) { v2 = g; i2 = n; }
            }
            if (i0 >= 0) selmask |= 1u << i0;
            if (i1 >= 0) selmask |= 1u << i1;
            if (i2 >= 0) selmask |= 1u << i2;
            __syncthreads();
        }
    }
    const bf16_t* kg0 = Kp + (size_t)lane * kpitch + wid * 8;
    const bf16_t* kg1 = Kp + (size_t)lane * kpitch + (8 + (wid & 3)) * 8;
    const int vrow = tid >> 3, vpc = tid & 7;
    const bf16_t* vg = Vp + (size_t)vrow * vpitch + vpc * 8;
    const int kdst0 = wid * 1024 + lane * 16, kdst1 = (8 + (wid & 3)) * 1024 + lane * 16, vdst = (vpc >> 2) * 4096 + vrow * 64 + (vpc & 3) * 16;
    u32x4 sk0, sk1 = (u32x4){0u, 0u, 0u, 0u}, sv;
    sk0 = *(const u32x4*)kg0; if (DK == 96 && wid < 4) sk1 = *(const u32x4*)kg1; sv = *(const u32x4*)vg;
    *(LAS u32x4*)(lds + OFF_K0 + kdst0) = sk0; if (DK == 96 && wid < 4) *(LAS u32x4*)(lds + OFF_K0 + kdst1) = sk1; *(LAS u32x4*)(lds + OFF_V0 + vdst) = sv;
    float m = -1e30f, l = 0.f; f32x16 ot[2]; ot[0] = f32x16{}; ot[1] = f32x16{};
    const int qrel = wid * 32 + r32;
    const int vq = (lane & 15) >> 2, vp = lane & 3, vblk = (lane >> 4) & 1;
    const int vbase = (4 * hi + vq) * 64 + vblk * 32 + vp * 8;
    for (int t = 0; t < NT; ++t) {
        __syncthreads();
        const int cur = t & 1;
        const bool more = (t + 1 < NT);
        if (more) { const size_t ro = (size_t)(t + 1) * 64; sk0 = *(const u32x4*)(kg0 + ro * kpitch); if (DK == 96 && wid < 4) sk1 = *(const u32x4*)(kg1 + ro * kpitch); sv = *(const u32x4*)(vg + ro * vpitch); }
        const LAS unsigned char* Kb = lds + (cur ? OFF_K1 : OFF_K0); const LAS unsigned char* Vb = lds + (cur ? OFF_V1 : OFF_V0);
        const int jb = t - 4 * qb;
        bool active = true; bool lane_sel = true;
        if (jb >= 0) { if (64 * jb > wid * 32 + 31) active = false; }
        else if constexpr (MOBA) { lane_sel = (selmask >> (t >> 2)) & 1u; active = __any(lane_sel); }
        if (active) {
            f32x16 s0 = f32x16{}, s1 = f32x16{};
#pragma unroll
            for (int ks = 0; ks < NKS; ++ks) {
                const bf16x8 ka = *(const LAS bf16x8*)(Kb + (2 * ks + hi) * 1024 + r32 * 16), kb = *(const LAS bf16x8*)(Kb + (2 * ks + hi) * 1024 + (32 + r32) * 16);
                s0 = MFMA32(ka, qf[ks], s0); s1 = MFMA32(kb, qf[ks], s1);
            }
            if (jb >= 0) { if (64 * jb + 63 > wid * 32) { const int kb0 = 64 * jb + 4 * hi;
#pragma unroll
                for (int r = 0; r < 16; ++r) { const int kv = kb0 + (r & 3) + 8 * (r >> 2); if (kv > qrel) s0[r] = -INFINITY; if (kv + 32 > qrel) s1[r] = -INFINITY; } } }
            else if constexpr (MOBA) { if (!lane_sel) {
#pragma unroll
                for (int r = 0; r < 16; ++r) { s0[r] = -INFINITY; s1[r] = -INFINITY; } } }
            float tm = s0[0];
#pragma unroll
            for (int r = 1; r < 16; ++r) tm = fmaxf(tm, s0[r]);
#pragma unroll
            for (int r = 0; r < 16; ++r) tm = fmaxf(tm, s1[r]);
            tm = fmaxf(tm, __shfl_xor(tm, 32));
            const float mn = fmaxf(m, tm);
            if (__any(mn > m)) { const float alpha = __builtin_amdgcn_exp2f(m - mn); l *= alpha;
#pragma unroll
                for (int r = 0; r < 16; ++r) { ot[0][r] *= alpha; ot[1][r] *= alpha; }
                m = mn; }
            float ls = 0.f;
#pragma unroll
            for (int r = 0; r < 16; ++r) { s0[r] = __builtin_amdgcn_exp2f(s0[r] - m); s1[r] = __builtin_amdgcn_exp2f(s1[r] - m); ls += s0[r] + s1[r]; }
            l += ls;
            bf16x8 pf[4];
#pragma unroll
            for (int s = 0; s < 4; ++s) { u32x4 w;
                if (s < 2) { w.x = cvt_pk_bf16(s0[8 * s], s0[8 * s + 1]); w.y = cvt_pk_bf16(s0[8 * s + 2], s0[8 * s + 3]); w.z = cvt_pk_bf16(s0[8 * s + 4], s0[8 * s + 5]); w.w = cvt_pk_bf16(s0[8 * s + 6], s0[8 * s + 7]); }
                else { const int q = s - 2; w.x = cvt_pk_bf16(s1[8 * q], s1[8 * q + 1]); w.y = cvt_pk_bf16(s1[8 * q + 2], s1[8 * q + 3]); w.z = cvt_pk_bf16(s1[8 * q + 4], s1[8 * q + 5]); w.w = cvt_pk_bf16(s1[8 * q + 6], s1[8 * q + 7]); }
                pf[s] = __builtin_bit_cast(bf16x8, w); }
#pragma unroll
            for (int db = 0; db < 2; ++db)
#pragma unroll
                for (int s = 0; s < 4; ++s) { const LAS char* vpn = (const LAS char*)Vb + db * 4096 + s * 1024 + vbase;
                    const s16x4 lo = vtr(vpn), hi4 = vtr(vpn + 512);
                    const bf16x8 vf = (bf16x8){lo[0], lo[1], lo[2], lo[3], hi4[0], hi4[1], hi4[2], hi4[3]};
                    ot[db] = MFMA32(vf, pf[s], ot[db]); }
        }
        if (more) { const int nb = cur ^ 1;
            *(LAS u32x4*)(lds + (nb ? OFF_K1 : OFF_K0) + kdst0) = sk0; if (DK == 96 && wid < 4) *(LAS u32x4*)(lds + (nb ? OFF_K1 : OFF_K0) + kdst1) = sk1; *(LAS u32x4*)(lds + (nb ? OFF_V1 : OFF_V0) + vdst) = sv; }
    }
    l += __shfl_xor(l, 32);
    const float rl = 1.f / l;
    bf16_t* orow = Op + (size_t)(q0 + qrel) * opitch;
#pragma unroll
    for (int db = 0; db < 2; ++db)
#pragma unroll
        for (int g = 0; g < 4; ++g) { u32x2 w; w.x = cvt_pk_bf16(ot[db][4 * g] * rl, ot[db][4 * g + 1] * rl); w.y = cvt_pk_bf16(ot[db][4 * g + 2] * rl, ot[db][4 * g + 3] * rl);
            *(u32x2*)(orow + 32 * db + 8 * g + 4 * hi) = w; }
    __syncthreads();
}

DI void dwconv_unit(LAS unsigned char* lds, int unit, const bf16_t* ug, const float (&w)[31][2], float b0, float b1, float g0, float g1, float be0, float be1, bf16_t* y, int tid) {
    const int row0 = unit * 16, tb = row0 % SEQ;
    for (int c = tid; c < 46 * 128; c += NTHR) { const int r = c >> 7, pc = c & 127; const int trel = tb - 30 + r;
        u32x4 v = (u32x4){0u, 0u, 0u, 0u};
        if (trel >= 0) v = *(const u32x4*)(ug + (size_t)(row0 - 30 + r) * DM + pc * 8);
        *(LAS u32x4*)(lds + r * 2048 + pc * 16) = v; }
    __syncthreads();
    unsigned xs[46];
#pragma unroll
    for (int r = 0; r < 46; ++r) xs[r] = *(const LAS unsigned*)(lds + r * 2048 + tid * 4);
    float a0[16], a1[16];
#pragma unroll
    for (int i = 0; i < 16; ++i) { float s0 = b0, s1 = b1;
#pragma unroll
        for (int j = 0; j < 31; ++j) { s0 += w[j][0] * bf_lo(xs[i + j]); s1 += w[j][1] * bf_hi(xs[i + j]); }
        a0[i] = s0; a1[i] = s1; }
    __syncthreads();
    LAS float* red = (LAS float*)lds;
    const int lane = tid & 63, wave = tid >> 6;
#pragma unroll
    for (int i = 0; i < 16; ++i) { const float s = wave_sum(a0[i] + a1[i]), q = wave_sum(a0[i] * a0[i] + a1[i] * a1[i]);
        if (lane == 0) { red[wave * 32 + i] = s; red[wave * 32 + 16 + i] = q; } }
    __syncthreads();
#pragma unroll
    for (int i = 0; i < 16; ++i) { float s = 0.f, q = 0.f;
#pragma unroll
        for (int wv = 0; wv < 8; ++wv) { s += red[wv * 32 + i]; q += red[wv * 32 + 16 + i]; }
        const float mean = s * (1.f / DM), var = fmaxf(q * (1.f / DM) - mean * mean, 0.f), rstd = rsqrtf(var + NORM_EPS);
        const float z0 = (a0[i] - mean) * rstd * g0 + be0, z1 = (a1[i] - mean) * rstd * g1 + be1;
        const float o0 = z0 / (1.f + __expf(-z0)), o1 = z1 / (1.f + __expf(-z1));
        *(unsigned*)(y + (size_t)(row0 + i) * DM + 2 * tid) = cvt_pk_bf16(o0, o1); }
    __syncthreads();
}

#define CE_DESC(a, b) do { const float _h = fmaxf((a), (b)), _l = fminf((a), (b)); (a) = _h; (b) = _l; } while (0)
DI void sort16_desc(float (&a)[16]) {
#pragma unroll
    for (int k = 2; k <= 16; k <<= 1)
#pragma unroll
        for (int j = k >> 1; j > 0; j >>= 1)
#pragma unroll
            for (int i = 0; i < 16; ++i) { const int p = i ^ j; if (p > i) { if ((i & k) == 0) CE_DESC(a[i], a[p]); else CE_DESC(a[p], a[i]); } }
}
DI void merge16_desc(float (&a)[16], const float (&b)[16]) {
#pragma unroll
    for (int i = 0; i < 16; ++i) a[i] = fmaxf(a[i], b[15 - i]);
#pragma unroll
    for (int j = 8; j > 0; j >>= 1)
#pragma unroll
        for (int i = 0; i < 16; ++i) { const int p = i ^ j; if (p > i) CE_DESC(a[i], a[p]); }
}
DI void top16_of_64(float (&g0)[16], float (&g1)[16], float (&g2)[16], float (&g3)[16]) {
    sort16_desc(g0); sort16_desc(g1); sort16_desc(g2); sort16_desc(g3);
    merge16_desc(g0, g1); merge16_desc(g2, g3); merge16_desc(g0, g2);
}
DI float pack_key(float v, unsigned code, unsigned mask) { return __builtin_bit_cast(float, (__builtin_bit_cast(unsigned, v) & ~mask) | code); }

DI void peer_topk_unit(const LAS unsigned char* sk, LAS unsigned* dec  , const bf16_t* q2, int tile, int h, int* idx, float* gate, int lane) {
    const int r32 = lane & 31, hi = lane >> 5; const int tok = tile * 32 + r32;
    float L[2][16];
#pragma unroll
    for (int c = 0; c < 2; ++c) {
        bf16x8 qf[8];
        const bf16_t* qrow = q2 + (size_t)tok * 2048 + (h * 2 + c) * 128 + hi * 8;
#pragma unroll
        for (int ks = 0; ks < 8; ++ks) qf[ks] = *(const bf16x8*)(qrow + ks * 16);
        f32x16 acc[4];
#pragma unroll
        for (int kt = 0; kt < 4; ++kt) { acc[kt] = f32x16{};
#pragma unroll
            for (int ks = 0; ks < 8; ++ks) { const bf16x8 a = *(const LAS bf16x8*)(sk + c * 32768 + (2 * ks + hi) * 2048 + (32 * kt + r32) * 16); acc[kt] = MFMA32(a, qf[ks], acc[kt]); } }
        float g[4][16];
#pragma unroll
        for (int kt = 0; kt < 4; ++kt)
#pragma unroll
            for (int r = 0; r < 16; ++r) { const int key = 32 * kt + (r & 3) + 8 * (r >> 2) + 4 * hi; g[kt][r] = pack_key(acc[kt][r], 127u - (unsigned)key, 127u); }
        top16_of_64(g[0], g[1], g[2], g[3]);
        float other[16];
#pragma unroll
        for (int i = 0; i < 16; ++i) other[i] = __shfl_xor(g[0][i], 32);
        merge16_desc(g[0], other);
#pragma unroll
        for (int i = 0; i < 16; ++i) L[c][i] = g[0][i];
    }
#pragma unroll
    for (int c = 0; c < 2; ++c)
#pragma unroll
        for (int q = 0; q < 4; ++q) { unsigned w = 0u;
#pragma unroll
            for (int e = 0; e < 4; ++e) w |= (127u - (__builtin_bit_cast(unsigned, L[c][4 * q + e]) & 127u)) << (8 * e);
            dec[(c * 4 + q) * 64 + lane] = w; }
    const float PAD = -3.0e38f;
    float c0[16], c1[16], c2[16], c3[16];
#define CAND(i, j) pack_key(L[0][i] + L[1][j], 255u - (unsigned)(16 * (i) + (j)), 255u)
#pragma unroll
    for (int j = 0; j < 16; ++j) c0[j] = CAND(0, j);
#pragma unroll
    for (int j = 0; j < 8; ++j) c1[j] = CAND(1, j);
#pragma unroll
    for (int j = 0; j < 5; ++j) c1[8 + j] = CAND(2, j);
    c1[13] = PAD; c1[14] = PAD; c1[15] = PAD;
#pragma unroll
    for (int j = 0; j < 4; ++j) c2[j] = CAND(3, j);
#pragma unroll
    for (int j = 0; j < 3; ++j) c2[4 + j] = CAND(4, j);
    c2[7] = CAND(5, 0); c2[8] = CAND(5, 1); c2[9] = CAND(6, 0); c2[10] = CAND(6, 1); c2[11] = CAND(7, 0); c2[12] = CAND(7, 1);
    c2[13] = PAD; c2[14] = PAD; c2[15] = PAD;
#pragma unroll
    for (int i = 0; i < 8; ++i) { c3[i] = CAND(8 + i, 0); c3[8 + i] = PAD; }
#undef CAND
    top16_of_64(c0, c1, c2, c3);
    float e[16], sum = 0.f;
#pragma unroll
    for (int k = 0; k < 16; ++k) { e[k] = __builtin_amdgcn_exp2f((c0[k] - c0[0]) * LOG2E); sum += e[k]; }
    const float rs = 1.f / sum;
    LDS_WAIT();
    int ids[16];
#pragma unroll
    for (int k = 0; k < 16; ++k) { const unsigned code = 255u - (__builtin_bit_cast(unsigned, c0[k]) & 255u); const unsigned i = code >> 4, j = code & 15u;
        const unsigned w1 = dec[(i >> 2) * 64 + lane], w2 = dec[(4 + (j >> 2)) * 64 + lane];
        ids[k] = (int)(((w1 >> (8 * (i & 3))) & 127u) * 128u + ((w2 >> (8 * (j & 3))) & 127u)); }
    if (hi == 0) {
        int* ip = idx + (size_t)tok * 128 + h * 16; float* gp = gate + (size_t)tok * 128 + h * 16;
#pragma unroll
        for (int q = 0; q < 4; ++q) { *(int4*)(ip + 4 * q) = make_int4(ids[4 * q], ids[4 * q + 1], ids[4 * q + 2], ids[4 * q + 3]);
            *(f32x4*)(gp + 4 * q) = (f32x4){e[4 * q] * rs, e[4 * q + 1] * rs, e[4 * q + 2] * rs, e[4 * q + 3] * rs}; }
    }
    LDS_WAIT();
}

typedef __bf16 bf2_t __attribute__((ext_vector_type(2)));
DI bf2_t as_bf2(unsigned u) { return __builtin_bit_cast(bf2_t, u); }
DI float dot8(u32x4 a, u32x4 b, float acc) {
    acc = __builtin_amdgcn_fdot2_f32_bf16(as_bf2(a.x), as_bf2(b.x), acc, false);
    acc = __builtin_amdgcn_fdot2_f32_bf16(as_bf2(a.y), as_bf2(b.y), acc, false);
    acc = __builtin_amdgcn_fdot2_f32_bf16(as_bf2(a.z), as_bf2(b.z), acc, false);
    acc = __builtin_amdgcn_fdot2_f32_bf16(as_bf2(a.w), as_bf2(b.w), acc, false);
    return acc;
}
DI void fma8(float (&o)[8], u32x4 v, float w) {
    o[0] += w * bf_lo(v.x); o[1] += w * bf_hi(v.x); o[2] += w * bf_lo(v.y); o[3] += w * bf_hi(v.y);
    o[4] += w * bf_lo(v.z); o[5] += w * bf_hi(v.z); o[6] += w * bf_lo(v.w); o[7] += w * bf_hi(v.w);
}
DI void peer_gather_token(int tok, const bf16_t* hn2, const int* idx, const float* gate, const bf16_t* U, const bf16_t* V,
                          const float* hin, float* hout, const float* ngain, bf16_t* hn_next, float* final_out, int lane) {
    const u32x4 x0 = *(const u32x4*)(hn2 + (size_t)tok * DM + 8 * lane), x1 = *(const u32x4*)(hn2 + (size_t)tok * DM + 512 + 8 * lane);
    const int id0 = idx[(size_t)tok * 128 + lane], id1 = idx[(size_t)tok * 128 + 64 + lane];
    const float g0 = gate[(size_t)tok * 128 + lane], g1 = gate[(size_t)tok * 128 + 64 + lane];
    float act0 = 0.f, act1 = 0.f;
    for (int gidx = 0; gidx < (DBG_SKIP_PEER ? 0 : 16); ++gidx) {
        u32x4 ua[8], ub[8];
#pragma unroll
        for (int s = 0; s < 8; ++s) { const int sl = gidx * 8 + s; const int e = __builtin_amdgcn_readlane(sl < 64 ? id0 : id1, sl & 63);
            const bf16_t* up = U + (size_t)e * DM + 8 * lane; ua[s] = *(const u32x4*)up; ub[s] = *(const u32x4*)(up + 512); }
#pragma unroll
        for (int s = 0; s < 8; ++s) { const int sl = gidx * 8 + s; float d = dot8(ua[s], x0, 0.f); d = dot8(ub[s], x1, d); d = wave_sum(d);
            if (sl < 64) { if (lane == sl) act0 = d; } else { if (lane == sl - 64) act1 = d; } }
    }
    const float w0 = g0 * 0.5f * act0 * (1.f + erff(act0 * 0.70710678118654752f)), w1 = g1 * 0.5f * act1 * (1.f + erff(act1 * 0.70710678118654752f));
    float oa[8] = {0.f, 0.f, 0.f, 0.f, 0.f, 0.f, 0.f, 0.f}, ob[8] = {0.f, 0.f, 0.f, 0.f, 0.f, 0.f, 0.f, 0.f};
    for (int gidx = 0; gidx < (DBG_SKIP_PEER ? 0 : 16); ++gidx) {
        u32x4 va[8], vb[8];
#pragma unroll
        for (int s = 0; s < 8; ++s) { const int sl = gidx * 8 + s; const int e = __builtin_amdgcn_readlane(sl < 64 ? id0 : id1, sl & 63);
            const bf16_t* vp = V + (size_t)e * DM + 8 * lane; va[s] = *(const u32x4*)vp; vb[s] = *(const u32x4*)(vp + 512); }
#pragma unroll
        for (int s = 0; s < 8; ++s) { const int sl = gidx * 8 + s;
            const float w = __builtin_bit_cast(float, __builtin_amdgcn_readlane(__builtin_bit_cast(int, sl < 64 ? w0 : w1), sl & 63));
            fma8(oa, va[s], w); fma8(ob, vb[s], w); }
    }
    const float* hp = hin + (size_t)tok * DM + 8 * lane;
    f32x4 ha0 = *(const f32x4*)hp, ha1 = *(const f32x4*)(hp + 4), hb0 = *(const f32x4*)(hp + 512), hb1 = *(const f32x4*)(hp + 516);
    ha0 += (f32x4){oa[0], oa[1], oa[2], oa[3]}; ha1 += (f32x4){oa[4], oa[5], oa[6], oa[7]}; hb0 += (f32x4){ob[0], ob[1], ob[2], ob[3]}; hb1 += (f32x4){ob[4], ob[5], ob[6], ob[7]};
    float ss = 0.f;
#pragma unroll
    for (int e = 0; e < 4; ++e) ss += ha0[e] * ha0[e] + ha1[e] * ha1[e] + hb0[e] * hb0[e] + hb1[e] * hb1[e];
    const float r = rsqrtf(wave_sum(ss) * (1.f / DM) + NORM_EPS);
    const float* gp = ngain + 8 * lane;
    const f32x4 ga0 = *(const f32x4*)gp, ga1 = *(const f32x4*)(gp + 4), gb0 = *(const f32x4*)(gp + 512), gb1 = *(const f32x4*)(gp + 516);
    if (final_out) {
        float* op = final_out + (size_t)tok * DM + 8 * lane;
        *(f32x4*)op = ha0 * r * ga0; *(f32x4*)(op + 4) = ha1 * r * ga1; *(f32x4*)(op + 512) = hb0 * r * gb0; *(f32x4*)(op + 516) = hb1 * r * gb1;
    } else {
        float* ho = hout + (size_t)tok * DM + 8 * lane;
        *(f32x4*)ho = ha0; *(f32x4*)(ho + 4) = ha1; *(f32x4*)(ho + 512) = hb0; *(f32x4*)(ho + 516) = hb1;
        u32x4 n0, n1;
        n0.x = cvt_pk_bf16(ha0[0] * r * ga0[0], ha0[1] * r * ga0[1]); n0.y = cvt_pk_bf16(ha0[2] * r * ga0[2], ha0[3] * r * ga0[3]);
        n0.z = cvt_pk_bf16(ha1[0] * r * ga1[0], ha1[1] * r * ga1[1]); n0.w = cvt_pk_bf16(ha1[2] * r * ga1[2], ha1[3] * r * ga1[3]);
        n1.x = cvt_pk_bf16(hb0[0] * r * gb0[0], hb0[1] * r * gb0[1]); n1.y = cvt_pk_bf16(hb0[2] * r * gb0[2], hb0[3] * r * gb0[3]);
        n1.z = cvt_pk_bf16(hb1[0] * r * gb1[0], hb1[1] * r * gb1[1]); n1.w = cvt_pk_bf16(hb1[2] * r * gb1[2], hb1[3] * r * gb1[3]);
        *(u32x4*)(hn_next + (size_t)tok * DM + 8 * lane) = n0; *(u32x4*)(hn_next + (size_t)tok * DM + 512 + 8 * lane) = n1;
    }
}

#define PHASE_BEGIN() \
    int tid = threadIdx.x; asm volatile("" : "+v"(tid)); \
    const int lane = tid & 63; const int wave = __builtin_amdgcn_readfirstlane(tid >> 6); \
    unsigned char* ws = p.ws; asm volatile("" : "+s"(ws)); \
    const int gw = vcu * NWAVES + wave, NGW = G * NWAVES; (void)lane; (void)gw; (void)NGW
__global__ void __launch_bounds__(NTHR, 2) fwd_kernel(Params p) {
    extern __shared__ __attribute__((aligned(16))) unsigned char lds_raw[];
    LAS unsigned char* lds = (LAS unsigned char*)lds_raw;
    const int G = gridDim.x; const int bx = blockIdx.x; const int vcu = (G % 8 == 0) ? (bx % 8) * (G / 8) + bx / 8 : bx;
    for (int u = threadIdx.x; u < (LDS_BYTES - RING_BYTES) / 4; u += NTHR) ((LAS unsigned*)(lds + RING_BYTES))[u] = 0u;
    __syncthreads();
    XcdBarrier bar; bar.bar = (unsigned*)(p.ws + WS_CTL) + CW_BAR; bar.x = 0; bar.st = nullptr;
    const int lo = p.ph_lo, hi = p.ph_hi;
    if ((hi - lo) > 1) bar = xcd_barrier_post((unsigned*)(p.ws + WS_CTL) + CW_BAR, (volatile LAS unsigned*)(lds + MISC_OFF) + 8);
    int ph = 0;
#define IN(k) (lo <= (k) && (k) < hi)
#define SEAM() do { if (IN(ph) && IN(ph + 1)) xcd_barrier(bar); ++ph; } while (0)

    if (PH_ON(0) && IN(ph)) {
        PHASE_BEGIN();
        LAS float* scr = (LAS float*)(lds + wave * 16384);
        constexpr int I_IN = 16 * 69, I_UQ = 6 * 24, I_UKV = 4 * 32, I_SQ = 16 * 32, I_CIN = 16 * 64, I_PQ = 16 * 64;
        constexpr int PER2 = I_IN + I_UQ + I_UKV + I_SQ + I_CIN + I_SQ;
        constexpr int NITEMS = 2 * PER2 + 4 * I_PQ;
        for (int it = gw; it < NITEMS; it += NGW) {
            if (it < 2 * PER2) { const int i = it / PER2; int r = it % PER2;
                if (r < I_IN) { transpose_item<0>(p.in[5] + (size_t)i * 1024 * NPROJ, 1024, NPROJ, (bf16_t*)(ws + WS_WIN) + (size_t)i * NPROJP * 1024, scr, r, lane); continue; } r -= I_IN;
                if (r < I_UQ) { transpose_item<0>(p.in[7] + (size_t)i * 384 * 768, 384, 768, (bf16_t*)(ws + WS_WUQ) + (size_t)i * 768 * 384, scr, r, lane); continue; } r -= I_UQ;
                if (r < I_UKV) { transpose_item<0>(p.in[9] + (size_t)i * 256 * 1024, 256, 1024, (bf16_t*)(ws + WS_WUKV) + (size_t)i * 1024 * 256, scr, r, lane); continue; } r -= I_UKV;
                if (r < I_SQ) { transpose_item<0>(p.in[10] + (size_t)i * 1024 * 1024, 1024, 1024, (bf16_t*)(ws + WS_WOUT) + (size_t)i * 1024 * 1024, scr, r, lane); continue; } r -= I_SQ;
                if (r < I_CIN) { transpose_item<1>(p.in[11] + (size_t)i * 1024 * 2048, 1024, 2048, (bf16_t*)(ws + WS_WCIN) + (size_t)i * 2048 * 1024, scr, r, lane); continue; } r -= I_CIN;
                transpose_item<0>(p.in[17] + (size_t)i * 1024 * 1024, 1024, 1024, (bf16_t*)(ws + WS_WCOUT) + (size_t)i * 1024 * 1024, scr, r, lane);
            } else { const int r2 = it - 2 * PER2, l = r2 / I_PQ, r = r2 % I_PQ;
                transpose_item<0>(p.in[19] + (size_t)l * 1024 * 2048, 1024, 2048, (bf16_t*)(ws + WS_WPQ) + (size_t)l * 2048 * 1024, scr, r, lane); }
        }
        { const size_t gt = (size_t)vcu * NTHR + tid, NGT = (size_t)G * NTHR;
          const size_t n_sub = (size_t)4 * 8 * 2 * 128 * 128 / 8, n_tab = (size_t)4 * 16384 * 1024 / 8;
          for (size_t i = gt; i < n_sub + 2 * n_tab; i += NGT) {
              const float* src; bf16_t* dst; size_t j;
              if (i < n_sub) { src = p.in[20]; dst = (bf16_t*)(ws + WS_SUBK); j = i; }
              else if (i < n_sub + n_tab) { src = p.in[21]; dst = (bf16_t*)(ws + WS_U16); j = i - n_sub; }
              else { src = p.in[22]; dst = (bf16_t*)(ws + WS_V16); j = i - n_sub - n_tab; }
              const f32x4 a = *(const f32x4*)(src + j * 8), b = *(const f32x4*)(src + j * 8 + 4);
              u32x4 o; o.x = cvt_pk_bf16(a[0], a[1]); o.y = cvt_pk_bf16(a[2], a[3]); o.z = cvt_pk_bf16(b[0], b[1]); o.w = cvt_pk_bf16(b[2], b[3]);
              *(u32x4*)(dst + j * 8) = o; } }
        { const int* positions = (const int*)p.in[1];
          float* cosr = (float*)(ws + WS_COSR); float* sinr = (float*)(ws + WS_SINR); float* cosm = (float*)(ws + WS_COSM); float* sinm = (float*)(ws + WS_SINM);
          const int gt = vcu * NTHR + tid, NGT = G * NTHR;
          for (int k = 0; k < 48; ++k) { const double inv = (k < 16) ? p.inv_r[k & 15] : p.inv_m[(k - 16) & 31];
              for (int row = gt; row < TT; row += NGT) { double rev = (double)positions[row] * inv * 0.15915494309189533577; rev -= floor(rev);
                  const float rf = (float)rev; const float c = __builtin_amdgcn_cosf(rf), sn = __builtin_amdgcn_sinf(rf);
                  if (k < 16) { cosr[row * 16 + k] = c; sinr[row * 16 + k] = sn; } else { cosm[row * 32 + (k - 16)] = c; sinm[row * 32 + (k - 16)] = sn; } } } }
        for (int m = gw; m < TT; m += NGW) rms_row_to_bf16(p.in[0] + (size_t)m * DM, p.in[2], (bf16_t*)(ws + WS_HN) + (size_t)m * DM, lane);
    }
    SEAM();

    for (int layer = 0; layer < 4; ++layer) {
        const int li = layer >> 1;
        if ((layer & 1) == 0) {
            if (PH_ON(1) && IN(ph)) { PHASE_BEGIN();
                pg8::Gemm g{(const bf16_t*)(ws + WS_HN), (const bf16_t*)(ws + WS_WIN) + (size_t)li * NPROJP * 1024, TT, NPROJP, 1024}; pg8::StaticOrder S; S.init(TT, NPROJP, G, bx);
                EpiPlain E{(bf16_t*)(ws + WS_PROJ), NPROJP}; pg8::gemm_phase<EpiPlain, pg8::StaticOrder, true, true>(lds, g, S, E); }
            SEAM();
            if (PH_ON(2) && IN(ph)) { PHASE_BEGIN();
                for (int u = vcu; u < TT / 64; u += G)
                    token_prep_unit(lds, u, (const bf16_t*)(ws + WS_PROJ), p.in[6] + li * 384, p.in[8] + li * 256, (const float*)(ws + WS_COSR), (const float*)(ws + WS_SINR), (const float*)(ws + WS_COSM), (const float*)(ws + WS_SINM),
                                    (bf16_t*)(ws + WS_CQN), (bf16_t*)(ws + WS_CKVN), (bf16_t*)(ws + WS_KM), (bf16_t*)(ws + WS_MQ), (bf16_t*)(ws + WS_MK), (float*)(ws + WS_KPART), wave, lane); }
            SEAM();
            if (PH_ON(3) && IN(ph)) { PHASE_BEGIN();
#if !defined(E3_SKIP_A)
                { pg8::Gemm g{(const bf16_t*)(ws + WS_CQN), (const bf16_t*)(ws + WS_WUQ) + (size_t)li * 768 * 384, TT, 768, 384}; pg8::StaticOrder S; S.init(TT, 768, G, bx);
                  EpiQup E{(bf16_t*)(ws + WS_QM), (const float*)(ws + WS_COSR), (const float*)(ws + WS_SINR), 0.10206207261596577f * LOG2E}; pg8::gemm_phase<EpiQup, pg8::StaticOrder, true, true>(lds, g, S, E); }
#endif
#if !defined(E3_SKIP_B)
                { pg8::Gemm g{(const bf16_t*)(ws + WS_CKVN), (const bf16_t*)(ws + WS_WUKV) + (size_t)li * 1024 * 256, TT, 1024, 256}; pg8::StaticOrder S; S.init(TT, 1024, G, bx);
                  EpiKVup E{(bf16_t*)(ws + WS_KM), (bf16_t*)(ws + WS_VM)}; pg8::gemm_phase<EpiKVup, pg8::StaticOrder, true, true>(lds, g, S, E); }
#endif
            }
            SEAM();
            if (PH_ON(4) && IN(ph)) { PHASE_BEGIN();
                bf16_t* QM = (bf16_t*)(ws + WS_QM); bf16_t* KM = (bf16_t*)(ws + WS_KM); bf16_t* VM = (bf16_t*)(ws + WS_VM); bf16_t* MQ = (bf16_t*)(ws + WS_MQ); bf16_t* MK = (bf16_t*)(ws + WS_MK);
                bf16_t* OB = (bf16_t*)(ws + WS_OB); const bf16_t* PROJ = (const bf16_t*)(ws + WS_PROJ); const float* kpart = (const float*)(ws + WS_KPART);
                for (int v = vcu; v < 256; v += G) { const int bh = v >> 4, s = v & 15, b = bh >> 3, h = bh & 7; const size_t rb = (size_t)b * SEQ;
                    for (int k = 0; k < 2; ++k) { const int qb = k ? 31 - s : s;
                        attn_unit<96, false>(lds, QM + rb * 768 + h * 96, 768, KM + rb * 768 + h * 96, 768, VM + rb * 512 + h * 64, 512, OB + rb * 1024 + h * 64, 1024, qb, nullptr);
                        attn_unit<64, true>(lds, MQ + rb * 512 + h * 64, 512, MK + rb * 512 + h * 64, 512, PROJ + rb * NPROJP + 1696 + h * 64, NPROJP, OB + rb * 1024 + 512 + h * 64, 1024, qb,
                                            kpart + (size_t)b * 32 * 4 * 512 + h * 64); } }
            }
            SEAM();
            if (PH_ON(5) && IN(ph)) { PHASE_BEGIN();
                pg8::Gemm g{(const bf16_t*)(ws + WS_OB), (const bf16_t*)(ws + WS_WOUT) + (size_t)li * 1024 * 1024, TT, 1024, 1024}; pg8::StaticOrder S; S.init(TT, 1024, G, bx);
                EpiResid E{layer == 0 ? p.in[0] : (const float*)(ws + WS_H1), (float*)(ws + WS_H0), nullptr, DBG_SKIP_ATTN}; pg8::gemm_phase<EpiResid, pg8::StaticOrder, true, true>(lds, g, S, E); }
            SEAM();
        } else {
            if (PH_ON(6) && IN(ph)) { PHASE_BEGIN();
                pg8::Gemm g{(const bf16_t*)(ws + WS_HN), (const bf16_t*)(ws + WS_WCIN) + (size_t)li * 2048 * 1024, TT, 2048, 1024}; pg8::StaticOrder S; S.init(TT, 2048, G, bx);
                EpiGlu E{(bf16_t*)(ws + WS_UG), p.in[12] + li * 2048}; pg8::gemm_phase<EpiGlu, pg8::StaticOrder, true, true>(lds, g, S, E); }
            SEAM();
            if (PH_ON(7) && IN(ph)) { PHASE_BEGIN();
                float w[31][2];
                const float* wd = p.in[13] + (size_t)li * 31 * 1024;
#pragma unroll
                for (int j = 0; j < 31; ++j) { const f32x2 t2 = *(const f32x2*)(wd + j * 1024 + 2 * tid); w[j][0] = t2.x; w[j][1] = t2.y; }
                const f32x2 bb = *(const f32x2*)(p.in[14] + li * 1024 + 2 * tid), gg = *(const f32x2*)(p.in[15] + li * 1024 + 2 * tid), be = *(const f32x2*)(p.in[16] + li * 1024 + 2 * tid);
                for (int u = vcu; u < TT / 16; u += G) dwconv_unit(lds, u, (const bf16_t*)(ws + WS_UG), w, bb.x, bb.y, gg.x, gg.y, be.x, be.y, (bf16_t*)(ws + WS_YB), tid);
            }
            SEAM();
            if (PH_ON(8) && IN(ph)) { PHASE_BEGIN();
                pg8::Gemm g{(const bf16_t*)(ws + WS_YB), (const bf16_t*)(ws + WS_WCOUT) + (size_t)li * 1024 * 1024, TT, 1024, 1024}; pg8::StaticOrder S; S.init(TT, 1024, G, bx);
                EpiResid E{(const float*)(ws + WS_H1), (float*)(ws + WS_H0), p.in[18] + li * 1024, DBG_SKIP_CONV}; pg8::gemm_phase<EpiResid, pg8::StaticOrder, true, true>(lds, g, S, E); }
            SEAM();
        }
        if (PH_ON(9) && IN(ph)) { PHASE_BEGIN();
            for (int m = gw; m < TT; m += NGW) rms_row_to_bf16((const float*)(ws + WS_H0) + (size_t)m * DM, p.in[3] + layer * DM, (bf16_t*)(ws + WS_HN) + (size_t)m * DM, lane); }
        SEAM();
        if (PH_ON(10) && IN(ph)) { PHASE_BEGIN();
            pg8::Gemm g{(const bf16_t*)(ws + WS_HN), (const bf16_t*)(ws + WS_WPQ) + (size_t)layer * 2048 * 1024, TT, 2048, 1024}; pg8::StaticOrder S; S.init(TT, 2048, G, bx);
            EpiPlain E{(bf16_t*)(ws + WS_Q2), 2048}; pg8::gemm_phase<EpiPlain, pg8::StaticOrder, true, true>(lds, g, S, E); }
        SEAM();
        if (PH_ON(11) && IN(ph)) { PHASE_BEGIN();
            const bf16_t* subk = (const bf16_t*)(ws + WS_SUBK) + (size_t)layer * 8 * 2 * 128 * 128;
            LAS unsigned* dec = (LAS unsigned*)(lds + 65536 + wave * 2048);
            for (int v = vcu; v < 256; v += G) { const int h = v & 7, tg = v >> 3;
                for (int e = tid; e < 2 * 128 * 16; e += NTHR) { const int c = e >> 11, key = (e >> 4) & 127, ch = e & 15;
                    *(LAS u32x4*)(lds + c * 32768 + ch * 2048 + key * 16) = *(const u32x4*)(subk + ((size_t)(h * 2 + c) * 128 + key) * 128 + ch * 8); }
                __syncthreads();
                for (int i = 0; i < 2; ++i) peer_topk_unit(lds, dec, (const bf16_t*)(ws + WS_Q2), tg * 16 + wave * 2 + i, h, (int*)(ws + WS_IDX), (float*)(ws + WS_GATE), lane);
                __syncthreads();
            }
        }
        SEAM();
        if (PH_ON(12) && IN(ph)) { PHASE_BEGIN();
            const bf16_t* U = (const bf16_t*)(ws + WS_U16) + (size_t)layer * 16384 * 1024; const bf16_t* V = (const bf16_t*)(ws + WS_V16) + (size_t)layer * 16384 * 1024;
            const bool lastl = (layer == 3);
            const float* ng = lastl ? p.in[4] : p.in[2] + (layer + 1) * DM;
            for (int tok = gw; tok < TT; tok += NGW)
                peer_gather_token(tok, (const bf16_t*)(ws + WS_HN), (const int*)(ws + WS_IDX), (const float*)(ws + WS_GATE), U, V, (const float*)(ws + WS_H0), (float*)(ws + WS_H1), ng,
                                  (bf16_t*)(ws + WS_HN), lastl ? p.out : nullptr, lane);
        }
        SEAM();
    }
#undef IN
#undef SEAM
}

extern "C" void kernel_launch(void* const* d_in, const int* in_sizes, int n_in, void* d_out, int out_size, void* d_ws, size_t ws_size, hipStream_t stream) {
    static int grid = 0;
    if (grid == 0) {
        if (n_in != 23 || out_size != TT * DM || ws_size < WS_END) { fprintf(stderr, "kernel_launch: unexpected shapes (n_in %d out %d ws %zu)\n", n_in, out_size, ws_size); grid = -1; return; }
        int dev = 0, cus = 0, per_cu = 0;
        if (hipGetDevice(&dev) != hipSuccess || hipDeviceGetAttribute(&cus, hipDeviceAttributeMultiprocessorCount, dev) != hipSuccess) { grid = -1; return; }
        if (hipFuncSetAttribute((const void*)fwd_kernel, hipFuncAttributeMaxDynamicSharedMemorySize, LDS_BYTES) != hipSuccess) { fprintf(stderr, "kernel_launch: hipFuncSetAttribute failed\n"); grid = -1; return; }
        if (hipOccupancyMaxActiveBlocksPerMultiprocessor(&per_cu, (const void*)fwd_kernel, NTHR, LDS_BYTES) != hipSuccess || per_cu < 1) fprintf(stderr, "kernel_launch: occupancy query says %d\n", per_cu);
        (void)hipGetLastError();
        grid = cus;
    }
    if (grid < 0) return;
    (void)hipMemsetAsync((char*)d_ws + WS_CTL, 0, CTL_ZERO_BYTES, stream);
    Params p;
    memset(&p, 0, sizeof(p));
    for (int i = 0; i < 23; ++i) p.in[i] = (const float*)d_in[i];
    p.out = (float*)d_out; p.ws = (unsigned char*)d_ws;
    for (int k = 0; k < 16; ++k) p.inv_r[k] = pow(10000.0, -(double)(2 * k) / 32.0);
    for (int k = 0; k < 32; ++k) p.inv_m[k] = pow(10000.0, -(double)(2 * k) / 64.0);
#if MK_ONE_LAUNCH
    p.ph_lo = 0; p.ph_hi = 1000;
    hipLaunchKernelGGL(fwd_kernel, dim3(grid), dim3(NTHR), LDS_BYTES, stream, p);
#else
    for (int k = 0; k < 33; ++k) { p.ph_lo = k; p.ph_hi = k + 1; hipLaunchKernelGGL(fwd_kernel, dim3(grid), dim3(NTHR), LDS_BYTES, stream, p); }
#endif
}
```

```cpp
#include <hip/hip_runtime.h>
#include <cstdio>
#include <cstdint>
#include <cstring>
#include <cmath>

#ifndef PHMASK
#define PHMASK 0xFFFF
#endif
#define PH_ON(n) ((PHMASK >> (n)) & 1)
#ifndef DBG_SKIP_ATTN
#define DBG_SKIP_ATTN 0
#endif
#ifndef DBG_SKIP_CONV
#define DBG_SKIP_CONV 0
#endif
#ifndef DBG_SKIP_PEER
#define DBG_SKIP_PEER 0
#endif
#ifndef MK_ONE_LAUNCH
#define MK_ONE_LAUNCH 1
#endif

#define LAS __attribute__((address_space(3)))
#define GAS __attribute__((address_space(1)))
typedef unsigned short bf16_t;
typedef short bf16x8 __attribute__((ext_vector_type(8)));
typedef short s16x4 __attribute__((ext_vector_type(4)));
typedef short v4i16_t __attribute__((ext_vector_type(4)));
typedef float f32x2 __attribute__((ext_vector_type(2)));
typedef float f32x4 __attribute__((ext_vector_type(4)));
typedef float f32x16 __attribute__((ext_vector_type(16)));
typedef unsigned u32x2 __attribute__((ext_vector_type(2)));
typedef unsigned u32x4 __attribute__((ext_vector_type(4)));
#define DI __device__ __forceinline__

constexpr int TT = 16384, SEQ = 8192, DM = 1024;
constexpr int NPROJ = 2208, NPROJP = 2304;
constexpr float NORM_EPS = 1e-6f;
constexpr float LOG2E = 1.4426950408889634f;
constexpr int NWAVES = 8, NTHR = 512;

constexpr size_t MiB = 1u << 20;
constexpr size_t WS_CTL = 0, CTL_ZERO_BYTES = 1 * MiB;
constexpr size_t WS_COSR = 2 * MiB, WS_SINR = 3 * MiB, WS_COSM = 4 * MiB, WS_SINM = 6 * MiB;
constexpr size_t WS_KPART = 8 * MiB;
constexpr size_t WS_WIN = 10 * MiB;
constexpr size_t WS_WUQ = 19 * MiB;
constexpr size_t WS_WUKV = 21 * MiB;
constexpr size_t WS_WOUT = 22 * MiB;
constexpr size_t WS_WCIN = 26 * MiB;
constexpr size_t WS_WCOUT = 34 * MiB;
constexpr size_t WS_WPQ = 38 * MiB;
constexpr size_t WS_SUBK = 54 * MiB;
constexpr size_t WS_U16 = 64 * MiB;
constexpr size_t WS_V16 = 192 * MiB;
constexpr size_t WS_H0 = 320 * MiB;
constexpr size_t WS_H1 = 384 * MiB;
constexpr size_t WS_HN = 448 * MiB;
constexpr size_t WS_PROJ = 480 * MiB;
constexpr size_t WS_CQN = 552 * MiB;
constexpr size_t WS_CKVN = 564 * MiB;
constexpr size_t WS_QM = 572 * MiB;
constexpr size_t WS_KM = 596 * MiB;
constexpr size_t WS_VM = 620 * MiB;
constexpr size_t WS_MQ = 636 * MiB;
constexpr size_t WS_MK = 652 * MiB;
constexpr size_t WS_OB = 668 * MiB;
constexpr size_t WS_Q2 = 700 * MiB;
constexpr size_t WS_IDX = 764 * MiB;
constexpr size_t WS_GATE = 772 * MiB;
constexpr size_t WS_UG = 780 * MiB;
constexpr size_t WS_YB = 812 * MiB;
constexpr size_t WS_END = 844 * MiB;
constexpr int CW_BAR = 4096;

constexpr int RING_BYTES = 131072;
constexpr int MISC_OFF = RING_BYTES + 320;
constexpr int LDS_BYTES = 147456;

DI unsigned cvt_pk_bf16(float lo, float hi) { unsigned r; asm volatile("v_cvt_pk_bf16_f32 %0, %1, %2" : "=v"(r) : "v"(lo), "v"(hi)); return r; }
DI float bf_lo(unsigned u) { return __builtin_bit_cast(float, u << 16); }
DI float bf_hi(unsigned u) { return __builtin_bit_cast(float, u & 0xffff0000u); }
DI float bf1(bf16_t b) { return __builtin_bit_cast(float, ((unsigned)b) << 16); }
DI float wave_sum(float v) {
#pragma unroll
    for (int o = 1; o < 64; o <<= 1) v += __shfl_xor(v, o);
    return v;
}
#define LDS_WAIT() asm volatile("s_waitcnt lgkmcnt(0)" ::: "memory")

namespace pg8 {
constexpr int BM = 256, BK = 64, HALF = 128, HTB = HALF * BK * 2, STAGE_BYTES = 8 * HTB, NXCD = 8, WGM = 8;
__host__ __device__ __forceinline__ int lds_byte(int r, int c) { const int st = (r >> 4) * 2 + (c >> 5), rr = r & 15, cc = c & 31, ob = rr * 64 + cc * 2; return st * 1024 + (ob ^ (((ob >> 9) & 1) << 5)); }
__host__ __device__ __forceinline__ void stage_rc(int b, int& R, int& C) { const int st = b / 1024, sb = b % 1024, swz = sb ^ (((sb >> 9) & 1) << 5); R = (st >> 1) * 16 + swz / 64; C = (st & 1) * 32 + (swz % 64) / 2; }
__host__ __device__ __forceinline__ int perm32(int rho) { const int n = rho >> 4, i = rho & 15; return 8 * (i >> 2) + 4 * n + (i & 3); }
struct Unit { int pm, pn; };
struct Gemm { const bf16_t* A; const bf16_t* Bt; int M, N, K; };
struct StaticOrder {
    int nM, nN, nwg, G, c;
    __host__ __device__ void init(int M, int N, int G_, int c_) { nM = M / BM; nN = N / BM; nwg = nM * nN; G = G_; c = c_; }
    __host__ __device__ bool next(int i, Unit& u) const {
        const long L = (long)i * G + c; if (L >= nwg) return false;
        int wgid = (int)L; { const int q = nwg / NXCD, r = nwg % NXCD, xcd = wgid % NXCD, off = wgid / NXCD; wgid = (xcd < r ? xcd * (q + 1) : r * (q + 1) + (xcd - r) * q) + off; }
        const int nig = WGM * nN, gid = wgid / nig, fm = gid * WGM, gsz = (nM - fm) < WGM ? (nM - fm) : WGM;
        u.pm = fm + ((wgid % nig) % gsz); u.pn = (wgid % nig) / gsz; return true;
    }
    __device__ __forceinline__ void a_ready(const Unit&) const {}
    __device__ __forceinline__ void done(const Unit&) const {}
};
template <class Epi, class Sched, bool ALIGN_EPI = false, bool SP2 = false>
__device__ __forceinline__ void gemm_phase(LAS unsigned char* lds, const Gemm g, const Sched& S, const Epi& E) {
    int tid_o = threadIdx.x; asm volatile("" : "+v"(tid_o));
    const int tid = tid_o, wid = __builtin_amdgcn_readfirstlane(tid >> 6), lane = tid & 63, wr = wid >> 2, wc = wid & 3, fr = lane & 15, fq = lane >> 4;
    const int K = g.K, nt = K / BK;
    unsigned voffA[2], voffB[2];
#pragma unroll
    for (int i = 0; i < 2; ++i) { int R, C; stage_rc(tid * 16 + i * 8192, R, C); const int Rb = Epi::PERM ? ((R & ~31) + perm32(R & 31)) : R;
        voffA[i] = (unsigned)(R * K + C) * 2u; voffB[i] = (unsigned)(Rb * K + C) * 2u; }
    const size_t kstep = (size_t)(BK * 2);
    const size_t hstep = (size_t)HALF * K * 2;
    const size_t tstep = 2 * hstep;
    const unsigned ldsw = (unsigned)wid * 1024u;
    const int aoff = lds_byte(wr * 64 + fr, fq * 8), boff = lds_byte(wc * 32 + fr, fq * 8);
#define PG8_SA(b, h) (((b) * 2 + (h)) * HTB)
#define PG8_SB(b, h) ((4 + (b) * 2 + (h)) * HTB)
#define PG8_STAGE(bufoff, gbase, voff) do { _Pragma("unroll") for (int _i = 0; _i < 2; ++_i) \
        __builtin_amdgcn_global_load_lds((const unsigned*)((const char*)(gbase) + (voff)[_i]), (LAS unsigned*)(lds + (bufoff) + ldsw + _i * 8192), 16, 0, 0); } while (0)
#define PG8_LDA(dst, b, h) do { _Pragma("unroll") for (int m = 0; m < 4; ++m) _Pragma("unroll") for (int k = 0; k < 2; ++k) dst[m][k] = *(const LAS bf16x8*)(lds + PG8_SA(b, h) + aoff + m * 2048 + k * 1024); } while (0)
#define PG8_LDB(dst, b, h) do { _Pragma("unroll") for (int n = 0; n < 2; ++n) _Pragma("unroll") for (int k = 0; k < 2; ++k) dst[n][k] = *(const LAS bf16x8*)(lds + PG8_SB(b, h) + boff + n * 2048 + k * 1024); } while (0)
#define PG8_MMA(ai, bj, At, Bt) do { __builtin_amdgcn_s_setprio(1); _Pragma("unroll") for (int m = 0; m < 4; ++m) _Pragma("unroll") for (int n = 0; n < 2; ++n) _Pragma("unroll") for (int k = 0; k < 2; ++k) \
        acc[ai][bj][m][n] = __builtin_amdgcn_mfma_f32_16x16x32_bf16(Bt[n][k], At[m][k], acc[ai][bj][m][n], 0, 0, 0); __builtin_amdgcn_s_setprio(0); } while (0)
#define PG8_WAIT_V(n) asm volatile("s_waitcnt vmcnt(" #n ")" ::: "memory")
#define PG8_WAIT_L(n) asm volatile("s_waitcnt lgkmcnt(" #n ")" ::: "memory")
#define PG8_BAR __builtin_amdgcn_s_barrier()
#define PG8_SCHED __builtin_amdgcn_sched_barrier(0)
    Unit cur, nxt; int ui = 0;
    if (!S.next(0, cur)) return;
    f32x4 acc[2][2][4][2];
#pragma unroll
    for (int a = 0; a < 2; ++a)
#pragma unroll
        for (int b = 0; b < 2; ++b)
#pragma unroll
            for (int m = 0; m < 4; ++m)
#pragma unroll
                for (int n = 0; n < 2; ++n) acc[a][b][m][n] = (f32x4){0.f, 0.f, 0.f, 0.f};
    bf16x8 At[4][2], B0[2][2], B1[2][2];
    const char* cA = (const char*)g.A + (size_t)cur.pm * tstep; const char* cB = (const char*)g.Bt + (size_t)cur.pn * tstep;
    S.a_ready(cur);
    if constexpr (SP2) {
        PG8_STAGE(PG8_SB(0, 0), cB, voffB); PG8_STAGE(PG8_SB(0, 1), cB + hstep, voffB); PG8_STAGE(PG8_SA(0, 0), cA, voffA); PG8_STAGE(PG8_SA(0, 1), cA + hstep, voffA);
        if (wr == 1) PG8_BAR;
        PG8_WAIT_V(2); PG8_BAR;
        PG8_STAGE(PG8_SB(1, 0), cB + kstep, voffB); PG8_STAGE(PG8_SA(1, 0), cA + kstep, voffA); PG8_STAGE(PG8_SB(1, 1), cB + hstep + kstep, voffB);
        PG8_WAIT_V(6); PG8_BAR;
    } else {
        PG8_STAGE(PG8_SB(0, 0), cB, voffB); PG8_STAGE(PG8_SA(0, 0), cA, voffA); PG8_STAGE(PG8_SB(0, 1), cB + hstep, voffB); PG8_STAGE(PG8_SA(0, 1), cA + hstep, voffA);
        if (wr == 1) PG8_BAR;
        PG8_WAIT_V(4); PG8_BAR;
        PG8_STAGE(PG8_SB(1, 0), cB + kstep, voffB); PG8_STAGE(PG8_SA(1, 0), cA + kstep, voffA); PG8_STAGE(PG8_SB(1, 1), cB + hstep + kstep, voffB);
        PG8_WAIT_V(6); PG8_BAR;
    }
    for (;;) {
        const bool has_next = S.next(ui + 1, nxt);
        const char* nA = has_next ? (const char*)g.A + (size_t)nxt.pm * tstep : cA; const char* nB = has_next ? (const char*)g.Bt + (size_t)nxt.pn * tstep : cB;
#pragma nounroll
        for (int t = 0; t < nt; t += 2) {
            const bool last = (t == nt - 2);
            const char* a1 = cA + (size_t)(t + 1) * kstep;
            const char* a2 = last ? nA : cA + (size_t)(t + 2) * kstep; const char* b2 = last ? nB : cB + (size_t)(t + 2) * kstep;
            const char* a3 = a2 + kstep; const char* b3 = b2 + kstep;
            if (last && has_next) S.a_ready(nxt);
            if constexpr (SP2) {
            PG8_LDB(B0, 0, 0); PG8_LDB(B1, 0, 1); PG8_SCHED; PG8_LDA(At, 0, 0); PG8_STAGE(PG8_SA(1, 1), a1 + hstep, voffA);
            PG8_WAIT_V(8); PG8_WAIT_L(0); PG8_BAR; PG8_MMA(0, 0, At, B0); PG8_MMA(0, 1, At, B1); PG8_BAR; PG8_SCHED;
            PG8_LDA(At, 0, 1); PG8_STAGE(PG8_SB(0, 0), b2, voffB); PG8_STAGE(PG8_SB(0, 1), b2 + hstep, voffB); PG8_STAGE(PG8_SA(0, 0), a2, voffA);
            PG8_WAIT_V(8); PG8_WAIT_L(0); PG8_BAR; PG8_MMA(1, 0, At, B0); PG8_MMA(1, 1, At, B1); PG8_BAR; PG8_SCHED;
            PG8_LDB(B0, 1, 0); PG8_LDB(B1, 1, 1); PG8_SCHED; PG8_LDA(At, 1, 0); PG8_STAGE(PG8_SA(0, 1), a2 + hstep, voffA);
            PG8_WAIT_V(8); PG8_WAIT_L(0); PG8_BAR; PG8_MMA(0, 0, At, B0); PG8_MMA(0, 1, At, B1); PG8_BAR; PG8_SCHED;
            PG8_LDA(At, 1, 1); PG8_STAGE(PG8_SB(1, 0), b3, voffB); PG8_STAGE(PG8_SB(1, 1), b3 + hstep, voffB); PG8_STAGE(PG8_SA(1, 0), a3, voffA);
            PG8_WAIT_V(8); PG8_WAIT_L(0); PG8_BAR; PG8_MMA(1, 0, At, B0); PG8_MMA(1, 1, At, B1); PG8_BAR; PG8_SCHED;
            } else {
            PG8_LDB(B0, 0, 0); PG8_SCHED; PG8_LDA(At, 0, 0); PG8_STAGE(PG8_SA(1, 1), a1 + hstep, voffA);
            PG8_WAIT_L(8); PG8_BAR; PG8_WAIT_L(0); PG8_MMA(0, 0, At, B0); PG8_BAR; PG8_SCHED;
            PG8_LDB(B1, 0, 1); PG8_STAGE(PG8_SB(0, 0), b2, voffB);
            PG8_BAR; PG8_WAIT_L(0); PG8_MMA(0, 1, At, B1); PG8_BAR;
            PG8_LDA(At, 0, 1); PG8_STAGE(PG8_SA(0, 0), a2, voffA);
            PG8_BAR; PG8_WAIT_L(0); PG8_MMA(1, 0, At, B0); PG8_BAR; PG8_SCHED;
            PG8_STAGE(PG8_SB(0, 1), b2 + hstep, voffB);
            PG8_WAIT_V(6); PG8_BAR; PG8_MMA(1, 1, At, B1); PG8_BAR;
            PG8_LDB(B0, 1, 0); PG8_SCHED; PG8_LDA(At, 1, 0); PG8_STAGE(PG8_SA(0, 1), a2 + hstep, voffA);
            PG8_WAIT_L(8); PG8_BAR; PG8_WAIT_L(0); PG8_MMA(0, 0, At, B0); PG8_BAR; PG8_SCHED;
            PG8_LDB(B1, 1, 1); PG8_STAGE(PG8_SB(1, 0), b3, voffB);
            PG8_BAR; PG8_WAIT_L(0); PG8_MMA(0, 1, At, B1); PG8_BAR;
            PG8_LDA(At, 1, 1); PG8_STAGE(PG8_SA(1, 0), a3, voffA);
            PG8_BAR; PG8_WAIT_L(0); PG8_MMA(1, 0, At, B0); PG8_BAR; PG8_SCHED;
            PG8_STAGE(PG8_SB(1, 1), b3 + hstep, voffB);
            PG8_WAIT_V(6); PG8_BAR; PG8_MMA(1, 1, At, B1); PG8_BAR;
            }
        }
        if constexpr (ALIGN_EPI) { if (wr == 0) PG8_BAR; }
        E(acc, cur, wr, wc, fr, fq); S.done(cur);
        if (!has_next) break;
#pragma unroll
        for (int a = 0; a < 2; ++a)
#pragma unroll
            for (int b = 0; b < 2; ++b)
#pragma unroll
                for (int m = 0; m < 4; ++m)
#pragma unroll
                    for (int n = 0; n < 2; ++n) acc[a][b][m][n] = (f32x4){0.f, 0.f, 0.f, 0.f};
        cur = nxt; cA = nA; cB = nB; ++ui;
        if constexpr (ALIGN_EPI) { if (wr == 1) PG8_BAR; }
    }
    PG8_WAIT_V(0);
    if constexpr (!ALIGN_EPI) { if (wr == 0) PG8_BAR; }
    PG8_BAR;
#undef PG8_SA
#undef PG8_SB
#undef PG8_STAGE
#undef PG8_LDA
#undef PG8_LDB
#undef PG8_MMA
#undef PG8_WAIT_V
#undef PG8_WAIT_L
#undef PG8_BAR
#undef PG8_SCHED
}
}
typedef f32x4 AccT[2][2][4][2];

struct EpiPlain {
    static constexpr bool PERM = true;
    bf16_t* O; int ldc;
    DI void operator()(const AccT& acc, const pg8::Unit& u, int wr, int wc, int fr, int fq) const {
        const int row0 = u.pm * 256 + wr * 64 + fr, col0 = u.pn * 256 + wc * 32 + 8 * fq;
#pragma unroll
        for (int ai = 0; ai < 2; ++ai)
#pragma unroll
            for (int m = 0; m < 4; ++m) { bf16_t* rowp = O + (size_t)(row0 + ai * 128 + m * 16) * ldc + col0;
#pragma unroll
                for (int bj = 0; bj < 2; ++bj) { const f32x4 v0 = acc[ai][bj][m][0], v1 = acc[ai][bj][m][1];
                    u32x4 w; w.x = cvt_pk_bf16(v0[0], v0[1]); w.y = cvt_pk_bf16(v0[2], v0[3]); w.z = cvt_pk_bf16(v1[0], v1[1]); w.w = cvt_pk_bf16(v1[2], v1[3]);
                    *(u32x4*)(rowp + bj * 128) = w; } }
    }
};
struct EpiResid {
    static constexpr bool PERM = true;
    const float* Hin; float* Hout; const float* bias; int zero;
    DI void operator()(const AccT& acc, const pg8::Unit& u, int wr, int wc, int fr, int fq) const {
        const int row0 = u.pm * 256 + wr * 64 + fr, col0 = u.pn * 256 + wc * 32 + 8 * fq;
        f32x4 bv[2][2];
#pragma unroll
        for (int bj = 0; bj < 2; ++bj)
#pragma unroll
            for (int n = 0; n < 2; ++n) bv[bj][n] = bias ? *(const f32x4*)(bias + col0 + bj * 128 + 4 * n) : (f32x4){0.f, 0.f, 0.f, 0.f};
#pragma unroll
        for (int ai = 0; ai < 2; ++ai)
#pragma unroll
            for (int m = 0; m < 4; ++m) { const size_t ro = (size_t)(row0 + ai * 128 + m * 16) * DM + col0;
#pragma unroll
                for (int bj = 0; bj < 2; ++bj)
#pragma unroll
                    for (int n = 0; n < 2; ++n) { const f32x4 hin = *(const f32x4*)(Hin + ro + bj * 128 + 4 * n);
                        *(f32x4*)(Hout + ro + bj * 128 + 4 * n) = zero ? hin : (hin + acc[ai][bj][m][n] + bv[bj][n]); } }
    }
};
struct EpiGlu {
    static constexpr bool PERM = true;
    bf16_t* O; const float* bias;
    DI void operator()(const AccT& acc, const pg8::Unit& u, int wr, int wc, int fr, int fq) const {
        const int row0 = u.pm * 256 + wr * 64 + fr, col0 = u.pn * 128 + wc * 32 + 8 * fq;
        f32x4 bu[2], bg[2];
#pragma unroll
        for (int n = 0; n < 2; ++n) { bu[n] = *(const f32x4*)(bias + col0 + 4 * n); bg[n] = *(const f32x4*)(bias + 1024 + col0 + 4 * n); }
#pragma unroll
        for (int ai = 0; ai < 2; ++ai)
#pragma unroll
            for (int m = 0; m < 4; ++m) { bf16_t* rowp = O + (size_t)(row0 + ai * 128 + m * 16) * DM + col0;
                float r[8];
#pragma unroll
                for (int n = 0; n < 2; ++n)
#pragma unroll
                    for (int e = 0; e < 4; ++e) { const float uu = acc[ai][0][m][n][e] + bu[n][e], gg = acc[ai][1][m][n][e] + bg[n][e];
                        r[4 * n + e] = uu / (1.f + __expf(-gg)); }
                u32x4 w; w.x = cvt_pk_bf16(r[0], r[1]); w.y = cvt_pk_bf16(r[2], r[3]); w.z = cvt_pk_bf16(r[4], r[5]); w.w = cvt_pk_bf16(r[6], r[7]);
                *(u32x4*)rowp = w; }
    }
};
struct EpiQup {
    static constexpr bool PERM = true;
    bf16_t* O; const float* cosr; const float* sinr; float qscale;
    DI void operator()(const AccT& acc, const pg8::Unit& u, int wr, int wc, int fr, int fq) const {
        const int row0 = u.pm * 256 + wr * 64 + fr;
#pragma unroll
        for (int bj = 0; bj < 2; ++bj) {
            const int c32 = u.pn * 256 + bj * 128 + wc * 32;
            const bool rope = (c32 % 96) == 64;
#pragma unroll
            for (int ai = 0; ai < 2; ++ai)
#pragma unroll
                for (int m = 0; m < 4; ++m) { const int row = row0 + ai * 128 + m * 16;
                    float r[8];
#pragma unroll
                    for (int n = 0; n < 2; ++n)
#pragma unroll
                        for (int e = 0; e < 4; ++e) r[4 * n + e] = acc[ai][bj][m][n][e];
                    if (rope) {
                        const int i0 = 8 * (fq & 1);
                        const f32x4 c0 = *(const f32x4*)(cosr + (size_t)row * 16 + i0), c1 = *(const f32x4*)(cosr + (size_t)row * 16 + i0 + 4);
                        const f32x4 s0 = *(const f32x4*)(sinr + (size_t)row * 16 + i0), s1 = *(const f32x4*)(sinr + (size_t)row * 16 + i0 + 4);
#pragma unroll
                        for (int j = 0; j < 8; ++j) { const float own = r[j], oth = __shfl_xor(own, 32);
                            const float c = j < 4 ? c0[j & 3] : c1[j & 3], s = j < 4 ? s0[j & 3] : s1[j & 3];
                            r[j] = (fq < 2) ? (own * c - oth * s) : (own * c + oth * s); }
                    }
                    u32x4 w; w.x = cvt_pk_bf16(r[0] * qscale, r[1] * qscale); w.y = cvt_pk_bf16(r[2] * qscale, r[3] * qscale);
                    w.z = cvt_pk_bf16(r[4] * qscale, r[5] * qscale); w.w = cvt_pk_bf16(r[6] * qscale, r[7] * qscale);
                    *(u32x4*)(O + (size_t)row * 768 + c32 + 8 * fq) = w;
                    asm volatile("" ::: "memory"); }
        }
    }
};
struct EpiKVup {
    static constexpr bool PERM = true;
    bf16_t* KM; bf16_t* VM;
    DI void operator()(const AccT& acc, const pg8::Unit& u, int wr, int wc, int fr, int fq) const {
        const int row0 = u.pm * 256 + wr * 64 + fr;
#pragma unroll
        for (int bj = 0; bj < 2; ++bj) { const int head = 2 * u.pn + bj;
            bf16_t* base = (wc < 2) ? (KM + head * 96 + wc * 32 + 8 * fq) : (VM + head * 64 + (wc - 2) * 32 + 8 * fq);
            const int pitch = (wc < 2) ? 768 : 512;
#pragma unroll
            for (int ai = 0; ai < 2; ++ai)
#pragma unroll
                for (int m = 0; m < 4; ++m) { const int row = row0 + ai * 128 + m * 16; const f32x4 v0 = acc[ai][bj][m][0], v1 = acc[ai][bj][m][1];
                    u32x4 w; w.x = cvt_pk_bf16(v0[0], v0[1]); w.y = cvt_pk_bf16(v0[2], v0[3]); w.z = cvt_pk_bf16(v1[0], v1[1]); w.w = cvt_pk_bf16(v1[2], v1[3]);
                    *(u32x4*)(base + (size_t)row * pitch) = w; } }
    }
};

#define XB_TMO      128
#define XB_XCNT(j)  (256  + 64 * (j))
#define XB_XSUB(j)  (1280 + 64 * (j))
#define XB_XGEN(j)  (2304 + 64 * (j))
#define XB_TOP      3328
#define XB_TOPGEN   3392
#define XCD_BAR_WORDS 3456
#define XB_SPIN_CAP (1u << 18)
__device__ __forceinline__ unsigned xb_ld(unsigned* p)              { return __hip_atomic_load(p, __ATOMIC_RELAXED, __HIP_MEMORY_SCOPE_AGENT); }
__device__ __forceinline__ unsigned xb_add(unsigned* p, unsigned v) { return __hip_atomic_fetch_add(p, v, __ATOMIC_RELAXED, __HIP_MEMORY_SCOPE_AGENT); }
__device__ __forceinline__ unsigned xb_xcc_id() { return (unsigned)__builtin_amdgcn_s_getreg((3 << 11) | 20) & 0xFu; }
#define XB_SPIN(cond, bar) do { unsigned _sp = 0; while (cond) { __builtin_amdgcn_s_sleep(1); \
    if ((++_sp & 255u) == 0u) { if (xb_ld(&(bar)[XB_TMO])) break; if (_sp > XB_SPIN_CAP) { atomicAdd(&(bar)[XB_TMO], 1u); break; } } } } while (0)
struct XcdBarrier { unsigned* bar; unsigned x; volatile LAS unsigned* st; };
__device__ __forceinline__ XcdBarrier xcd_barrier_post(unsigned* bar, volatile LAS unsigned* st) {
    XcdBarrier b; b.bar = bar; b.x = xb_xcc_id(); b.st = st;
    if (threadIdx.x == 0) (void)xb_add(&bar[XB_XCNT(b.x)], 1u);
    return b;
}
__device__ __forceinline__ void xcd_barrier_complete(unsigned* bar, unsigned x, unsigned& nloc, unsigned& nx) {
    const unsigned G = gridDim.x * gridDim.y * gridDim.z;
    unsigned sum, cnt, mine, sp = 0u;
    for (;;) {
        sum = 0u; cnt = 0u; mine = 0u;
#pragma unroll
        for (unsigned j = 0; j < 16; ++j) { const unsigned c = xb_ld(&bar[XB_XCNT(j)]); sum += c; cnt += (c > 0u) ? 1u : 0u; mine = (j == x) ? c : mine; }
        if (sum == G) break;
        __builtin_amdgcn_s_sleep(1);
        if ((++sp & 255u) == 0u) { if (xb_ld(&bar[XB_TMO])) break; if (sp > XB_SPIN_CAP) { atomicAdd(&bar[XB_TMO], 1u); break; } }
    }
    nloc = mine > 0u ? mine : 1u; nx = cnt > 0u ? cnt : 1u;
}
__device__ __forceinline__ void xcd_barrier(const XcdBarrier& b) {
    asm volatile("s_waitcnt vmcnt(0)" ::: "memory");
    __syncthreads();
    if (threadIdx.x == 0) {
        unsigned* bar = b.bar;
        __builtin_amdgcn_s_waitcnt(0);
        unsigned nloc = b.st[0], nx = b.st[1];
        if (nloc == 0u) { xcd_barrier_complete(bar, b.x, nloc, nx); b.st[0] = nloc; b.st[1] = nx; }
        const unsigned old = xb_add(&bar[XB_XSUB(b.x)], 1u);
        const unsigned gen = old / nloc;
        if (old + 1u == (gen + 1u) * nloc) {
            __builtin_amdgcn_fence(__ATOMIC_RELEASE, "agent");
            asm volatile("s_waitcnt vmcnt(0)" ::: "memory");
            const unsigned og = xb_add(&bar[XB_TOP], 1u);
            const unsigned tg = og / nx;
            if (og + 1u == (tg + 1u) * nx) xb_add(&bar[XB_TOPGEN], 1u);
            else XB_SPIN(xb_ld(&bar[XB_TOPGEN]) == tg, bar);
            __builtin_amdgcn_fence(__ATOMIC_ACQUIRE, "agent");
            xb_add(&bar[XB_XGEN(b.x)], 1u);
            asm volatile("s_waitcnt vmcnt(0)" ::: "memory");
        } else {
            XB_SPIN(xb_ld(&bar[XB_XGEN(b.x)]) == gen, bar);
            __builtin_amdgcn_fence(__ATOMIC_ACQUIRE, "agent");
            asm volatile("s_waitcnt vmcnt(0)" ::: "memory");
        }
    }
    __syncthreads();
}

struct Params {
    const float* in[23];
    float* out;
    unsigned char* ws;
    double inv_r[16];
    double inv_m[32];
    int ph_lo, ph_hi;
};

template <int GLU>
DI void transpose_item(const float* W, int K, int N, bf16_t* WT, LAS float* scr, int item, int lane) {
    const int nblk = N / 32, kb = item / nblk, nb = item % nblk, k0 = 64 * kb, n0 = 32 * nb;
#pragma unroll 8
    for (int i = 0; i < 32; ++i) { const int kk = 2 * i + (lane >> 5); scr[kk * 33 + (lane & 31)] = W[(size_t)(k0 + kk) * N + n0 + (lane & 31)]; }
    LDS_WAIT(); asm volatile("" ::: "memory");
    const int c = lane & 7;
#pragma unroll
    for (int j = 0; j < 4; ++j) { const int n = (lane >> 3) + 8 * j; const LAS float* s = scr + (8 * c) * 33 + n;
        u32x4 o; o.x = cvt_pk_bf16(s[0 * 33], s[1 * 33]); o.y = cvt_pk_bf16(s[2 * 33], s[3 * 33]); o.z = cvt_pk_bf16(s[4 * 33], s[5 * 33]); o.w = cvt_pk_bf16(s[6 * 33], s[7 * 33]);
        int nn = n0 + n;
        if (GLU) nn = (nn < 1024) ? ((nn >> 7) * 256 + (nn & 127)) : (((nn - 1024) >> 7) * 256 + 128 + (nn & 127));
        *(u32x4*)(WT + (size_t)nn * K + k0 + 8 * c) = o; }
    LDS_WAIT(); asm volatile("" ::: "memory");
}
DI void rms_row_to_bf16(const float* xrow, const float* gain, bf16_t* orow, int lane) {
    const f32x4* xr = (const f32x4*)xrow + lane; const f32x4* gr = (const f32x4*)gain + lane;
    f32x4 v[4]; float s = 0.f;
#pragma unroll
    for (int j = 0; j < 4; ++j) { v[j] = xr[64 * j]; s += (v[j].x * v[j].x + v[j].y * v[j].y) + (v[j].z * v[j].z + v[j].w * v[j].w); }
    const float r = rsqrtf(wave_sum(s) * (1.f / DM) + NORM_EPS);
    u32x2* o8 = (u32x2*)orow + lane;
#pragma unroll
    for (int j = 0; j < 4; ++j) { const f32x4 g = gr[64 * j]; u32x2 o; o.x = cvt_pk_bf16(v[j].x * r * g.x, v[j].y * r * g.y); o.y = cvt_pk_bf16(v[j].z * r * g.z, v[j].w * r * g.w); o8[64 * j] = o; }
}

DI void token_prep_unit(LAS unsigned char* lds, int unit, const bf16_t* proj, const float* qn, const float* kvn,
                        const float* cosr, const float* sinr, const float* cosm, const float* sinm,
                        bf16_t* cqn, bf16_t* ckvn, bf16_t* KM, bf16_t* MQ, bf16_t* MK, float* kpart, int wave, int lane) {
    float ks1[4] = {0.f, 0.f, 0.f, 0.f}, ks2[4] = {0.f, 0.f, 0.f, 0.f};
    const float mscale = 0.125f * LOG2E;
    for (int i = 0; i < 8; ++i) {
        const int row = unit * 64 + wave * 8 + i;
        const bf16_t* P = proj + (size_t)row * NPROJP;
        { unsigned w[3]; float ss = 0.f;
#pragma unroll
          for (int j = 0; j < 3; ++j) { w[j] = *(const unsigned*)(P + 2 * lane + 128 * j); const float a = bf_lo(w[j]), b = bf_hi(w[j]); ss += a * a + b * b; }
          const float r = rsqrtf(wave_sum(ss) * (1.f / 384.f) + NORM_EPS);
#pragma unroll
          for (int j = 0; j < 3; ++j) { const f32x2 g = *(const f32x2*)(qn + 2 * lane + 128 * j);
              *(unsigned*)(cqn + (size_t)row * 384 + 2 * lane + 128 * j) = cvt_pk_bf16(bf_lo(w[j]) * r * g.x, bf_hi(w[j]) * r * g.y); } }
        { unsigned w[2]; float ss = 0.f;
#pragma unroll
          for (int j = 0; j < 2; ++j) { w[j] = *(const unsigned*)(P + 384 + 2 * lane + 128 * j); const float a = bf_lo(w[j]), b = bf_hi(w[j]); ss += a * a + b * b; }
          const float r = rsqrtf(wave_sum(ss) * (1.f / 256.f) + NORM_EPS);
#pragma unroll
          for (int j = 0; j < 2; ++j) { const f32x2 g = *(const f32x2*)(kvn + 2 * lane + 128 * j);
              *(unsigned*)(ckvn + (size_t)row * 256 + 2 * lane + 128 * j) = cvt_pk_bf16(bf_lo(w[j]) * r * g.x, bf_hi(w[j]) * r * g.y); } }
        { const int h = lane >> 3, i2 = 2 * (lane & 7);
          const unsigned x1 = *(const unsigned*)(P + 640 + i2), x2 = *(const unsigned*)(P + 656 + i2);
          const f32x2 c = *(const f32x2*)(cosr + (size_t)row * 16 + i2), s = *(const f32x2*)(sinr + (size_t)row * 16 + i2);
          const float a0 = bf_lo(x1), a1 = bf_hi(x1), b0 = bf_lo(x2), b1 = bf_hi(x2);
          *(unsigned*)(KM + (size_t)row * 768 + h * 96 + 64 + i2) = cvt_pk_bf16(a0 * c.x - b0 * s.x, a1 * c.y - b1 * s.y);
          *(unsigned*)(KM + (size_t)row * 768 + h * 96 + 80 + i2) = cvt_pk_bf16(b0 * c.x + a0 * s.x, b1 * c.y + a1 * s.y); }
        { const int hq = lane >> 3, i4 = 4 * (lane & 7);
          const f32x4 c = *(const f32x4*)(cosm + (size_t)row * 32 + i4), s = *(const f32x4*)(sinm + (size_t)row * 32 + i4);
          { const u32x2 x1 = *(const u32x2*)(P + 672 + hq * 64 + i4), x2 = *(const u32x2*)(P + 672 + hq * 64 + 32 + i4);
            const float a[4] = {bf_lo(x1.x), bf_hi(x1.x), bf_lo(x1.y), bf_hi(x1.y)}, b[4] = {bf_lo(x2.x), bf_hi(x2.x), bf_lo(x2.y), bf_hi(x2.y)};
            float y1[4], y2[4];
#pragma unroll
            for (int e = 0; e < 4; ++e) { y1[e] = (a[e] * c[e] - b[e] * s[e]) * mscale; y2[e] = (b[e] * c[e] + a[e] * s[e]) * mscale; }
            u32x2 o1, o2; o1.x = cvt_pk_bf16(y1[0], y1[1]); o1.y = cvt_pk_bf16(y1[2], y1[3]); o2.x = cvt_pk_bf16(y2[0], y2[1]); o2.y = cvt_pk_bf16(y2[2], y2[3]);
            *(u32x2*)(MQ + (size_t)row * 512 + hq * 64 + i4) = o1; *(u32x2*)(MQ + (size_t)row * 512 + hq * 64 + 32 + i4) = o2; }
          { const u32x2 x1 = *(const u32x2*)(P + 1184 + hq * 64 + i4), x2 = *(const u32x2*)(P + 1184 + hq * 64 + 32 + i4);
            const float a[4] = {bf_lo(x1.x), bf_hi(x1.x), bf_lo(x1.y), bf_hi(x1.y)}, b[4] = {bf_lo(x2.x), bf_hi(x2.x), bf_lo(x2.y), bf_hi(x2.y)};
            float y1[4], y2[4];
#pragma unroll
            for (int e = 0; e < 4; ++e) { y1[e] = a[e] * c[e] - b[e] * s[e]; y2[e] = b[e] * c[e] + a[e] * s[e]; ks1[e] += y1[e]; ks2[e] += y2[e]; }
            u32x2 o1, o2; o1.x = cvt_pk_bf16(y1[0], y1[1]); o1.y = cvt_pk_bf16(y1[2], y1[3]); o2.x = cvt_pk_bf16(y2[0], y2[1]); o2.y = cvt_pk_bf16(y2[2], y2[3]);
            *(u32x2*)(MK + (size_t)row * 512 + hq * 64 + i4) = o1; *(u32x2*)(MK + (size_t)row * 512 + hq * 64 + 32 + i4) = o2; } }
    }
    LAS float* red = (LAS float*)lds;
    { const int hq = lane >> 3, i4 = 4 * (lane & 7);
#pragma unroll
      for (int e = 0; e < 4; ++e) { red[wave * 512 + hq * 64 + i4 + e] = ks1[e]; red[wave * 512 + hq * 64 + 32 + i4 + e] = ks2[e]; } }
    __syncthreads();
    { const int tid = wave * 64 + lane; float s = 0.f;
#pragma unroll
      for (int w = 0; w < 8; ++w) s += red[w * 512 + tid];
      const int row0 = unit * 64, b = row0 / SEQ, t0 = row0 % SEQ, n = t0 / 256, part = (t0 % 256) / 64;
      kpart[((size_t)(b * 32 + n) * 4 + part) * 512 + tid] = s; }
    __syncthreads();
}

DI s16x4 vtr(const LAS char* p) { return __builtin_bit_cast(s16x4, __builtin_amdgcn_ds_read_tr16_b64_v4i16((LAS v4i16_t*)p)); }
#define MFMA32(a, b, c) __builtin_amdgcn_mfma_f32_32x32x16_bf16((a), (b), (c), 0, 0, 0)

template <int DK, bool MOBA>
DI void attn_unit(LAS unsigned char* lds, const bf16_t* Qp, int qpitch, const bf16_t* Kp, int kpitch, const bf16_t* Vp, int vpitch,
                  bf16_t* Op, int opitch, int qb, const float* kpart_b  ) {
    constexpr int NKS = DK / 16, KCH = DK / 8, KBYTES = KCH * 1024, VBYTES = 8192;
    constexpr int OFF_K0 = 0, OFF_K1 = KBYTES, OFF_V0 = 2 * KBYTES, OFF_V1 = 2 * KBYTES + VBYTES, OFF_KM = 2 * KBYTES + 2 * VBYTES;
    int tid_o = threadIdx.x; asm volatile("" : "+v"(tid_o));
    const int tid = tid_o, lane = tid & 63, r32 = lane & 31, hi = lane >> 5; const int wid = __builtin_amdgcn_readfirstlane(tid >> 6);
    const int q0 = qb * 256, NT = 4 * qb + 4;
    bf16x8 qf[NKS];
    { const bf16_t* qrow = Qp + (size_t)(q0 + wid * 32 + r32) * qpitch + hi * 8;
#pragma unroll
      for (int ks = 0; ks < NKS; ++ks) qf[ks] = *(const bf16x8*)(qrow + ks * 16); }
    unsigned selmask = 0u;
    if constexpr (MOBA) {
        const int own = qb;
        if (own > 0) {
            LAS float* km = (LAS float*)(lds + OFF_KM);
            for (int e = tid; e < own * 64; e += NTHR) { const int n = e >> 6, d = e & 63; const float* kp = kpart_b + (size_t)n * 4 * 512 + d;
                km[e] = (kp[0] + kp[512] + kp[1024] + kp[1536]) * (1.f / 256.f); }
            __syncthreads();
            float qv[NKS][8];
#pragma unroll
            for (int ks = 0; ks < NKS; ++ks)
#pragma unroll
                for (int j = 0; j < 8; ++j) qv[ks][j] = bf1((bf16_t)qf[ks][j]);
            float v0 = -INFINITY, v1 = -INFINITY, v2 = -INFINITY; int i0 = -1, i1 = -1, i2 = -1;
            for (int n = 0; n < own; ++n) {
                float g = 0.f;
#pragma unroll
                for (int ks = 0; ks < NKS; ++ks) { const f32x4 ka = *(const LAS f32x4*)(km + n * 64 + ks * 16 + hi * 8), kb = *(const LAS f32x4*)(km + n * 64 + ks * 16 + hi * 8 + 4);
                    g += qv[ks][0] * ka[0] + qv[ks][1] * ka[1] + qv[ks][2] * ka[2] + qv[ks][3] * ka[3] + qv[ks][4] * kb[0] + qv[ks][5] * kb[1] + qv[ks][6] * kb[2] + qv[ks][7] * kb[3]; }
                g += __shfl_xor(g, 32);
                if (g > v0) { v2 = v1; i2 = i1; v1 = v0; i1 = i0; v0 = g; i0 = n; }
                else if (g > v1) { v2 = v1; i2 = i1; v1 = g; i1 = n; }
                else if (g > v2) { v2 = g; i2 = n; }
            }
            if (i0 >= 0) selmask |= 1u << i0;
            if (i1 >= 0) selmask |= 1u << i1;
            if (i2 >= 0) selmask |= 1u << i2;
            __syncthreads();
        }
    }
    const bf16_t* kg0 = Kp + (size_t)lane * kpitch + wid * 8;
    const bf16_t* kg1 = Kp + (size_t)lane * kpitch + (8 + (wid & 3)) * 8;
    const int vrow = tid >> 3, vpc = tid & 7;
    const bf16_t* vg = Vp + (size_t)vrow * vpitch + vpc * 8;
    const int kdst0 = wid * 1024 + lane * 16, kdst1 = (8 + (wid & 3)) * 1024 + lane * 16, vdst = (vpc >> 2) * 4096 + vrow * 64 + (vpc & 3) * 16;
    u32x4 sk0, sk1 = (u32x4){0u, 0u, 0u, 0u}, sv;
    sk0 = *(const u32x4*)kg0; if (DK == 96 && wid < 4) sk1 = *(const u32x4*)kg1; sv = *(const u32x4*)vg;
    *(LAS u32x4*)(lds + OFF_K0 + kdst0) = sk0; if (DK == 96 && wid < 4) *(LAS u32x4*)(lds + OFF_K0 + kdst1) = sk1; *(LAS u32x4*)(lds + OFF_V0 + vdst) = sv;
    float m = -1e30f, l = 0.f; f32x16 ot[2]; ot[0] = f32x16{}; ot[1] = f32x16{};
    const int qrel = wid * 32 + r32;
    const int vq = (lane & 15) >> 2, vp = lane & 3, vblk = (lane >> 4) & 1;
    const int vbase = (4 * hi + vq) * 64 + vblk * 32 + vp * 8;
    for (int t = 0; t < NT; ++t) {
        __syncthreads();
        const int cur = t & 1;
        const bool more = (t + 1 < NT);
        if (more) { const size_t ro = (size_t)(t + 1) * 64; sk0 = *(const u32x4*)(kg0 + ro * kpitch); if (DK == 96 && wid < 4) sk1 = *(const u32x4*)(kg1 + ro * kpitch); sv = *(const u32x4*)(vg + ro * vpitch); }
        const LAS unsigned char* Kb = lds + (cur ? OFF_K1 : OFF_K0); const LAS unsigned char* Vb = lds + (cur ? OFF_V1 : OFF_V0);
        const int jb = t - 4 * qb;
        bool active = true; bool lane_sel = true;
        if (jb >= 0) { if (64 * jb > wid * 32 + 31) active = false; }
        else if constexpr (MOBA) { lane_sel = (selmask >> (t >> 2)) & 1u; active = __any(lane_sel); }
        if (active) {
            f32x16 s0 = f32x16{}, s1 = f32x16{};
#pragma unroll
            for (int ks = 0; ks < NKS; ++ks) {
                const bf16x8 ka = *(const LAS bf16x8*)(Kb + (2 * ks + hi) * 1024 + r32 * 16), kb = *(const LAS bf16x8*)(Kb + (2 * ks + hi) * 1024 + (32 + r32) * 16);
                s0 = MFMA32(ka, qf[ks], s0); s1 = MFMA32(kb, qf[ks], s1);
            }
            if (jb >= 0) { if (64 * jb + 63 > wid * 32) { const int kb0 = 64 * jb + 4 * hi;
#pragma unroll
                for (int r = 0; r < 16; ++r) { const int kv = kb0 + (r & 3) + 8 * (r >> 2); if (kv > qrel) s0[r] = -INFINITY; if (kv + 32 > qrel) s1[r] = -INFINITY; } } }
            else if constexpr (MOBA) { if (!lane_sel) {
#pragma unroll
                for (int r = 0; r < 16; ++r) { s0[r] = -INFINITY; s1[r] = -INFINITY; } } }
            float tm = s0[0];
#pragma unroll
            for (int r = 1; r < 16; ++r) tm = fmaxf(tm, s0[r]);
#pragma unroll
            for (int r = 0; r < 16; ++r) tm = fmaxf(tm, s1[r]);
            tm = fmaxf(tm, __shfl_xor(tm, 32));
            const float mn = fmaxf(m, tm);
            if (__any(mn > m)) { const float alpha = __builtin_amdgcn_exp2f(m - mn); l *= alpha;
#pragma unroll
                for (int r = 0; r < 16; ++r) { ot[0][r] *= alpha; ot[1][r] *= alpha; }
                m = mn; }
            float ls = 0.f;
#pragma unroll
            for (int r = 0; r < 16; ++r) { s0[r] = __builtin_amdgcn_exp2f(s0[r] - m); s1[r] = __builtin_amdgcn_exp2f(s1[r] - m); ls += s0[r] + s1[r]; }
            l += ls;
            bf16x8 pf[4];
#pragma unroll
            for (int s = 0; s < 4; ++s) { u32x4 w;
                if (s < 2) { w.x = cvt_pk_bf16(s0[8 * s], s0[8 * s + 1]); w.y = cvt_pk_bf16(s0[8 * s + 2], s0[8 * s + 3]); w.z = cvt_pk_bf16(s0[8 * s + 4], s0[8 * s + 5]); w.w = cvt_pk_bf16(s0[8 * s + 6], s0[8 * s + 7]); }
                else { const int q = s - 2; w.x = cvt_pk_bf16(s1[8 * q], s1[8 * q + 1]); w.y = cvt_pk_bf16(s1[8 * q + 2], s1[8 * q + 3]); w.z = cvt_pk_bf16(s1[8 * q + 4], s1[8 * q + 5]); w.w = cvt_pk_bf16(s1[8 * q + 6], s1[8 * q + 7]); }
                pf[s] = __builtin_bit_cast(bf16x8, w); }
#pragma unroll
            for (int db = 0; db < 2; ++db)
#pragma unroll
                for (int s = 0; s < 4; ++s) { const LAS char* vpn = (const LAS char*)Vb + db * 4096 + s * 1024 + vbase;
                    const s16x4 lo = vtr(vpn), hi4 = vtr(vpn + 512);
                    const bf16x8 vf = (bf16x8){lo[0], lo[1], lo[2], lo[3], hi4[0], hi4[1], hi4[2], hi4[3]};
                    ot[db] = MFMA32(vf, pf[s], ot[db]); }
        }
        if (more) { const int nb = cur ^ 1;
            *(LAS u32x4*)(lds + (nb ? OFF_K1 : OFF_K0) + kdst0) = sk0; if (DK == 96 && wid < 4) *(LAS u32x4*)(lds + (nb ? OFF_K1 : OFF_K0) + kdst1) = sk1; *(LAS u32x4*)(lds + (nb ? OFF_V1 : OFF_V0) + vdst) = sv; }
    }
    l += __shfl_xor(l, 32);
    const float rl = 1.f / l;
    bf16_t* orow = Op + (size_t)(q0 + qrel) * opitch;
#pragma unroll
    for (int db = 0; db < 2; ++db)
#pragma unroll
        for (int g = 0; g < 4; ++g) { u32x2 w; w.x = cvt_pk_bf16(ot[db][4 * g] * rl, ot[db][4 * g + 1] * rl); w.y = cvt_pk_bf16(ot[db][4 * g + 2] * rl, ot[db][4 * g + 3] * rl);
            *(u32x2*)(orow + 32 * db + 8 * g + 4 * hi) = w; }
    __syncthreads();
}

DI void dwconv_unit(LAS unsigned char* lds, int unit, const bf16_t* ug, const float (&w)[31][2], float b0, float b1, float g0, float g1, float be0, float be1, bf16_t* y, int tid) {
    const int row0 = unit * 16, tb = row0 % SEQ;
    for (int c = tid; c < 46 * 128; c += NTHR) { const int r = c >> 7, pc = c & 127; const int trel = tb - 30 + r;
        u32x4 v = (u32x4){0u, 0u, 0u, 0u};
        if (trel >= 0) v = *(const u32x4*)(ug + (size_t)(row0 - 30 + r) * DM + pc * 8);
        *(LAS u32x4*)(lds + r * 2048 + pc * 16) = v; }
    __syncthreads();
    unsigned xs[46];
#pragma unroll
    for (int r = 0; r < 46; ++r) xs[r] = *(const LAS unsigned*)(lds + r * 2048 + tid * 4);
    float a0[16], a1[16];
#pragma unroll
    for (int i = 0; i < 16; ++i) { float s0 = b0, s1 = b1;
#pragma unroll
        for (int j = 0; j < 31; ++j) { s0 += w[j][0] * bf_lo(xs[i + j]); s1 += w[j][1] * bf_hi(xs[i + j]); }
        a0[i] = s0; a1[i] = s1; }
    __syncthreads();
    LAS float* red = (LAS float*)lds;
    const int lane = tid & 63, wave = tid >> 6;
#pragma unroll
    for (int i = 0; i < 16; ++i) { const float s = wave_sum(a0[i] + a1[i]), q = wave_sum(a0[i] * a0[i] + a1[i] * a1[i]);
        if (lane == 0) { red[wave * 32 + i] = s; red[wave * 32 + 16 + i] = q; } }
    __syncthreads();
#pragma unroll
    for (int i = 0; i < 16; ++i) { float s = 0.f, q = 0.f;
#pragma unroll
        for (int wv = 0; wv < 8; ++wv) { s += red[wv * 32 + i]; q += red[wv * 32 + 16 + i]; }
        const float mean = s * (1.f / DM), var = fmaxf(q * (1.f / DM) - mean * mean, 0.f), rstd = rsqrtf(var + NORM_EPS);
        const float z0 = (a0[i] - mean) * rstd * g0 + be0, z1 = (a1[i] - mean) * rstd * g1 + be1;
        const float o0 = z0 / (1.f + __expf(-z0)), o1 = z1 / (1.f + __expf(-z1));
        *(unsigned*)(y + (size_t)(row0 + i) * DM + 2 * tid) = cvt_pk_bf16(o0, o1); }
    __syncthreads();
}

#define CE_DESC(a, b) do { const float _h = fmaxf((a), (b)), _l = fminf((a), (b)); (a) = _h; (b) = _l; } while (0)
DI void sort16_desc(float (&a)[16]) {
#pragma unroll
    for (int k = 2; k <= 16; k <<= 1)
#pragma unroll
        for (int j = k >> 1; j > 0; j >>= 1)
#pragma unroll
            for (int i = 0; i < 16; ++i) { const int p = i ^ j; if (p > i) { if ((i & k) == 0) CE_DESC(a[i], a[p]); else CE_DESC(a[p], a[i]); } }
}
DI void merge16_desc(float (&a)[16], const float (&b)[16]) {
#pragma unroll
    for (int i = 0; i < 16; ++i) a[i] = fmaxf(a[i], b[15 - i]);
#pragma unroll
    for (int j = 8; j > 0; j >>= 1)
#pragma unroll
        for (int i = 0; i < 16; ++i) { const int p = i ^ j; if (p > i) CE_DESC(a[i], a[p]); }
}
DI void top16_of_64(float (&g0)[16], float (&g1)[16], float (&g2)[16], float (&g3)[16]) {
    sort16_desc(g0); sort16_desc(g1); sort16_desc(g2); sort16_desc(g3);
    merge16_desc(g0, g1); merge16_desc(g2, g3); merge16_desc(g0, g2);
}
DI float pack_key(float v, unsigned code, unsigned mask) { return __builtin_bit_cast(float, (__builtin_bit_cast(unsigned, v) & ~mask) | code); }

DI void peer_topk_unit(const LAS unsigned char* sk, LAS unsigned* dec  , const bf16_t* q2, int tile, int h, int* idx, float* gate, int lane) {
    const int r32 = lane & 31, hi = lane >> 5; const int tok = tile * 32 + r32;
    float L[2][16];
#pragma unroll
    for (int c = 0; c < 2; ++c) {
        bf16x8 qf[8];
        const bf16_t* qrow = q2 + (size_t)tok * 2048 + (h * 2 + c) * 128 + hi * 8;
#pragma unroll
        for (int ks = 0; ks < 8; ++ks) qf[ks] = *(const bf16x8*)(qrow + ks * 16);
        f32x16 acc[4];
#pragma unroll
        for (int kt = 0; kt < 4; ++kt) { acc[kt] = f32x16{};
#pragma unroll
            for (int ks = 0; ks < 8; ++ks) { const bf16x8 a = *(const LAS bf16x8*)(sk + c * 32768 + (2 * ks + hi) * 2048 + (32 * kt + r32) * 16); acc[kt] = MFMA32(a, qf[ks], acc[kt]); } }
        float g[4][16];
#pragma unroll
        for (int kt = 0; kt < 4; ++kt)
#pragma unroll
            for (int r = 0; r < 16; ++r) { const int key = 32 * kt + (r & 3) + 8 * (r >> 2) + 4 * hi; g[kt][r] = pack_key(acc[kt][r], 127u - (unsigned)key, 127u); }
        top16_of_64(g[0], g[1], g[2], g[3]);
        float other[16];
#pragma unroll
        for (int i = 0; i < 16; ++i) other[i] = __shfl_xor(g[0][i], 32);
        merge16_desc(g[0], other);
#pragma unroll
        for (int i = 0; i < 16; ++i) L[c][i] = g[0][i];
    }
#pragma unroll
    for (int c = 0; c < 2; ++c)
#pragma unroll
        for (int q = 0; q < 4; ++q) { unsigned w = 0u;
#pragma unroll
            for (int e = 0; e < 4; ++e) w |= (127u - (__builtin_bit_cast(unsigned, L[c][4 * q + e]) & 127u)) << (8 * e);
            dec[(c * 4 + q) * 64 + lane] = w; }
    const float PAD = -3.0e38f;
    float c0[16], c1[16], c2[16], c3[16];
#define CAND(i, j) pack_key(L[0][i] + L[1][j], 255u - (unsigned)(16 * (i) + (j)), 255u)
#pragma unroll
    for (int j = 0; j < 16; ++j) c0[j] = CAND(0, j);
#pragma unroll
    for (int j = 0; j < 8; ++j) c1[j] = CAND(1, j);
#pragma unroll
    for (int j = 0; j < 5; ++j) c1[8 + j] = CAND(2, j);
    c1[13] = PAD; c1[14] = PAD; c1[15] = PAD;
#pragma unroll
    for (int j = 0; j < 4; ++j) c2[j] = CAND(3, j);
#pragma unroll
    for (int j = 0; j < 3; ++j) c2[4 + j] = CAND(4, j);
    c2[7] = CAND(5, 0); c2[8] = CAND(5, 1); c2[9] = CAND(6, 0); c2[10] = CAND(6, 1); c2[11] = CAND(7, 0); c2[12] = CAND(7, 1);
    c2[13] = PAD; c2[14] = PAD; c2[15] = PAD;
#pragma unroll
    for (int i = 0; i < 8; ++i) { c3[i] = CAND(8 + i, 0); c3[8 + i] = PAD; }
#undef CAND
    top16_of_64(c0, c1, c2, c3);
    float e[16], sum = 0.f;
#pragma unroll
    for (int k = 0; k < 16; ++k) { e[k] = __builtin_amdgcn_exp2f((c0[k] - c0[0]) * LOG2E); sum += e[k]; }
    const float rs = 1.f / sum;
    LDS_WAIT();
    int ids[16];
#pragma unroll
    for (int k = 0; k < 16; ++k) { const unsigned code = 255u - (__builtin_bit_cast(unsigned, c0[k]) & 255u); const unsigned i = code >> 4, j = code & 15u;
        const unsigned w1 = dec[(i >> 2) * 64 + lane], w2 = dec[(4 + (j >> 2)) * 64 + lane];
        ids[k] = (int)(((w1 >> (8 * (i & 3))) & 127u) * 128u + ((w2 >> (8 * (j & 3))) & 127u)); }
    if (hi == 0) {
        int* ip = idx + (size_t)tok * 128 + h * 16; float* gp = gate + (size_t)tok * 128 + h * 16;
#pragma unroll
        for (int q = 0; q < 4; ++q) { *(int4*)(ip + 4 * q) = make_int4(ids[4 * q], ids[4 * q + 1], ids[4 * q + 2], ids[4 * q + 3]);
            *(f32x4*)(gp + 4 * q) = (f32x4){e[4 * q] * rs, e[4 * q + 1] * rs, e[4 * q + 2] * rs, e[4 * q + 3] * rs}; }
    }
    LDS_WAIT();
}

typedef __bf16 bf2_t __attribute__((ext_vector_type(2)));
DI bf2_t as_bf2(unsigned u) { return __builtin_bit_cast(bf2_t, u); }
DI float dot8(u32x4 a, u32x4 b, float acc) {
    acc = __builtin_amdgcn_fdot2_f32_bf16(as_bf2(a.x), as_bf2(b.x), acc, false);
    acc = __builtin_amdgcn_fdot2_f32_bf16(as_bf2(a.y), as_bf2(b.y), acc, false);
    acc = __builtin_amdgcn_fdot2_f32_bf16(as_bf2(a.z), as_bf2(b.z), acc, false);
    acc = __builtin_amdgcn_fdot2_f32_bf16(as_bf2(a.w), as_bf2(b.w), acc, false);
    return acc;
}
DI void fma8(float (&o)[8], u32x4 v, float w) {
    o[0] += w * bf_lo(v.x); o[1] += w * bf_hi(v.x); o[2] += w * bf_lo(v.y); o[3] += w * bf_hi(v.y);
    o[4] += w * bf_lo(v.z); o[5] += w * bf_hi(v.z); o[6] += w * bf_lo(v.w); o[7] += w * bf_hi(v.w);
}
DI void peer_gather_token(int tok, const bf16_t* hn2, const int* idx, const float* gate, const bf16_t* U, const bf16_t* V,
                          const float* hin, float* hout, const float* ngain, bf16_t* hn_next, float* final_out, int lane) {
    const u32x4 x0 = *(const u32x4*)(hn2 + (size_t)tok * DM + 8 * lane), x1 = *(const u32x4*)(hn2 + (size_t)tok * DM + 512 + 8 * lane);
    const int id0 = idx[(size_t)tok * 128 + lane], id1 = idx[(size_t)tok * 128 + 64 + lane];
    const float g0 = gate[(size_t)tok * 128 + lane], g1 = gate[(size_t)tok * 128 + 64 + lane];
    float act0 = 0.f, act1 = 0.f;
    for (int gidx = 0; gidx < (DBG_SKIP_PEER ? 0 : 16); ++gidx) {
        u32x4 ua[8], ub[8];
#pragma unroll
        for (int s = 0; s < 8; ++s) { const int sl = gidx * 8 + s; const int e = __builtin_amdgcn_readlane(sl < 64 ? id0 : id1, sl & 63);
            const bf16_t* up = U + (size_t)e * DM + 8 * lane; ua[s] = *(const u32x4*)up; ub[s] = *(const u32x4*)(up + 512); }
#pragma unroll
        for (int s = 0; s < 8; ++s) { const int sl = gidx * 8 + s; float d = dot8(ua[s], x0, 0.f); d = dot8(ub[s], x1, d); d = wave_sum(d);
            if (sl < 64) { if (lane == sl) act0 = d; } else { if (lane == sl - 64) act1 = d; } }
    }
    const float w0 = g0 * 0.5f * act0 * (1.f + erff(act0 * 0.70710678118654752f)), w1 = g1 * 0.5f * act1 * (1.f + erff(act1 * 0.70710678118654752f));
    float oa[8] = {0.f, 0.f, 0.f, 0.f, 0.f, 0.f, 0.f, 0.f}, ob[8] = {0.f, 0.f, 0.f, 0.f, 0.f, 0.f, 0.f, 0.f};
    for (int gidx = 0; gidx < (DBG_SKIP_PEER ? 0 : 16); ++gidx) {
        u32x4 va[8], vb[8];
#pragma unroll
        for (int s = 0; s < 8; ++s) { const int sl = gidx * 8 + s; const int e = __builtin_amdgcn_readlane(sl < 64 ? id0 : id1, sl & 63);
            const bf16_t* vp = V + (size_t)e * DM + 8 * lane; va[s] = *(const u32x4*)vp; vb[s] = *(const u32x4*)(vp + 512); }
#pragma unroll
        for (int s = 0; s < 8; ++s) { const int sl = gidx * 8 + s;
            const float w = __builtin_bit_cast(float, __builtin_amdgcn_readlane(__builtin_bit_cast(int, sl < 64 ? w0 : w1), sl & 63));
            fma8(oa, va[s], w); fma8(ob, vb[s], w); }
    }
    const float* hp = hin + (size_t)tok * DM + 8 * lane;
    f32x4 ha0 = *(const f32x4*)hp, ha1 = *(const f32x4*)(hp + 4), hb0 = *(const f32x4*)(hp + 512), hb1 = *(const f32x4*)(hp + 516);
    ha0 += (f32x4){oa[0], oa[1], oa[2], oa[3]}; ha1 += (f32x4){oa[4], oa[5], oa[6], oa[7]}; hb0 += (f32x4){ob[0], ob[1], ob[2], ob[3]}; hb1 += (f32x4){ob[4], ob[5], ob[6], ob[7]};
    float ss = 0.f;
#pragma unroll
    for (int e = 0; e < 4; ++e) ss += ha0[e] * ha0[e] + ha1[e] * ha1[e] + hb0[e] * hb0[e] + hb1[e] * hb1[e];
    const float r = rsqrtf(wave_sum(ss) * (1.f / DM) + NORM_EPS);
    const float* gp = ngain + 8 * lane;
    const f32x4 ga0 = *(const f32x4*)gp, ga1 = *(const f32x4*)(gp + 4), gb0 = *(const f32x4*)(gp + 512), gb1 = *(const f32x4*)(gp + 516);
    if (final_out) {
        float* op = final_out + (size_t)tok * DM + 8 * lane;
        *(f32x4*)op = ha0 * r * ga0; *(f32x4*)(op + 4) = ha1 * r * ga1; *(f32x4*)(op + 512) = hb0 * r * gb0; *(f32x4*)(op + 516) = hb1 * r * gb1;
    } else {
        float* ho = hout + (size_t)tok * DM + 8 * lane;
        *(f32x4*)ho = ha0; *(f32x4*)(ho + 4) = ha1; *(f32x4*)(ho + 512) = hb0; *(f32x4*)(ho + 516) = hb1;
        u32x4 n0, n1;
        n0.x = cvt_pk_bf16(ha0[0] * r * ga0[0], ha0[1] * r * ga0[1]); n0.y = cvt_pk_bf16(ha0[2] * r * ga0[2], ha0[3] * r * ga0[3]);
        n0.z = cvt_pk_bf16(ha1[0] * r * ga1[0], ha1[1] * r * ga1[1]); n0.w = cvt_pk_bf16(ha1[2] * r * ga1[2], ha1[3] * r * ga1[3]);
        n1.x = cvt_pk_bf16(hb0[0] * r * gb0[0], hb0[1] * r * gb0[1]); n1.y = cvt_pk_bf16(hb0[2] * r * gb0[2], hb0[3] * r * gb0[3]);
        n1.z = cvt_pk_bf16(hb1[0] * r * gb1[0], hb1[1] * r * gb1[1]); n1.w = cvt_pk_bf16(hb1[2] * r * gb1[2], hb1[3] * r * gb1[3]);
        *(u32x4*)(hn_next + (size_t)tok * DM + 8 * lane) = n0; *(u32x4*)(hn_next + (size_t)tok * DM + 512 + 8 * lane) = n1;
    }
}

#define PHASE_BEGIN() \
    int tid = threadIdx.x; asm volatile("" : "+v"(tid)); \
    const int lane = tid & 63; const int wave = __builtin_amdgcn_readfirstlane(tid >> 6); \
    unsigned char* ws = p.ws; asm volatile("" : "+s"(ws)); \
    const int gw = vcu * NWAVES + wave, NGW = G * NWAVES; (void)lane; (void)gw; (void)NGW
__global__ void __launch_bounds__(NTHR, 2) fwd_kernel(Params p) {
    extern __shared__ __attribute__((aligned(16))) unsigned char lds_raw[];
    LAS unsigned char* lds = (LAS unsigned char*)lds_raw;
    const int G = gridDim.x; const int bx = blockIdx.x; const int vcu = (G % 8 == 0) ? (bx % 8) * (G / 8) + bx / 8 : bx;
    for (int u = threadIdx.x; u < (LDS_BYTES - RING_BYTES) / 4; u += NTHR) ((LAS unsigned*)(lds + RING_BYTES))[u] = 0u;
    __syncthreads();
    XcdBarrier bar; bar.bar = (unsigned*)(p.ws + WS_CTL) + CW_BAR; bar.x = 0; bar.st = nullptr;
    const int lo = p.ph_lo, hi = p.ph_hi;
    if ((hi - lo) > 1) bar = xcd_barrier_post((unsigned*)(p.ws + WS_CTL) + CW_BAR, (volatile LAS unsigned*)(lds + MISC_OFF) + 8);
    int ph = 0;
#define IN(k) (lo <= (k) && (k) < hi)
#define SEAM() do { if (IN(ph) && IN(ph + 1)) xcd_barrier(bar); ++ph; } while (0)

    if (PH_ON(0) && IN(ph)) {
        PHASE_BEGIN();
        LAS float* scr = (LAS float*)(lds + wave * 16384);
        constexpr int I_IN = 16 * 69, I_UQ = 6 * 24, I_UKV = 4 * 32, I_SQ = 16 * 32, I_CIN = 16 * 64, I_PQ = 16 * 64;
        constexpr int PER2 = I_IN + I_UQ + I_UKV + I_SQ + I_CIN + I_SQ;
        constexpr int NITEMS = 2 * PER2 + 4 * I_PQ;
        for (int it = gw; it < NITEMS; it += NGW) {
            if (it < 2 * PER2) { const int i = it / PER2; int r = it % PER2;
                if (r < I_IN) { transpose_item<0>(p.in[5] + (size_t)i * 1024 * NPROJ, 1024, NPROJ, (bf16_t*)(ws + WS_WIN) + (size_t)i * NPROJP * 1024, scr, r, lane); continue; } r -= I_IN;
                if (r < I_UQ) { transpose_item<0>(p.in[7] + (size_t)i * 384 * 768, 384, 768, (bf16_t*)(ws + WS_WUQ) + (size_t)i * 768 * 384, scr, r, lane); continue; } r -= I_UQ;
                if (r < I_UKV) { transpose_item<0>(p.in[9] + (size_t)i * 256 * 1024, 256, 1024, (bf16_t*)(ws + WS_WUKV) + (size_t)i * 1024 * 256, scr, r, lane); continue; } r -= I_UKV;
                if (r < I_SQ) { transpose_item<0>(p.in[10] + (size_t)i * 1024 * 1024, 1024, 1024, (bf16_t*)(ws + WS_WOUT) + (size_t)i * 1024 * 1024, scr, r, lane); continue; } r -= I_SQ;
                if (r < I_CIN) { transpose_item<1>(p.in[11] + (size_t)i * 1024 * 2048, 1024, 2048, (bf16_t*)(ws + WS_WCIN) + (size_t)i * 2048 * 1024, scr, r, lane); continue; } r -= I_CIN;
                transpose_item<0>(p.in[17] + (size_t)i * 1024 * 1024, 1024, 1024, (bf16_t*)(ws + WS_WCOUT) + (size_t)i * 1024 * 1024, scr, r, lane);
            } else { const int r2 = it - 2 * PER2, l = r2 / I_PQ, r = r2 % I_PQ;
                transpose_item<0>(p.in[19] + (size_t)l * 1024 * 2048, 1024, 2048, (bf16_t*)(ws + WS_WPQ) + (size_t)l * 2048 * 1024, scr, r, lane); }
        }
        { const size_t gt = (size_t)vcu * NTHR + tid, NGT = (size_t)G * NTHR;
          const size_t n_sub = (size_t)4 * 8 * 2 * 128 * 128 / 8, n_tab = (size_t)4 * 16384 * 1024 / 8;
          for (size_t i = gt; i < n_sub + 2 * n_tab; i += NGT) {
              const float* src; bf16_t* dst; size_t j;
              if (i < n_sub) { src = p.in[20]; dst = (bf16_t*)(ws + WS_SUBK); j = i; }
              else if (i < n_sub + n_tab) { src = p.in[21]; dst = (bf16_t*)(ws + WS_U16); j = i - n_sub; }
              else { src = p.in[22]; dst = (bf16_t*)(ws + WS_V16); j = i - n_sub - n_tab; }
              const f32x4 a = *(const f32x4*)(src + j * 8), b = *(const f32x4*)(src + j * 8 + 4);
              u32x4 o; o.x = cvt_pk_bf16(a[0], a[1]); o.y = cvt_pk_bf16(a[2], a[3]); o.z = cvt_pk_bf16(b[0], b[1]); o.w = cvt_pk_bf16(b[2], b[3]);
              *(u32x4*)(dst + j * 8) = o; } }
        { const int* positions = (const int*)p.in[1];
          float* cosr = (float*)(ws + WS_COSR); float* sinr = (float*)(ws + WS_SINR); float* cosm = (float*)(ws + WS_COSM); float* sinm = (float*)(ws + WS_SINM);
          const int gt = vcu * NTHR + tid, NGT = G * NTHR;
          for (int k = 0; k < 48; ++k) { const double inv = (k < 16) ? p.inv_r[k & 15] : p.inv_m[(k - 16) & 31];
              for (int row = gt; row < TT; row += NGT) { double rev = (double)positions[row] * inv * 0.15915494309189533577; rev -= floor(rev);
                  const float rf = (float)rev; const float c = __builtin_amdgcn_cosf(rf), sn = __builtin_amdgcn_sinf(rf);
                  if (k < 16) { cosr[row * 16 + k] = c; sinr[row * 16 + k] = sn; } else { cosm[row * 32 + (k - 16)] = c; sinm[row * 32 + (k - 16)] = sn; } } } }
        for (int m = gw; m < TT; m += NGW) rms_row_to_bf16(p.in[0] + (size_t)m * DM, p.in[2], (bf16_t*)(ws + WS_HN) + (size_t)m * DM, lane);
    }
    SEAM();

    for (int layer = 0; layer < 4; ++layer) {
        const int li = layer >> 1;
        if ((layer & 1) == 0) {
            if (PH_ON(1) && IN(ph)) { PHASE_BEGIN();
                pg8::Gemm g{(const bf16_t*)(ws + WS_HN), (const bf16_t*)(ws + WS_WIN) + (size_t)li * NPROJP * 1024, TT, NPROJP, 1024}; pg8::StaticOrder S; S.init(TT, NPROJP, G, bx);
                EpiPlain E{(bf16_t*)(ws + WS_PROJ), NPROJP}; pg8::gemm_phase<EpiPlain, pg8::StaticOrder, true, true>(lds, g, S, E); }
            SEAM();
            if (PH_ON(2) && IN(ph)) { PHASE_BEGIN();
                for (int u = vcu; u < TT / 64; u += G)
                    token_prep_unit(lds, u, (const bf16_t*)(ws + WS_PROJ), p.in[6] + li * 384, p.in[8] + li * 256, (const float*)(ws + WS_COSR), (const float*)(ws + WS_SINR), (const float*)(ws + WS_COSM), (const float*)(ws + WS_SINM),
                                    (bf16_t*)(ws + WS_CQN), (bf16_t*)(ws + WS_CKVN), (bf16_t*)(ws + WS_KM), (bf16_t*)(ws + WS_MQ), (bf16_t*)(ws + WS_MK), (float*)(ws + WS_KPART), wave, lane); }
            SEAM();
            if (PH_ON(3) && IN(ph)) { PHASE_BEGIN();
#if !defined(E3_SKIP_A)
                { pg8::Gemm g{(const bf16_t*)(ws + WS_CQN), (const bf16_t*)(ws + WS_WUQ) + (size_t)li * 768 * 384, TT, 768, 384}; pg8::StaticOrder S; S.init(TT, 768, G, bx);
                  EpiQup E{(bf16_t*)(ws + WS_QM), (const float*)(ws + WS_COSR), (const float*)(ws + WS_SINR), 0.10206207261596577f * LOG2E}; pg8::gemm_phase<EpiQup, pg8::StaticOrder, true, true>(lds, g, S, E); }
#endif
#if !defined(E3_SKIP_B)
                { pg8::Gemm g{(const bf16_t*)(ws + WS_CKVN), (const bf16_t*)(ws + WS_WUKV) + (size_t)li * 1024 * 256, TT, 1024, 256}; pg8::StaticOrder S; S.init(TT, 1024, G, bx);
                  EpiKVup E{(bf16_t*)(ws + WS_KM), (bf16_t*)(ws + WS_VM)}; pg8::gemm_phase<EpiKVup, pg8::StaticOrder, true, true>(lds, g, S, E); }
#endif
            }
            SEAM();
            if (PH_ON(4) && IN(ph)) { PHASE_BEGIN();
                bf16_t* QM = (bf16_t*)(ws + WS_QM); bf16_t* KM = (bf16_t*)(ws + WS_KM); bf16_t* VM = (bf16_t*)(ws + WS_VM); bf16_t* MQ = (bf16_t*)(ws + WS_MQ); bf16_t* MK = (bf16_t*)(ws + WS_MK);
                bf16_t* OB = (bf16_t*)(ws + WS_OB); const bf16_t* PROJ = (const bf16_t*)(ws + WS_PROJ); const float* kpart = (const float*)(ws + WS_KPART);
                for (int v = vcu; v < 256; v += G) { const int bh = v >> 4, s = v & 15, b = bh >> 3, h = bh & 7; const size_t rb = (size_t)b * SEQ;
                    for (int k = 0; k < 2; ++k) { const int qb = k ? 31 - s : s;
                        attn_unit<96, false>(lds, QM + rb * 768 + h * 96, 768, KM + rb * 768 + h * 96, 768, VM + rb * 512 + h * 64, 512, OB + rb * 1024 + h * 64, 1024, qb, nullptr);
                        attn_unit<64, true>(lds, MQ + rb * 512 + h * 64, 512, MK + rb * 512 + h * 64, 512, PROJ + rb * NPROJP + 1696 + h * 64, NPROJP, OB + rb * 1024 + 512 + h * 64, 1024, qb,
                                            kpart + (size_t)b * 32 * 4 * 512 + h * 64); } }
            }
            SEAM();
            if (PH_ON(5) && IN(ph)) { PHASE_BEGIN();
                pg8::Gemm g{(const bf16_t*)(ws + WS_OB), (const bf16_t*)(ws + WS_WOUT) + (size_t)li * 1024 * 1024, TT, 1024, 1024}; pg8::StaticOrder S; S.init(TT, 1024, G, bx);
                EpiResid E{layer == 0 ? p.in[0] : (const float*)(ws + WS_H1), (float*)(ws + WS_H0), nullptr, DBG_SKIP_ATTN}; pg8::gemm_phase<EpiResid, pg8::StaticOrder, true, true>(lds, g, S, E); }
            SEAM();
        } else {
            if (PH_ON(6) && IN(ph)) { PHASE_BEGIN();
                pg8::Gemm g{(const bf16_t*)(ws + WS_HN), (const bf16_t*)(ws + WS_WCIN) + (size_t)li * 2048 * 1024, TT, 2048, 1024}; pg8::StaticOrder S; S.init(TT, 2048, G, bx);
                EpiGlu E{(bf16_t*)(ws + WS_UG), p.in[12] + li * 2048}; pg8::gemm_phase<EpiGlu, pg8::StaticOrder, true, true>(lds, g, S, E); }
            SEAM();
            if (PH_ON(7) && IN(ph)) { PHASE_BEGIN();
                float w[31][2];
                const float* wd = p.in[13] + (size_t)li * 31 * 1024;
#pragma unroll
                for (int j = 0; j < 31; ++j) { const f32x2 t2 = *(const f32x2*)(wd + j * 1024 + 2 * tid); w[j][0] = t2.x; w[j][1] = t2.y; }
                const f32x2 bb = *(const f32x2*)(p.in[14] + li * 1024 + 2 * tid), gg = *(const f32x2*)(p.in[15] + li * 1024 + 2 * tid), be = *(const f32x2*)(p.in[16] + li * 1024 + 2 * tid);
                for (int u = vcu; u < TT / 16; u += G) dwconv_unit(lds, u, (const bf16_t*)(ws + WS_UG), w, bb.x, bb.y, gg.x, gg.y, be.x, be.y, (bf16_t*)(ws + WS_YB), tid);
            }
            SEAM();
            if (PH_ON(8) && IN(ph)) { PHASE_BEGIN();
                pg8::Gemm g{(const bf16_t*)(ws + WS_YB), (const bf16_t*)(ws + WS_WCOUT) + (size_t)li * 1024 * 1024, TT, 1024, 1024}; pg8::StaticOrder S; S.init(TT, 1024, G, bx);
                EpiResid E{(const float*)(ws + WS_H1), (float*)(ws + WS_H0), p.in[18] + li * 1024, DBG_SKIP_CONV}; pg8::gemm_phase<EpiResid, pg8::StaticOrder, true, true>(lds, g, S, E); }
            SEAM();
        }
        if (PH_ON(9) && IN(ph)) { PHASE_BEGIN();
            for (int m = gw; m < TT; m += NGW) rms_row_to_bf16((const float*)(ws + WS_H0) + (size_t)m * DM, p.in[3] + layer * DM, (bf16_t*)(ws + WS_HN) + (size_t)m * DM, lane); }
        SEAM();
        if (PH_ON(10) && IN(ph)) { PHASE_BEGIN();
            pg8::Gemm g{(const bf16_t*)(ws + WS_HN), (const bf16_t*)(ws + WS_WPQ) + (size_t)layer * 2048 * 1024, TT, 2048, 1024}; pg8::StaticOrder S; S.init(TT, 2048, G, bx);
            EpiPlain E{(bf16_t*)(ws + WS_Q2), 2048}; pg8::gemm_phase<EpiPlain, pg8::StaticOrder, true, true>(lds, g, S, E); }
        SEAM();
        if (PH_ON(11) && IN(ph)) { PHASE_BEGIN();
            const bf16_t* subk = (const bf16_t*)(ws + WS_SUBK) + (size_t)layer * 8 * 2 * 128 * 128;
            LAS unsigned* dec = (LAS unsigned*)(lds + 65536 + wave * 2048);
            for (int v = vcu; v < 256; v += G) { const int h = v & 7, tg = v >> 3;
                for (int e = tid; e < 2 * 128 * 16; e += NTHR) { const int c = e >> 11, key = (e >> 4) & 127, ch = e & 15;
                    *(LAS u32x4*)(lds + c * 32768 + ch * 2048 + key * 16) = *(const u32x4*)(subk + ((size_t)(h * 2 + c) * 128 + key) * 128 + ch * 8); }
                __syncthreads();
                for (int i = 0; i < 2; ++i) peer_topk_unit(lds, dec, (const bf16_t*)(ws + WS_Q2), tg * 16 + wave * 2 + i, h, (int*)(ws + WS_IDX), (float*)(ws + WS_GATE), lane);
                __syncthreads();
            }
        }
        SEAM();
        if (PH_ON(12) && IN(ph)) { PHASE_BEGIN();
            const bf16_t* U = (const bf16_t*)(ws + WS_U16) + (size_t)layer * 16384 * 1024; const bf16_t* V = (const bf16_t*)(ws + WS_V16) + (size_t)layer * 16384 * 1024;
            const bool lastl = (layer == 3);
            const float* ng = lastl ? p.in[4] : p.in[2] + (layer + 1) * DM;
            for (int tok = gw; tok < TT; tok += NGW)
                peer_gather_token(tok, (const bf16_t*)(ws + WS_HN), (const int*)(ws + WS_IDX), (const float*)(ws + WS_GATE), U, V, (const float*)(ws + WS_H0), (float*)(ws + WS_H1), ng,
                                  (bf16_t*)(ws + WS_HN), lastl ? p.out : nullptr, lane);
        }
        SEAM();
    }
#undef IN
#undef SEAM
}

extern "C" void kernel_launch(void* const* d_in, const int* in_sizes, int n_in, void* d_out, int out_size, void* d_ws, size_t ws_size, hipStream_t stream) {
    static int grid = 0;
    if (grid == 0) {
        if (n_in != 23 || out_size != TT * DM || ws_size < WS_END) { fprintf(stderr, "kernel_launch: unexpected shapes (n_in %d out %d ws %zu)\n", n_in, out_size, ws_size); grid = -1; return; }
        int dev = 0, cus = 0, per_cu = 0;
        if (hipGetDevice(&dev) != hipSuccess || hipDeviceGetAttribute(&cus, hipDeviceAttributeMultiprocessorCount, dev) != hipSuccess) { grid = -1; return; }
        if (hipFuncSetAttribute((const void*)fwd_kernel, hipFuncAttributeMaxDynamicSharedMemorySize, LDS_BYTES) != hipSuccess) { fprintf(stderr, "kernel_launch: hipFuncSetAttribute failed\n"); grid = -1; return; }
        if (hipOccupancyMaxActiveBlocksPerMultiprocessor(&per_cu, (const void*)fwd_kernel, NTHR, LDS_BYTES) != hipSuccess || per_cu < 1) fprintf(stderr, "kernel_launch: occupancy query says %d\n", per_cu);
        (void)hipGetLastError();
        grid = cus;
    }
    if (grid < 0) return;
    (void)hipMemsetAsync((char*)d_ws + WS_CTL, 0, CTL_ZERO_BYTES, stream);
    Params p;
    memset(&p, 0, sizeof(p));
    for (int i = 0; i < 23; ++i) p.in[i] = (const float*)d_in[i];
    p.out = (float*)d_out; p.ws = (unsigned char*)d_ws;
    for (int k = 0; k < 16; ++k) p.inv_r[k] = pow(10000.0, -(double)(2 * k) / 32.0);
    for (int k = 0; k < 32; ++k) p.inv_m[k] = pow(10000.0, -(double)(2 * k) / 64.0);
#if MK_ONE_LAUNCH
    p.ph_lo = 0; p.ph_hi = 1000;
    hipLaunchKernelGGL(fwd_kernel, dim3(grid), dim3(NTHR), LDS_BYTES, stream, p);
#else
    for (int k = 0; k < 33; ++k) { p.ph_lo = k; p.ph_hi = k + 1; hipLaunchKernelGGL(fwd_kernel, dim3(grid), dim3(NTHR), LDS_BYTES, stream, p); }
#endif
}
```

```cpp
#include <hip/hip_runtime.h>
#include <cstdio>
#include <cstdint>
#include <cstring>
#include <cmath>

#ifndef ATTN_SP
#define ATTN_SP 1
#endif
#ifndef REP_EPI
#define REP_EPI 0
#endif
#ifndef PHMASK
#define PHMASK 0xFFFF
#endif
#define PH_ON(n) ((PHMASK >> (n)) & 1)
#ifndef DBG_SKIP_ATTN
#define DBG_SKIP_ATTN 0
#endif
#ifndef DBG_SKIP_CONV
#define DBG_SKIP_CONV 0
#endif
#ifndef DBG_SKIP_PEER
#define DBG_SKIP_PEER 0
#endif
#ifndef PROBE_SELA
#define PROBE_SELA 0ull
#endif
#ifndef PROBE_SELB
#define PROBE_SELB 0ull
#endif
#define PROBE_ON ((PROBE_SELA | PROBE_SELB) != 0ull)
constexpr int CW_TS = 16384;
#ifndef PGR
#define PGR 4
#endif
#ifndef DBG_PEER_NOISE
#define DBG_PEER_NOISE 0.0f
#endif
#ifndef DBG_MOBA_NOISE
#define DBG_MOBA_NOISE 0.0f
#endif
#ifndef REP_V
#define REP_V 1
#endif
#ifndef REP_U
#define REP_U 1
#endif
#ifndef DBG_VREP
#define DBG_VREP 0
#endif
#ifndef DBG_VREP_MASK
#define DBG_VREP_MASK 1023
#endif
#ifndef MOBA_GATHER
#define MOBA_GATHER 1
#endif
#ifndef DBG_MOBA_CHECK
#define DBG_MOBA_CHECK 0
#endif
#ifndef DBG_NAIVE_CHECK
#define DBG_NAIVE_CHECK 0
#endif
#ifndef DBG_CTRL_SCALE
#define DBG_CTRL_SCALE 1.0f
#endif
constexpr int CW_DIFF = 20480;
#ifndef MK_ONE_LAUNCH
#define MK_ONE_LAUNCH 1
#endif

#define LAS __attribute__((address_space(3)))
#define GAS __attribute__((address_space(1)))
typedef unsigned short bf16_t;
typedef short bf16x8 __attribute__((ext_vector_type(8)));
typedef short s16x4 __attribute__((ext_vector_type(4)));
typedef short v4i16_t __attribute__((ext_vector_type(4)));
typedef float f32x2 __attribute__((ext_vector_type(2)));
typedef float f32x4 __attribute__((ext_vector_type(4)));
typedef float f32x16 __attribute__((ext_vector_type(16)));
typedef unsigned u32x2 __attribute__((ext_vector_type(2)));
typedef unsigned u32x4 __attribute__((ext_vector_type(4)));
#define DI __device__ __forceinline__

constexpr int TT = 16384, SEQ = 8192, DM = 1024;
constexpr int NPROJ = 2208, NPROJP = 2304;
constexpr float NORM_EPS = 1e-6f;
constexpr float LOG2E = 1.4426950408889634f;
constexpr int NWAVES = 8, NTHR = 512;

constexpr size_t MiB = 1u << 20;
constexpr size_t WS_CTL = 0, CTL_ZERO_BYTES = 1 * MiB;
constexpr size_t WS_COSR = 2 * MiB, WS_SINR = 3 * MiB, WS_COSM = 4 * MiB, WS_SINM = 6 * MiB;
constexpr size_t WS_KPART = 8 * MiB;
constexpr size_t WS_WIN = 10 * MiB;
constexpr size_t WS_WUQ = 19 * MiB;
constexpr size_t WS_WUKV = 21 * MiB;
constexpr size_t WS_WOUT = 22 * MiB;
constexpr size_t WS_WCIN = 26 * MiB;
constexpr size_t WS_WCOUT = 34 * MiB;
constexpr size_t WS_WPQ = 38 * MiB;
constexpr size_t WS_SUBK = 54 * MiB;
constexpr size_t WS_SU = 56 * MiB;
constexpr size_t WS_SV = 57 * MiB;
constexpr size_t WS_U8 = 64 * MiB;
constexpr size_t WS_V8 = 128 * MiB;
constexpr size_t WS_H0 = 320 * MiB;
constexpr size_t WS_H1 = 384 * MiB;
constexpr size_t WS_HN = 448 * MiB;
constexpr size_t WS_PROJ = 480 * MiB;
constexpr size_t WS_CQN = 552 * MiB;
constexpr size_t WS_CKVN = 564 * MiB;
constexpr size_t WS_QM = 572 * MiB;
constexpr size_t WS_KM = 596 * MiB;
constexpr size_t WS_VM = 620 * MiB;
constexpr size_t WS_MQ = 636 * MiB;
constexpr size_t WS_MK = 652 * MiB;
constexpr size_t WS_OB = 668 * MiB;
constexpr size_t WS_Q2 = 700 * MiB;
constexpr size_t WS_IDX = 764 * MiB;
constexpr size_t WS_GATE = 772 * MiB;
constexpr size_t WS_UG = 780 * MiB;
constexpr size_t WS_YB = 812 * MiB;
constexpr size_t WS_XQ = 844 * MiB;
constexpr size_t WS_SX = 860 * MiB;
constexpr size_t WS_ACT = 861 * MiB;
constexpr size_t WS_ENT = 872 * MiB;
constexpr size_t WS_HB = 936 * MiB;
constexpr size_t WS_SS = 968 * MiB;
constexpr size_t WS_SS16 = 969 * MiB;
constexpr size_t WS_MENT = WS_Q2;
constexpr size_t WS_PM = WS_Q2 + 16 * MiB;
constexpr size_t WS_MSEL = WS_Q2 + 20 * MiB;
constexpr size_t WS_PO = WS_UG;
constexpr size_t WS_END = 970 * MiB;
constexpr int CW_MCNT = 32768;
constexpr int ENT_CAP = 1 << 21;
constexpr int CW_CNT = 24576;
constexpr int CW_BAR = 4096;

constexpr int RING_BYTES = 131072;
constexpr int MISC_OFF = RING_BYTES + 320;
constexpr int LDS_BYTES = 147456;

typedef __bf16 bf16n2 __attribute__((ext_vector_type(2)));
typedef float f32n2 __attribute__((ext_vector_type(2)));
DI unsigned cvt_pk_bf16_b(float lo, float hi) { const f32n2 v = {lo, hi}; return __builtin_bit_cast(unsigned, __builtin_convertvector(v, bf16n2)); }
DI unsigned cvt_pk_bf16(float lo, float hi) { unsigned r; asm volatile("v_cvt_pk_bf16_f32 %0, %1, %2" : "=v"(r) : "v"(lo), "v"(hi)); return r; }
DI float bf_lo(unsigned u) { return __builtin_bit_cast(float, u << 16); }
DI float bf_hi(unsigned u) { return __builtin_bit_cast(float, u & 0xffff0000u); }
DI float bf1(bf16_t b) { return __builtin_bit_cast(float, ((unsigned)b) << 16); }
#define DPP_F(v, ctrl) __builtin_bit_cast(float, __builtin_amdgcn_update_dpp(0, __builtin_bit_cast(int, (v)), (ctrl), 0xF, 0xF, false))
DI float wave_sum(float v) {
    v += DPP_F(v, 0xB1); v += DPP_F(v, 0x4E); v += DPP_F(v, 0x141); v += DPP_F(v, 0x140);
    auto a = __builtin_amdgcn_permlane16_swap(__float_as_uint(v), __float_as_uint(v), false, false); const unsigned a0 = a[0], a1 = a[1];
    v = __uint_as_float(a0) + __uint_as_float(a1);
    auto b = __builtin_amdgcn_permlane32_swap(__float_as_uint(v), __float_as_uint(v), false, false); const unsigned b0 = b[0], b1 = b[1];
    return __uint_as_float(b0) + __uint_as_float(b1);
}
DI int bperm(int v, int src) { return __builtin_amdgcn_ds_bpermute(src << 2, v); }
DI float xchg32(float v, bool lo_half) {
    auto a = __builtin_amdgcn_permlane32_swap(__float_as_uint(v), __float_as_uint(v), false, false); const unsigned a0 = a[0], a1 = a[1];
    return __uint_as_float(lo_half ? a1 : a0);
}
DI float xsum_16_32(float v) {
    auto a = __builtin_amdgcn_permlane16_swap(__float_as_uint(v), __float_as_uint(v), false, false); const unsigned a0 = a[0], a1 = a[1];
    v = __uint_as_float(a0) + __uint_as_float(a1);
    auto b = __builtin_amdgcn_permlane32_swap(__float_as_uint(v), __float_as_uint(v), false, false); const unsigned b0 = b[0], b1 = b[1];
    return __uint_as_float(b0) + __uint_as_float(b1);
}
#define LDS_WAIT() asm volatile("s_waitcnt lgkmcnt(0)" ::: "memory")
DI unsigned pack4_i8(float a, float b, float c, float d, float inv, int off) {
    const int qa = __float2int_rn(a * inv) + off, qb = __float2int_rn(b * inv) + off, qc = __float2int_rn(c * inv) + off, qd = __float2int_rn(d * inv) + off;
    return (unsigned)(qa & 255) | ((unsigned)(qb & 255) << 8) | ((unsigned)(qc & 255) << 16) | ((unsigned)(qd & 255) << 24);
}
DI float wave_max_all(float v) {
    v = fmaxf(v, DPP_F(v, 0xB1)); v = fmaxf(v, DPP_F(v, 0x4E)); v = fmaxf(v, DPP_F(v, 0x141)); v = fmaxf(v, DPP_F(v, 0x140));
    auto a = __builtin_amdgcn_permlane16_swap(__float_as_uint(v), __float_as_uint(v), false, false); const unsigned a0 = a[0], a1 = a[1];
    v = fmaxf(__uint_as_float(a0), __uint_as_float(a1));
    auto b = __builtin_amdgcn_permlane32_swap(__float_as_uint(v), __float_as_uint(v), false, false); const unsigned b0 = b[0], b1 = b[1];
    return fmaxf(__uint_as_float(b0), __uint_as_float(b1));
}
DI float hash_noise(unsigned a) { a ^= a >> 16; a *= 0x7feb352du; a ^= a >> 15; a *= 0x846ca68bu; a ^= a >> 16; return (float)(a >> 8) * (1.f / 8388608.f) - 1.f; }
DI u32x4 ldg_u4(const void* p) { return *(const GAS u32x4*)p; }
DI f32x4 ldg_f4(const void* p) { return *(const GAS f32x4*)p; }
DI f32x2 ldg_f2(const void* p) { return *(const GAS f32x2*)p; }
DI float ldg_f(const void* p) { return *(const GAS float*)p; }
DI int ldg_i(const void* p) { return *(const GAS int*)p; }
DI void stg_u4(void* p, u32x4 v) { *(GAS u32x4*)p = v; }
DI void stg_f4(void* p, f32x4 v) { *(GAS f32x4*)p = v; }
DI __amdgpu_buffer_rsrc_t mk_rsrc(const void* p) {
    const unsigned long long a = (unsigned long long)p; const unsigned lo = __builtin_amdgcn_readfirstlane((unsigned)a), hi = __builtin_amdgcn_readfirstlane((unsigned)(a >> 32));
    return __builtin_amdgcn_make_buffer_rsrc((void*)(((unsigned long long)hi << 32) | lo), 0, 0x7fffffff, 0x00020000);
}
DI u32x4 ldb_u4(__amdgpu_buffer_rsrc_t rs, int off) { return __builtin_bit_cast(u32x4, __builtin_amdgcn_raw_buffer_load_b128(rs, off, 0, 0)); }
DI u32x4 ldb_u4s(__amdgpu_buffer_rsrc_t rs, int voff, int soff) { return __builtin_bit_cast(u32x4, __builtin_amdgcn_raw_buffer_load_b128(rs, voff, soff, 0)); }

namespace pg8 {
constexpr int BM = 256, BK = 64, HALF = 128, HTB = HALF * BK * 2, STAGE_BYTES = 8 * HTB, NXCD = 8, WGM = 8;
__host__ __device__ __forceinline__ int lds_byte(int r, int c) { const int st = (r >> 4) * 2 + (c >> 5), rr = r & 15, cc = c & 31, ob = rr * 64 + cc * 2; return st * 1024 + (ob ^ (((ob >> 9) & 1) << 5)); }
__host__ __device__ __forceinline__ void stage_rc(int b, int& R, int& C) { const int st = b / 1024, sb = b % 1024, swz = sb ^ (((sb >> 9) & 1) << 5); R = (st >> 1) * 16 + swz / 64; C = (st & 1) * 32 + (swz % 64) / 2; }
__host__ __device__ __forceinline__ int perm32(int rho) { const int n = rho >> 4, i = rho & 15; return 8 * (i >> 2) + 4 * n + (i & 3); }
struct Unit { int pm, pn; };
struct Gemm { const bf16_t* A; const bf16_t* Bt; int M, N, K; };
struct StaticOrder {
    int nM, nN, nwg, G, c;
    __host__ __device__ void init(int M, int N, int G_, int c_) { nM = M / BM; nN = N / BM; nwg = nM * nN; G = G_; c = c_; }
    __host__ __device__ bool next(int i, Unit& u) const {
        const long L = (long)i * G + c; if (L >= nwg) return false;
        int wgid = (int)L; { const int q = nwg / NXCD, r = nwg % NXCD, xcd = wgid % NXCD, off = wgid / NXCD; wgid = (xcd < r ? xcd * (q + 1) : r * (q + 1) + (xcd - r) * q) + off; }
        const int nig = WGM * nN, gid = wgid / nig, fm = gid * WGM, gsz = (nM - fm) < WGM ? (nM - fm) : WGM;
        u.pm = fm + ((wgid % nig) % gsz); u.pn = (wgid % nig) / gsz; return true;
    }
    __device__ __forceinline__ void a_ready(const Unit&) const {}
    __device__ __forceinline__ void done(const Unit&) const {}
};
template <class Epi, class Sched, bool ALIGN_EPI = false, bool SP2 = false>
__device__ __forceinline__ void gemm_phase(LAS unsigned char* lds, const Gemm g, const Sched& S, const Epi& E) {
    int tid_o = threadIdx.x; asm volatile("" : "+v"(tid_o));
    const int tid = tid_o, wid = __builtin_amdgcn_readfirstlane(tid >> 6), lane = tid & 63, wr = wid >> 2, wc = wid & 3, fr = lane & 15, fq = lane >> 4;
    const int K = g.K, nt = K / BK;
    unsigned voffA[2], voffB[2];
#pragma unroll
    for (int i = 0; i < 2; ++i) { int R, C; stage_rc(tid * 16 + i * 8192, R, C); const int Rb = Epi::PERM ? ((R & ~31) + perm32(R & 31)) : R;
        voffA[i] = (unsigned)(R * K + C) * 2u; voffB[i] = (unsigned)(Rb * K + C) * 2u; }
    const size_t kstep = (size_t)(BK * 2);
    const size_t hstep = (size_t)HALF * K * 2;
    const size_t tstep = 2 * hstep;
    const unsigned ldsw = (unsigned)wid * 1024u;
    const int aoff = lds_byte(wr * 64 + fr, fq * 8), boff = lds_byte(wc * 32 + fr, fq * 8);
#define PG8_SA(b, h) (((b) * 2 + (h)) * HTB)
#define PG8_SB(b, h) ((4 + (b) * 2 + (h)) * HTB)
#define PG8_STAGE(bufoff, gbase, voff) do { _Pragma("unroll") for (int _i = 0; _i < 2; ++_i) \
        __builtin_amdgcn_global_load_lds((const unsigned*)((const char*)(gbase) + (voff)[_i]), (LAS unsigned*)(lds + (bufoff) + ldsw + _i * 8192), 16, 0, 0); } while (0)
#define PG8_LDA(dst, b, h) do { _Pragma("unroll") for (int m = 0; m < 4; ++m) _Pragma("unroll") for (int k = 0; k < 2; ++k) dst[m][k] = *(const LAS bf16x8*)(lds + PG8_SA(b, h) + aoff + m * 2048 + k * 1024); } while (0)
#define PG8_LDB(dst, b, h) do { _Pragma("unroll") for (int n = 0; n < 2; ++n) _Pragma("unroll") for (int k = 0; k < 2; ++k) dst[n][k] = *(const LAS bf16x8*)(lds + PG8_SB(b, h) + boff + n * 2048 + k * 1024); } while (0)
#define PG8_MMA(ai, bj, At, Bt) do { __builtin_amdgcn_s_setprio(1); _Pragma("unroll") for (int m = 0; m < 4; ++m) _Pragma("unroll") for (int n = 0; n < 2; ++n) _Pragma("unroll") for (int k = 0; k < 2; ++k) \
        acc[ai][bj][m][n] = __builtin_amdgcn_mfma_f32_16x16x32_bf16(Bt[n][k], At[m][k], acc[ai][bj][m][n], 0, 0, 0); __builtin_amdgcn_s_setprio(0); } while (0)
#define PG8_WAIT_V(n) asm volatile("s_waitcnt vmcnt(" #n ")" ::: "memory")
#define PG8_WAIT_L(n) asm volatile("s_waitcnt lgkmcnt(" #n ")" ::: "memory")
#define PG8_BAR __builtin_amdgcn_s_barrier()
#define PG8_SCHED __builtin_amdgcn_sched_barrier(0)
    Unit cur, nxt; int ui = 0;
    if (!S.next(0, cur)) return;
    f32x4 acc[2][2][4][2];
#pragma unroll
    for (int a = 0; a < 2; ++a)
#pragma unroll
        for (int b = 0; b < 2; ++b)
#pragma unroll
            for (int m = 0; m < 4; ++m)
#pragma unroll
                for (int n = 0; n < 2; ++n) acc[a][b][m][n] = (f32x4){0.f, 0.f, 0.f, 0.f};
    bf16x8 At[4][2], B0[2][2], B1[2][2];
    const char* cA = (const char*)g.A + (size_t)cur.pm * tstep; const char* cB = (const char*)g.Bt + (size_t)cur.pn * tstep;
    S.a_ready(cur);
    if constexpr (SP2) {
        PG8_STAGE(PG8_SB(0, 0), cB, voffB); PG8_STAGE(PG8_SB(0, 1), cB + hstep, voffB); PG8_STAGE(PG8_SA(0, 0), cA, voffA); PG8_STAGE(PG8_SA(0, 1), cA + hstep, voffA);
        if (wr == 1) PG8_BAR;
        PG8_WAIT_V(2); PG8_BAR;
        PG8_STAGE(PG8_SB(1, 0), cB + kstep, voffB); PG8_STAGE(PG8_SA(1, 0), cA + kstep, voffA); PG8_STAGE(PG8_SB(1, 1), cB + hstep + kstep, voffB);
        PG8_WAIT_V(6); PG8_BAR;
    } else {
        PG8_STAGE(PG8_SB(0, 0), cB, voffB); PG8_STAGE(PG8_SA(0, 0), cA, voffA); PG8_STAGE(PG8_SB(0, 1), cB + hstep, voffB); PG8_STAGE(PG8_SA(0, 1), cA + hstep, voffA);
        if (wr == 1) PG8_BAR;
        PG8_WAIT_V(4); PG8_BAR;
        PG8_STAGE(PG8_SB(1, 0), cB + kstep, voffB); PG8_STAGE(PG8_SA(1, 0), cA + kstep, voffA); PG8_STAGE(PG8_SB(1, 1), cB + hstep + kstep, voffB);
        PG8_WAIT_V(6); PG8_BAR;
    }
    for (;;) {
        const bool has_next = S.next(ui + 1, nxt);
        const char* nA = has_next ? (const char*)g.A + (size_t)nxt.pm * tstep : cA; const char* nB = has_next ? (const char*)g.Bt + (size_t)nxt.pn * tstep : cB;
#pragma nounroll
        for (int t = 0; t < nt; t += 2) {
            const bool last = (t == nt - 2);
            const char* a1 = cA + (size_t)(t + 1) * kstep;
            const char* a2 = last ? nA : cA + (size_t)(t + 2) * kstep; const char* b2 = last ? nB : cB + (size_t)(t + 2) * kstep;
            const char* a3 = a2 + kstep; const char* b3 = b2 + kstep;
            if (last && has_next) S.a_ready(nxt);
            if constexpr (SP2) {
            PG8_LDB(B0, 0, 0); PG8_LDB(B1, 0, 1); PG8_SCHED; PG8_LDA(At, 0, 0); PG8_STAGE(PG8_SA(1, 1), a1 + hstep, voffA);
            PG8_WAIT_V(8); PG8_WAIT_L(0); PG8_BAR; PG8_MMA(0, 0, At, B0); PG8_MMA(0, 1, At, B1); PG8_BAR; PG8_SCHED;
            PG8_LDA(At, 0, 1); PG8_STAGE(PG8_SB(0, 0), b2, voffB); PG8_STAGE(PG8_SB(0, 1), b2 + hstep, voffB); PG8_STAGE(PG8_SA(0, 0), a2, voffA);
            PG8_WAIT_V(8); PG8_WAIT_L(0); PG8_BAR; PG8_MMA(1, 0, At, B0); PG8_MMA(1, 1, At, B1); PG8_BAR; PG8_SCHED;
            PG8_LDB(B0, 1, 0); PG8_LDB(B1, 1, 1); PG8_SCHED; PG8_LDA(At, 1, 0); PG8_STAGE(PG8_SA(0, 1), a2 + hstep, voffA);
            PG8_WAIT_V(8); PG8_WAIT_L(0); PG8_BAR; PG8_MMA(0, 0, At, B0); PG8_MMA(0, 1, At, B1); PG8_BAR; PG8_SCHED;
            PG8_LDA(At, 1, 1); PG8_STAGE(PG8_SB(1, 0), b3, voffB); PG8_STAGE(PG8_SB(1, 1), b3 + hstep, voffB); PG8_STAGE(PG8_SA(1, 0), a3, voffA);
            PG8_WAIT_V(8); PG8_WAIT_L(0); PG8_BAR; PG8_MMA(1, 0, At, B0); PG8_MMA(1, 1, At, B1); PG8_BAR; PG8_SCHED;
            } else {
            PG8_LDB(B0, 0, 0); PG8_SCHED; PG8_LDA(At, 0, 0); PG8_STAGE(PG8_SA(1, 1), a1 + hstep, voffA);
            PG8_WAIT_L(8); PG8_BAR; PG8_WAIT_L(0); PG8_MMA(0, 0, At, B0); PG8_BAR; PG8_SCHED;
            PG8_LDB(B1, 0, 1); PG8_STAGE(PG8_SB(0, 0), b2, voffB);
            PG8_BAR; PG8_WAIT_L(0); PG8_MMA(0, 1, At, B1); PG8_BAR;
            PG8_LDA(At, 0, 1); PG8_STAGE(PG8_SA(0, 0), a2, voffA);
            PG8_BAR; PG8_WAIT_L(0); PG8_MMA(1, 0, At, B0); PG8_BAR; PG8_SCHED;
            PG8_STAGE(PG8_SB(0, 1), b2 + hstep, voffB);
            PG8_WAIT_V(6); PG8_BAR; PG8_MMA(1, 1, At, B1); PG8_BAR;
            PG8_LDB(B0, 1, 0); PG8_SCHED; PG8_LDA(At, 1, 0); PG8_STAGE(PG8_SA(0, 1), a2 + hstep, voffA);
            PG8_WAIT_L(8); PG8_BAR; PG8_WAIT_L(0); PG8_MMA(0, 0, At, B0); PG8_BAR; PG8_SCHED;
            PG8_LDB(B1, 1, 1); PG8_STAGE(PG8_SB(1, 0), b3, voffB);
            PG8_BAR; PG8_WAIT_L(0); PG8_MMA(0, 1, At, B1); PG8_BAR;
            PG8_LDA(At, 1, 1); PG8_STAGE(PG8_SA(1, 0), a3, voffA);
            PG8_BAR; PG8_WAIT_L(0); PG8_MMA(1, 0, At, B0); PG8_BAR; PG8_SCHED;
            PG8_STAGE(PG8_SB(1, 1), b3 + hstep, voffB);
            PG8_WAIT_V(6); PG8_BAR; PG8_MMA(1, 1, At, B1); PG8_BAR;
            }
        }
        if constexpr (ALIGN_EPI) { if (wr == 0) PG8_BAR; }
        E(acc, cur, wr, wc, fr, fq);
#if REP_EPI
        asm volatile("" ::: "memory"); E(acc, cur, wr, wc, fr, fq);
#endif
        S.done(cur);
        if (!has_next) break;
#pragma unroll
        for (int a = 0; a < 2; ++a)
#pragma unroll
            for (int b = 0; b < 2; ++b)
#pragma unroll
                for (int m = 0; m < 4; ++m)
#pragma unroll
                    for (int n = 0; n < 2; ++n) acc[a][b][m][n] = (f32x4){0.f, 0.f, 0.f, 0.f};
        cur = nxt; cA = nA; cB = nB; ++ui;
        if constexpr (ALIGN_EPI) { if (wr == 1) PG8_BAR; }
    }
    PG8_WAIT_V(0);
    if constexpr (!ALIGN_EPI) { if (wr == 0) PG8_BAR; }
    PG8_BAR;
#undef PG8_SA
#undef PG8_SB
#undef PG8_STAGE
#undef PG8_LDA
#undef PG8_LDB
#undef PG8_MMA
#undef PG8_WAIT_V
#undef PG8_WAIT_L
#undef PG8_BAR
#undef PG8_SCHED
}
}
typedef f32x4 AccT[2][2][4][2];

DI float row_rms_scale(const float* ss, int row) {
    const f32x4 a = ldg_f4(ss + (size_t)row * 8), b = ldg_f4(ss + (size_t)row * 8 + 4);
    return rsqrtf(((a[0] + a[1]) + (a[2] + a[3]) + (b[0] + b[1]) + (b[2] + b[3])) * (1.f / DM) + NORM_EPS);
}
DI float row_rms_scale16(const float* ss, int row) {
    const f32x4 a = ldg_f4(ss + (size_t)row * 16), b = ldg_f4(ss + (size_t)row * 16 + 4), c = ldg_f4(ss + (size_t)row * 16 + 8), d = ldg_f4(ss + (size_t)row * 16 + 12);
    return rsqrtf((((a[0] + a[1]) + (a[2] + a[3]) + (b[0] + b[1]) + (b[2] + b[3])) + ((c[0] + c[1]) + (c[2] + c[3]) + (d[0] + d[1]) + (d[2] + d[3]))) * (1.f / DM) + NORM_EPS);
}
template <int NSS> DI void row_scales8(const float* ss, int row0, int fq, float (&rs)[8]) {
    if constexpr (NSS == 16) { f32x4 q[8];
#pragma unroll
        for (int i = 0; i < 8; ++i) q[i] = ldg_f4(ss + (size_t)(row0 + (i >> 2) * 128 + (i & 3) * 16) * 16 + 4 * fq);
#pragma unroll
        for (int i = 0; i < 8; ++i) rs[i] = (q[i][0] + q[i][1]) + (q[i][2] + q[i][3]);
    } else { f32x2 q[8];
#pragma unroll
        for (int i = 0; i < 8; ++i) q[i] = ldg_f2(ss + (size_t)(row0 + (i >> 2) * 128 + (i & 3) * 16) * 8 + 2 * fq);
#pragma unroll
        for (int i = 0; i < 8; ++i) rs[i] = q[i][0] + q[i][1];
    }
#pragma unroll
    for (int i = 0; i < 8; ++i) rs[i] = rsqrtf(xsum_16_32(rs[i]) * (1.f / DM) + NORM_EPS);
}
struct EpiPlain {
    static constexpr bool PERM = true;
    bf16_t* O; int ldc; const float* ss; int nss;
    DI void operator()(const AccT& acc, const pg8::Unit& u, int wr, int wc, int fr, int fq) const {
        const int row0 = u.pm * 256 + wr * 64 + fr, col0 = u.pn * 256 + wc * 32 + 8 * fq;
        float rs[8];
        if (nss == 16) row_scales8<16>(ss, row0, fq, rs); else row_scales8<8>(ss, row0, fq, rs);
#pragma unroll
        for (int ai = 0; ai < 2; ++ai)
#pragma unroll
            for (int m = 0; m < 4; ++m) { bf16_t* rowp = O + (size_t)(row0 + ai * 128 + m * 16) * ldc + col0;
#pragma unroll
                for (int bj = 0; bj < 2; ++bj) { const f32x4 v0 = acc[ai][bj][m][0] * rs[ai * 4 + m], v1 = acc[ai][bj][m][1] * rs[ai * 4 + m];
                    u32x4 w; w.x = cvt_pk_bf16(v0[0], v0[1]); w.y = cvt_pk_bf16(v0[2], v0[3]); w.z = cvt_pk_bf16(v1[0], v1[1]); w.w = cvt_pk_bf16(v1[2], v1[3]);
                    stg_u4(rowp + bj * 128, w); } }
    }
};
struct EpiResid {
    static constexpr bool PERM = true;
    const float* Hin; float* Hout; const float* bias; int zero; bf16_t* HBo; float* ss16;
    DI void operator()(const AccT& acc, const pg8::Unit& u, int wr, int wc, int fr, int fq) const {
        const int row0 = u.pm * 256 + wr * 64 + fr, col0 = u.pn * 256 + wc * 32 + 8 * fq;
        f32x4 bv[2][2];
#pragma unroll
        for (int bj = 0; bj < 2; ++bj)
#pragma unroll
            for (int n = 0; n < 2; ++n) bv[bj][n] = bias ? ldg_f4(bias + col0 + bj * 128 + 4 * n) : (f32x4){0.f, 0.f, 0.f, 0.f};
        f32x4 hin[2][4][2][2];
#define RESID_LD(a) do { _Pragma("unroll") for (int m_ = 0; m_ < 4; ++m_) { const size_t ro_ = (size_t)(row0 + (a) * 128 + m_ * 16) * DM + col0; \
            _Pragma("unroll") for (int bj = 0; bj < 2; ++bj) _Pragma("unroll") for (int n = 0; n < 2; ++n) hin[a][m_][bj][n] = ldg_f4(Hin + ro_ + bj * 128 + 4 * n); } } while (0)
        RESID_LD(0); __builtin_amdgcn_sched_barrier(0);
#pragma unroll
        for (int i = 0; i < 8; ++i) { const int ai = i >> 2, m = i & 3; const int row = row0 + ai * 128 + m * 16; const size_t ro = (size_t)row * DM + col0; float sq = 0.f;
            if (i == 2) { __builtin_amdgcn_sched_barrier(0); RESID_LD(1); __builtin_amdgcn_sched_barrier(0); }
            if (i == 4) __builtin_amdgcn_sched_barrier(0);
#pragma unroll
            for (int bj = 0; bj < 2; ++bj) { f32x4 hv[2];
#pragma unroll
                for (int n = 0; n < 2; ++n) { const f32x4 h_in = hin[ai][m][bj][n];
                    hv[n] = zero ? h_in : (h_in + acc[ai][bj][m][n] + bv[bj][n]); stg_f4(Hout + ro + bj * 128 + 4 * n, hv[n]);
                    sq += (hv[n][0] * hv[n][0] + hv[n][1] * hv[n][1]) + (hv[n][2] * hv[n][2] + hv[n][3] * hv[n][3]); }
                u32x4 w; w.x = cvt_pk_bf16(hv[0][0], hv[0][1]); w.y = cvt_pk_bf16(hv[0][2], hv[0][3]); w.z = cvt_pk_bf16(hv[1][0], hv[1][1]); w.w = cvt_pk_bf16(hv[1][2], hv[1][3]);
                stg_u4(HBo + ro + bj * 128, w); }
            sq = xsum_16_32(sq);
            if (fq == 0) *(GAS float*)(ss16 + (size_t)row * 16 + u.pn * 4 + wc) = sq;
        }
#undef RESID_LD
    }
};
struct EpiGlu {
    static constexpr bool PERM = true;
    bf16_t* O; const float* bias; const float* ss;
    DI void operator()(const AccT& acc, const pg8::Unit& u, int wr, int wc, int fr, int fq) const {
        const int row0 = u.pm * 256 + wr * 64 + fr, col0 = u.pn * 128 + wc * 32 + 8 * fq;
        f32x4 bu[2], bg[2];
#pragma unroll
        for (int n = 0; n < 2; ++n) { bu[n] = ldg_f4(bias + col0 + 4 * n); bg[n] = ldg_f4(bias + 1024 + col0 + 4 * n); }
        float rs8[8]; row_scales8<8>(ss, row0, fq, rs8);
#pragma unroll
        for (int ai = 0; ai < 2; ++ai)
#pragma unroll
            for (int m = 0; m < 4; ++m) { bf16_t* rowp = O + (size_t)(row0 + ai * 128 + m * 16) * DM + col0;
                const float rs = rs8[ai * 4 + m];
                float r[8];
#pragma unroll
                for (int n = 0; n < 2; ++n)
#pragma unroll
                    for (int e = 0; e < 4; ++e) { const float uu = acc[ai][0][m][n][e] * rs + bu[n][e], gg = acc[ai][1][m][n][e] * rs + bg[n][e];
                        r[4 * n + e] = uu / (1.f + __expf(-gg)); }
                u32x4 w; w.x = cvt_pk_bf16(r[0], r[1]); w.y = cvt_pk_bf16(r[2], r[3]); w.z = cvt_pk_bf16(r[4], r[5]); w.w = cvt_pk_bf16(r[6], r[7]);
                stg_u4(rowp, w); }
    }
};
struct EpiQup {
    static constexpr bool PERM = true;
    bf16_t* O; const float* cosr; const float* sinr; float qscale;
    DI void operator()(const AccT& acc, const pg8::Unit& u, int wr, int wc, int fr, int fq) const {
        const int row0 = u.pm * 256 + wr * 64 + fr;
#pragma unroll
        for (int bj = 0; bj < 2; ++bj) {
            const int c32 = u.pn * 256 + bj * 128 + wc * 32;
            const bool rope = (c32 % 96) == 64;
#pragma unroll
            for (int ai = 0; ai < 2; ++ai)
#pragma unroll
                for (int m = 0; m < 4; ++m) { const int row = row0 + ai * 128 + m * 16;
                    float r[8];
#pragma unroll
                    for (int n = 0; n < 2; ++n)
#pragma unroll
                        for (int e = 0; e < 4; ++e) r[4 * n + e] = acc[ai][bj][m][n][e];
                    if (rope) {
                        const int i0 = 8 * (fq & 1);
                        const f32x4 c0 = *(const f32x4*)(cosr + (size_t)row * 16 + i0), c1 = *(const f32x4*)(cosr + (size_t)row * 16 + i0 + 4);
                        const f32x4 s0 = *(const f32x4*)(sinr + (size_t)row * 16 + i0), s1 = *(const f32x4*)(sinr + (size_t)row * 16 + i0 + 4);
#pragma unroll
                        for (int j = 0; j < 8; ++j) { const float own = r[j]; auto sw = __builtin_amdgcn_permlane32_swap(__float_as_uint(own), __float_as_uint(own), false, false); const unsigned sw0 = sw[0], sw1 = sw[1];
                            const float oth = __uint_as_float(fq < 2 ? sw1 : sw0);
                            const float c = j < 4 ? c0[j & 3] : c1[j & 3], s = j < 4 ? s0[j & 3] : s1[j & 3];
                            r[j] = (fq < 2) ? (own * c - oth * s) : (own * c + oth * s); }
                    }
                    u32x4 w; w.x = cvt_pk_bf16(r[0] * qscale, r[1] * qscale); w.y = cvt_pk_bf16(r[2] * qscale, r[3] * qscale);
                    w.z = cvt_pk_bf16(r[4] * qscale, r[5] * qscale); w.w = cvt_pk_bf16(r[6] * qscale, r[7] * qscale);
                    stg_u4(O + (size_t)row * 768 + c32 + 8 * fq, w);
                    asm volatile("" ::: "memory"); }
        }
    }
};
struct EpiKVup {
    static constexpr bool PERM = true;
    bf16_t* KM; bf16_t* VM;
    DI void operator()(const AccT& acc, const pg8::Unit& u, int wr, int wc, int fr, int fq) const {
        const int row0 = u.pm * 256 + wr * 64 + fr;
#pragma unroll
        for (int bj = 0; bj < 2; ++bj) { const int head = 2 * u.pn + bj;
            bf16_t* base = (wc < 2) ? (KM + head * 96 + wc * 32 + 8 * fq) : (VM + head * 64 + (wc - 2) * 32 + 8 * fq);
            const int pitch = (wc < 2) ? 768 : 512;
#pragma unroll
            for (int ai = 0; ai < 2; ++ai)
#pragma unroll
                for (int m = 0; m < 4; ++m) { const int row = row0 + ai * 128 + m * 16; const f32x4 v0 = acc[ai][bj][m][0], v1 = acc[ai][bj][m][1];
                    u32x4 w; w.x = cvt_pk_bf16(v0[0], v0[1]); w.y = cvt_pk_bf16(v0[2], v0[3]); w.z = cvt_pk_bf16(v1[0], v1[1]); w.w = cvt_pk_bf16(v1[2], v1[3]);
                    stg_u4(base + (size_t)row * pitch, w); } }
    }
};

#define XB_TMO      128
#define XB_XCNT(j)  (256  + 64 * (j))
#define XB_XSUB(j)  (1280 + 64 * (j))
#define XB_XGEN(j)  (2304 + 64 * (j))
#define XB_TOP      3328
#define XB_TOPGEN   3392
#define XCD_BAR_WORDS 3456
#define XB_XLOC(j)  (3456 + 64 * (j))
#define XB_SPIN_CAP (1u << 18)
__device__ __forceinline__ unsigned xb_ld(unsigned* p)              { return __hip_atomic_load(p, __ATOMIC_RELAXED, __HIP_MEMORY_SCOPE_AGENT); }
__device__ __forceinline__ unsigned xb_add(unsigned* p, unsigned v) { return __hip_atomic_fetch_add(p, v, __ATOMIC_RELAXED, __HIP_MEMORY_SCOPE_AGENT); }
__device__ __forceinline__ unsigned xb_xcc_id() { return (unsigned)__builtin_amdgcn_s_getreg((3 << 11) | 20) & 0xFu; }
#define XB_SPIN(cond, bar) do { unsigned _sp = 0; while (cond) { __builtin_amdgcn_s_sleep(1); \
    if ((++_sp & 255u) == 0u) { if (xb_ld(&(bar)[XB_TMO])) break; if (_sp > XB_SPIN_CAP) { atomicAdd(&(bar)[XB_TMO], 1u); break; } } } } while (0)
struct XcdBarrier { unsigned* bar; unsigned x; volatile LAS unsigned* st; };
__device__ __forceinline__ XcdBarrier xcd_barrier_post(unsigned* bar, volatile LAS unsigned* st) {
    XcdBarrier b; b.bar = bar; b.x = xb_xcc_id(); b.st = st;
    if (threadIdx.x == 0) st[2] = xb_add(&bar[XB_XCNT(b.x)], 1u);
    return b;
}
__device__ __forceinline__ void xcd_barrier_complete(unsigned* bar, unsigned x, unsigned& nloc, unsigned& nx, unsigned& uni) {
    const unsigned G = gridDim.x * gridDim.y * gridDim.z;
    unsigned sum, cnt, mine, sp = 0u, even;
    for (;;) {
        sum = 0u; cnt = 0u; mine = 0u; even = 1u;
#pragma unroll
        for (unsigned j = 0; j < 16; ++j) { const unsigned c = xb_ld(&bar[XB_XCNT(j)]); sum += c; cnt += (c > 0u) ? 1u : 0u; mine = (j == x) ? c : mine;
            if (j < 8u ? (c * 8u != G) : (c != 0u)) even = 0u; }
        if (sum == G) break;
        __builtin_amdgcn_s_sleep(1);
        if ((++sp & 255u) == 0u) { if (xb_ld(&bar[XB_TMO])) break; if (sp > XB_SPIN_CAP) { atomicAdd(&bar[XB_TMO], 1u); break; } }
    }
    nloc = mine > 0u ? mine : 1u; nx = cnt > 0u ? cnt : 1u; uni = (sum == G) ? even : 0u;
}
__device__ __forceinline__ void xcd_barrier(const XcdBarrier& b) {
    asm volatile("s_waitcnt vmcnt(0)" ::: "memory");
    __syncthreads();
    if (threadIdx.x == 0) {
        unsigned* bar = b.bar;
        __builtin_amdgcn_s_waitcnt(0);
        unsigned nloc = b.st[0], nx = b.st[1];
        if (nloc == 0u) { unsigned uni; xcd_barrier_complete(bar, b.x, nloc, nx, uni); b.st[0] = nloc; b.st[1] = nx; b.st[3] = uni; }
        const unsigned old = xb_add(&bar[XB_XSUB(b.x)], 1u);
        const unsigned gen = old / nloc;
        if (old + 1u == (gen + 1u) * nloc) {
            __builtin_amdgcn_fence(__ATOMIC_RELEASE, "agent");
            asm volatile("s_waitcnt vmcnt(0)" ::: "memory");
            const unsigned og = xb_add(&bar[XB_TOP], 1u);
            const unsigned tg = og / nx;
            if (og + 1u == (tg + 1u) * nx) xb_add(&bar[XB_TOPGEN], 1u);
            else XB_SPIN(xb_ld(&bar[XB_TOPGEN]) == tg, bar);
            __builtin_amdgcn_fence(__ATOMIC_ACQUIRE, "agent");
            xb_add(&bar[XB_XGEN(b.x)], 1u);
            asm volatile("s_waitcnt vmcnt(0)" ::: "memory");
        } else {
            XB_SPIN(xb_ld(&bar[XB_XGEN(b.x)]) == gen, bar);
            __builtin_amdgcn_fence(__ATOMIC_ACQUIRE, "agent");
            asm volatile("s_waitcnt vmcnt(0)" ::: "memory");
        }
    }
    __syncthreads();
}

__device__ __forceinline__ void xcd_local_barrier(const XcdBarrier& b, unsigned nloc, unsigned lgen) {
    asm volatile("s_waitcnt vmcnt(0)" ::: "memory");
    __syncthreads();
    if (threadIdx.x == 0) {
        unsigned* bar = b.bar;
        (void)xb_add(&bar[XB_XLOC(b.x)], 1u);
        XB_SPIN(xb_ld(&bar[XB_XLOC(b.x)]) < lgen * nloc, bar);
        __builtin_amdgcn_fence(__ATOMIC_ACQUIRE, "agent");
        asm volatile("s_waitcnt vmcnt(0)" ::: "memory");
    }
    __syncthreads();
}

struct Params {
    const float* in[23];
    float* out;
    unsigned char* ws;
    double inv_r[16];
    double inv_m[32];
    int ph_lo, ph_hi;
};

template <int GLU>
DI void transpose_item(const float* W, int K, int N, bf16_t* WT, LAS float* scr, int item, int lane, const float* kgain = nullptr) {
    const int nblk = N / 32, kb = item / nblk, nb = item % nblk, k0 = 64 * kb, n0 = 32 * nb;
#pragma unroll 8
    for (int i = 0; i < 32; ++i) { const int kk = 2 * i + (lane >> 5); const float gk = kgain ? kgain[k0 + kk] : 1.f; scr[kk * 33 + (lane & 31)] = W[(size_t)(k0 + kk) * N + n0 + (lane & 31)] * gk; }
    LDS_WAIT(); asm volatile("" ::: "memory");
    const int c = lane & 7;
#pragma unroll
    for (int j = 0; j < 4; ++j) { const int n = (lane >> 3) + 8 * j; const LAS float* s = scr + (8 * c) * 33 + n;
        u32x4 o; o.x = cvt_pk_bf16(s[0 * 33], s[1 * 33]); o.y = cvt_pk_bf16(s[2 * 33], s[3 * 33]); o.z = cvt_pk_bf16(s[4 * 33], s[5 * 33]); o.w = cvt_pk_bf16(s[6 * 33], s[7 * 33]);
        int nn = n0 + n;
        if (GLU) nn = (nn < 1024) ? ((nn >> 7) * 256 + (nn & 127)) : (((nn - 1024) >> 7) * 256 + 128 + (nn & 127));
        *(u32x4*)(WT + (size_t)nn * K + k0 + 8 * c) = o; }
    LDS_WAIT(); asm volatile("" ::: "memory");
}
DI void rms_row_to_bf16(const float* xrow, const float* gain, bf16_t* orow, int lane) {
    const f32x4* xr = (const f32x4*)xrow + lane; const f32x4* gr = (const f32x4*)gain + lane;
    f32x4 v[4]; float s = 0.f;
#pragma unroll
    for (int j = 0; j < 4; ++j) { v[j] = xr[64 * j]; s += (v[j].x * v[j].x + v[j].y * v[j].y) + (v[j].z * v[j].z + v[j].w * v[j].w); }
    const float r = rsqrtf(wave_sum(s) * (1.f / DM) + NORM_EPS);
    u32x2* o8 = (u32x2*)orow + lane;
#pragma unroll
    for (int j = 0; j < 4; ++j) { const f32x4 g = gr[64 * j]; u32x2 o; o.x = cvt_pk_bf16(v[j].x * r * g.x, v[j].y * r * g.y); o.y = cvt_pk_bf16(v[j].z * r * g.z, v[j].w * r * g.w); o8[64 * j] = o; }
}

DI void rms_row_q(const float* xrow, const float* gain, bf16_t* orow, unsigned char* xq, float* sx, int lane) {
    f32x4 v[4]; float s = 0.f;
#pragma unroll
    for (int j = 0; j < 4; ++j) { v[j] = ldg_f4(xrow + 4 * lane + 256 * j); s += (v[j].x * v[j].x + v[j].y * v[j].y) + (v[j].z * v[j].z + v[j].w * v[j].w); }
    const float r = rsqrtf(wave_sum(s) * (1.f / DM) + NORM_EPS);
    float am = 0.f;
#pragma unroll
    for (int j = 0; j < 4; ++j) { const f32x4 g = ldg_f4(gain + 4 * lane + 256 * j); v[j] = v[j] * r * g;
        u32x2 o; o.x = cvt_pk_bf16(v[j].x, v[j].y); o.y = cvt_pk_bf16(v[j].z, v[j].w); *(GAS u32x2*)(orow + 4 * lane + 256 * j) = o;
        am = fmaxf(fmaxf(am, fabsf(v[j].x)), fmaxf(fmaxf(fabsf(v[j].y), fabsf(v[j].z)), fabsf(v[j].w))); }
    am = wave_max_all(am);
    const float inv = am > 0.f ? 127.f / am : 0.f;
#pragma unroll
    for (int j = 0; j < 4; ++j) *(GAS unsigned*)(xq + 4 * lane + 256 * j) = pack4_i8(v[j].x, v[j].y, v[j].z, v[j].w, inv, 0);
    if (lane == 0) *sx = am * (1.f / 127.f);
}

DI void token_prep_unit(LAS unsigned char* lds, int unit, const bf16_t* proj, const float* qn, const float* kvn,
                        const float* cosr, const float* sinr, const float* cosm, const float* sinm,
                        bf16_t* cqn, bf16_t* ckvn, bf16_t* KM, bf16_t* MQ, bf16_t* MK, float* kpart, int wave, int lane) {
    float ks1[4] = {0.f, 0.f, 0.f, 0.f}, ks2[4] = {0.f, 0.f, 0.f, 0.f};
    const float mscale = 0.125f * LOG2E;
    for (int i = 0; i < 8; ++i) {
        const int row = unit * 64 + wave * 8 + i;
        const bf16_t* P = proj + (size_t)row * NPROJP;
        { unsigned w[3]; float ss = 0.f;
#pragma unroll
          for (int j = 0; j < 3; ++j) { w[j] = *(const unsigned*)(P + 2 * lane + 128 * j); const float a = bf_lo(w[j]), b = bf_hi(w[j]); ss += a * a + b * b; }
          const float r = rsqrtf(wave_sum(ss) * (1.f / 384.f) + NORM_EPS);
#pragma unroll
          for (int j = 0; j < 3; ++j) { const f32x2 g = *(const f32x2*)(qn + 2 * lane + 128 * j);
              *(unsigned*)(cqn + (size_t)row * 384 + 2 * lane + 128 * j) = cvt_pk_bf16(bf_lo(w[j]) * r * g.x, bf_hi(w[j]) * r * g.y); } }
        { unsigned w[2]; float ss = 0.f;
#pragma unroll
          for (int j = 0; j < 2; ++j) { w[j] = *(const unsigned*)(P + 384 + 2 * lane + 128 * j); const float a = bf_lo(w[j]), b = bf_hi(w[j]); ss += a * a + b * b; }
          const float r = rsqrtf(wave_sum(ss) * (1.f / 256.f) + NORM_EPS);
#pragma unroll
          for (int j = 0; j < 2; ++j) { const f32x2 g = *(const f32x2*)(kvn + 2 * lane + 128 * j);
              *(unsigned*)(ckvn + (size_t)row * 256 + 2 * lane + 128 * j) = cvt_pk_bf16(bf_lo(w[j]) * r * g.x, bf_hi(w[j]) * r * g.y); } }
        { const int h = lane >> 3, i2 = 2 * (lane & 7);
          const unsigned x1 = *(const unsigned*)(P + 640 + i2), x2 = *(const unsigned*)(P + 656 + i2);
          const f32x2 c = *(const f32x2*)(cosr + (size_t)row * 16 + i2), s = *(const f32x2*)(sinr + (size_t)row * 16 + i2);
          const float a0 = bf_lo(x1), a1 = bf_hi(x1), b0 = bf_lo(x2), b1 = bf_hi(x2);
          *(unsigned*)(KM + (size_t)row * 768 + h * 96 + 64 + i2) = cvt_pk_bf16(a0 * c.x - b0 * s.x, a1 * c.y - b1 * s.y);
          *(unsigned*)(KM + (size_t)row * 768 + h * 96 + 80 + i2) = cvt_pk_bf16(b0 * c.x + a0 * s.x, b1 * c.y + a1 * s.y); }
        { const int hq = lane >> 3, i4 = 4 * (lane & 7);
          const f32x4 c = *(const f32x4*)(cosm + (size_t)row * 32 + i4), s = *(const f32x4*)(sinm + (size_t)row * 32 + i4);
          { const u32x2 x1 = *(const u32x2*)(P + 672 + hq * 64 + i4), x2 = *(const u32x2*)(P + 672 + hq * 64 + 32 + i4);
            const float a[4] = {bf_lo(x1.x), bf_hi(x1.x), bf_lo(x1.y), bf_hi(x1.y)}, b[4] = {bf_lo(x2.x), bf_hi(x2.x), bf_lo(x2.y), bf_hi(x2.y)};
            float y1[4], y2[4];
#pragma unroll
            for (int e = 0; e < 4; ++e) { y1[e] = (a[e] * c[e] - b[e] * s[e]) * mscale; y2[e] = (b[e] * c[e] + a[e] * s[e]) * mscale; }
            u32x2 o1, o2; o1.x = cvt_pk_bf16(y1[0], y1[1]); o1.y = cvt_pk_bf16(y1[2], y1[3]); o2.x = cvt_pk_bf16(y2[0], y2[1]); o2.y = cvt_pk_bf16(y2[2], y2[3]);
            *(u32x2*)(MQ + (size_t)row * 512 + hq * 64 + i4) = o1; *(u32x2*)(MQ + (size_t)row * 512 + hq * 64 + 32 + i4) = o2; }
          { const u32x2 x1 = *(const u32x2*)(P + 1184 + hq * 64 + i4), x2 = *(const u32x2*)(P + 1184 + hq * 64 + 32 + i4);
            const float a[4] = {bf_lo(x1.x), bf_hi(x1.x), bf_lo(x1.y), bf_hi(x1.y)}, b[4] = {bf_lo(x2.x), bf_hi(x2.x), bf_lo(x2.y), bf_hi(x2.y)};
            float y1[4], y2[4];
#pragma unroll
            for (int e = 0; e < 4; ++e) { y1[e] = a[e] * c[e] - b[e] * s[e]; y2[e] = b[e] * c[e] + a[e] * s[e]; ks1[e] += y1[e]; ks2[e] += y2[e]; }
            u32x2 o1, o2; o1.x = cvt_pk_bf16(y1[0], y1[1]); o1.y = cvt_pk_bf16(y1[2], y1[3]); o2.x = cvt_pk_bf16(y2[0], y2[1]); o2.y = cvt_pk_bf16(y2[2], y2[3]);
            *(u32x2*)(MK + (size_t)row * 512 + hq * 64 + i4) = o1; *(u32x2*)(MK + (size_t)row * 512 + hq * 64 + 32 + i4) = o2; } }
    }
    LAS float* red = (LAS float*)lds;
    { const int hq = lane >> 3, i4 = 4 * (lane & 7);
#pragma unroll
      for (int e = 0; e < 4; ++e) { red[wave * 512 + hq * 64 + i4 + e] = ks1[e]; red[wave * 512 + hq * 64 + 32 + i4 + e] = ks2[e]; } }
    __syncthreads();
    { const int tid = wave * 64 + lane; float s = 0.f;
#pragma unroll
      for (int w = 0; w < 8; ++w) s += red[w * 512 + tid];
      const int row0 = unit * 64, b = row0 / SEQ, t0 = row0 % SEQ, n = t0 / 256, part = (t0 % 256) / 64;
      kpart[((size_t)(b * 32 + n) * 4 + part) * 512 + tid] = s; }
    __syncthreads();
}

DI float xmax32(float v) {
    auto r = __builtin_amdgcn_permlane32_swap(__float_as_uint(v), __float_as_uint(v), false, false); const unsigned r0 = r[0], r1 = r[1];
    return fmaxf(__uint_as_float(r0), __uint_as_float(r1)); }
DI float xsum32(float v) {
    auto r = __builtin_amdgcn_permlane32_swap(__float_as_uint(v), __float_as_uint(v), false, false); const unsigned r0 = r[0], r1 = r[1];
    return __uint_as_float(r0) + __uint_as_float(r1); }
#ifndef ATTN_THR
#define ATTN_THR 8.0f
#endif
DI s16x4 vtr(const LAS char* p) { return __builtin_bit_cast(s16x4, __builtin_amdgcn_ds_read_tr16_b64_v4i16((LAS v4i16_t*)p)); }
#define MFMA32(a, b, c) __builtin_amdgcn_mfma_f32_32x32x16_bf16((a), (b), (c), 0, 0, 0)

#define SPB() __builtin_amdgcn_sched_barrier(0)
#define SPIN(x) asm volatile("" : "+v"(x))
#define MX3(a, b, c) fmaxf(fmaxf((a), (b)), (c))
DI float rowmax32(const f32x16& p0, const f32x16& p1) {
    float a = MX3(p0[0], p0[1], p1[0]), b = MX3(p0[2], p0[3], p1[1]); a = MX3(a, p1[2], p1[3]);
#pragma unroll
    for (int r = 4; r < 16; r += 4) { a = MX3(a, p0[r], p0[r + 1]); b = MX3(b, p0[r + 2], p0[r + 3]); a = MX3(a, p1[r], p1[r + 1]); b = MX3(b, p1[r + 2], p1[r + 3]); }
    return xmax32(fmaxf(a, b));
}
DI void cmask32(f32x16& p0, f32x16& p1, int jb, int qrel, int hi) {
    const int kb = 64 * jb + 4 * hi;
#pragma unroll
    for (int r = 0; r < 16; ++r) { const int kv = kb + (r & 3) + 8 * (r >> 2); if (kv > qrel) p0[r] = -INFINITY; if (kv + 32 > qrel) p1[r] = -INFINITY; }
}
DI void glds16_asm(const void* g, unsigned lds_base) {
    unsigned sv; asm volatile("s_mov_b32 %0, m0\n\ts_mov_b32 m0, %2\n\ts_nop 0\n\tglobal_load_lds_dwordx4 %1, off\n\ts_mov_b32 m0, %0" : "=&s"(sv) : "v"(g), "s"(lds_base) : "memory"); }
template <int DK>
DI void attn_unit_sp(LAS unsigned char* lds, const bf16_t* Qp, int qpitch, const bf16_t* Kp, int kpitch, const bf16_t* Vp, int vpitch, bf16_t* Op, int opitch, int qb) {
    static_assert(DK == 96, "12 K fragments");
    constexpr int NKS = DK / 16, KCH = DK / 8, KBYTES = KCH * 1024, VBYTES = 8192, OFF_K = 0, OFF_V = 3 * KBYTES;
    int tid_o = threadIdx.x; asm volatile("" : "+v"(tid_o));
    const int tid = tid_o, lane = tid & 63, r32 = lane & 31, hi = lane >> 5; const int wid = __builtin_amdgcn_readfirstlane(tid >> 6);
    const int q0 = qb * 256, NT = 4 * qb + 4;
    const bf16_t* kg0 = Kp + (size_t)lane * kpitch + wid * 8;
    const bf16_t* kg1 = Kp + (size_t)lane * kpitch + (8 + (wid & 3)) * 8;
    const bf16_t* vg = Vp + (size_t)(16 * (wid & 3) + (lane >> 2)) * vpitch + (wid >> 2) * 32 + (lane & 3) * 8;
    const int kd0 = OFF_K + wid * 1024, kd1 = OFF_K + (8 + (wid & 3)) * 1024, vd = OFF_V + wid * 1024;
    const unsigned lds0 = (unsigned)(size_t)lds;
#define SP_DMA(g, off) glds16_asm((g), (unsigned)__builtin_amdgcn_readfirstlane((int)(lds0 + (unsigned)(off))))
#define SP_DMAK(tk, slot) do { const size_t rk_ = (size_t)(tk) * 64 * kpitch; SP_DMA(kg0 + rk_, kd0 + (slot) * KBYTES); if (wid < 4) SP_DMA(kg1 + rk_, kd1 + (slot) * KBYTES); } while (0)
#define SP_DMAV(tv, slot) SP_DMA(vg + (size_t)(tv) * 64 * vpitch, vd + (slot) * VBYTES)
#define SP_BAR(N) asm volatile("s_waitcnt vmcnt(" #N ") lgkmcnt(0)\n\ts_barrier" ::: "memory")
#define KLD2(so, d0) do { kf[2 * (d0)] = *(const LAS bf16x8*)(kp0 + (so) + (d0) * 2048); kf[2 * (d0) + 1] = *(const LAS bf16x8*)(kp0 + (so) + (d0) * 2048 + 512); } while (0)
    SP_DMAK(0, 0); SP_DMAV(0, 0); SP_DMAK(1, 1); SP_DMAK(2, 2); SP_DMAV(1, 1);
    bf16x8 qf[NKS];
    { const bf16_t* qrow = Qp + (size_t)(q0 + wid * 32 + r32) * qpitch + hi * 8;
#pragma unroll
      for (int ks = 0; ks < NKS; ++ks) qf[ks] = *(const GAS bf16x8*)(qrow + ks * 16); }
    const int qrel = wid * 32 + r32;
    const LAS char* vp0 = (const LAS char*)lds + OFF_V + (4 * hi + ((lane & 15) >> 2)) * 64 + ((lane >> 4) & 1) * 32 + (lane & 3) * 8;
    const LAS char* kp0 = (const LAS char*)lds + OFF_K + hi * 1024 + r32 * 16;
    f32x16 pA0, pA1, pB0, pB1; bf16x8 kf[2 * NKS]; s16x4 vlo[8], vhi[8]; u32x4 pw0, pw1, pw2, pw3;
    f32x16 ot[2]; ot[0] = f32x16{}; ot[1] = f32x16{};
    float m, l = 0.f, alpha = 1.f; bool resc = false;
    SP_BAR(0);
#pragma unroll
    for (int d0 = 0; d0 < NKS; ++d0) KLD2(0, d0);
    pA0 = MFMA32(kf[0], qf[0], f32x16{}); pA1 = MFMA32(kf[1], qf[0], f32x16{});
#pragma unroll
    for (int d0 = 1; d0 < NKS; ++d0) { pA0 = MFMA32(kf[2 * d0], qf[d0], pA0); pA1 = MFMA32(kf[2 * d0 + 1], qf[d0], pA1); }
    if (NT == 4) cmask32(pA0, pA1, 0, qrel, hi);
    m = rowmax32(pA0, pA1);
#pragma unroll
    for (int r = 0; r < 16; ++r) { pA0[r] = __builtin_amdgcn_exp2f(pA0[r] - m); pA1[r] = __builtin_amdgcn_exp2f(pA1[r] - m); }
#pragma unroll
    for (int d0 = 0; d0 < NKS; ++d0) KLD2(KBYTES, d0);
    SP_BAR(0);
    SP_DMAK(3, 0);
    int sp = 0, sc = 1, sn = 2;
#define ROT3() do { const int t_ = sp; sp = sc; sc = sn; sn = t_; } while (0)
#define PKW(P, i) cvt_pk_bf16_b(P[i], P[(i) + 1])
#define PAF(k) __builtin_bit_cast(bf16x8, pw##k)
#define VFR(i) (bf16x8){vlo[i][0], vlo[i][1], vlo[i][2], vlo[i][3], vhi[i][0], vhi[i][1], vhi[i][2], vhi[i][3]}
#define VRD(i) do { vlo[i] = vtr(vp_ + (((i) >> 2) * 4096 + ((i) & 3) * 1024)); vhi[i] = vtr(vp_ + (((i) >> 2) * 4096 + ((i) & 3) * 1024 + 512)); } while (0)
#define KRD(KRO, d0) do { KLD2(KRO, d0); SPB(); } while (0)
#define EX(v) __builtin_amdgcn_exp2f((v) + nm)
#define GAPA(MF, a0, a1, a2, a3, W0, W1, PW) do { MF; sacc += a0; sacc += a1; sacc += a2; sacc += a3; W0; W1; SPIN(PW); SPIN(sacc); SPB(); } while (0)
#define GAPB(MF, X, i) do { MF; X[i] = EX(X[i]); X[(i) + 1] = EX(X[(i) + 1]); X[(i) + 2] = EX(X[(i) + 2]); X[(i) + 3] = EX(X[(i) + 3]); SPIN(X); SPB(); } while (0)
#define STEP(C0, C1, P0, P1, t, MASK) do { SPB(); \
    { const int tk_ = (t) + 3 < NT ? (t) + 3 : NT - 1, tv_ = (t) + 1 < NT ? (t) + 1 : NT - 1; SP_DMAK(tk_, sc); SP_DMAV(tv_, sn); } \
    const int kro_ = sn * KBYTES; \
    const LAS char* vp_ = vp0 + sp * VBYTES; \
    VRD(0); SPB(); float sacc = P0[0] + P0[1]; \
                    GAPA(C0 = MFMA32(kf[0], qf[0], f32x16{}), P0[2], P0[3], P0[4], P0[5],     pw0[0] = PKW(P0, 0),  pw0[1] = PKW(P0, 2),  pw0); \
    VRD(4); SPB(); GAPA(C1 = MFMA32(kf[1], qf[0], f32x16{}), P0[6], P0[7], P0[8], P0[9],     pw0[2] = PKW(P0, 4),  pw0[3] = PKW(P0, 6),  pw0); \
    VRD(1); SPB(); GAPA(C0 = MFMA32(kf[2], qf[1], C0),       P0[10], P0[11], P0[12], P0[13], pw1[0] = PKW(P0, 8),  pw1[1] = PKW(P0, 10), pw1); \
    VRD(5); SPB(); GAPA(C1 = MFMA32(kf[3], qf[1], C1),       P0[14], P0[15], P1[0], P1[1],   pw1[2] = PKW(P0, 12), pw1[3] = PKW(P0, 14), pw1); \
    VRD(2); SPB(); GAPA(C0 = MFMA32(kf[4], qf[2], C0),       P1[2], P1[3], P1[4], P1[5],     pw2[0] = PKW(P1, 0),  pw2[1] = PKW(P1, 2),  pw2); \
    VRD(6); SPB(); GAPA(C1 = MFMA32(kf[5], qf[2], C1),       P1[6], P1[7], P1[8], P1[9],     pw2[2] = PKW(P1, 4),  pw2[3] = PKW(P1, 6),  pw2); \
    VRD(3); SPB(); GAPA(C0 = MFMA32(kf[6], qf[3], C0),       P1[10], P1[11], P1[12], P1[13], pw3[0] = PKW(P1, 8),  pw3[1] = PKW(P1, 10), pw3); \
    VRD(7); SPB(); GAPA(C1 = MFMA32(kf[7], qf[3], C1),       P1[14], P1[15], 0.f, 0.f,       pw3[2] = PKW(P1, 12), pw3[3] = PKW(P1, 14), pw3); \
    C0 = MFMA32(kf[8], qf[4], C0); C1 = MFMA32(kf[9], qf[4], C1); C0 = MFMA32(kf[10], qf[5], C0); C1 = MFMA32(kf[11], qf[5], C1); SPB(); \
    l += sacc; \
    if (MASK) cmask32(C0, C1, (t) - (NT - 4), qrel, hi); \
    { const float rm = rowmax32(C0, C1) - m; resc = false;                                    \
      if (__builtin_expect(__any(rm > ATTN_THR), 0)) { const float dl = fmaxf(rm, 0.f); m += dl; alpha = __builtin_amdgcn_exp2f(-dl); l *= alpha; resc = true; } } \
    const float nm = -m; SPB(); \
                GAPB(ot[0] = MFMA32(VFR(0), PAF(0), ot[0]), C0, 0);              GAPB(ot[1] = MFMA32(VFR(4), PAF(0), ot[1]), C0, 4); \
    KRD(kro_, 0); GAPB(ot[0] = MFMA32(VFR(1), PAF(1), ot[0]), C0, 8);  KRD(kro_, 1); GAPB(ot[1] = MFMA32(VFR(5), PAF(1), ot[1]), C0, 12); \
    KRD(kro_, 2); GAPB(ot[0] = MFMA32(VFR(2), PAF(2), ot[0]), C1, 0);  KRD(kro_, 3); GAPB(ot[1] = MFMA32(VFR(6), PAF(2), ot[1]), C1, 4); \
    KRD(kro_, 4); GAPB(ot[0] = MFMA32(VFR(3), PAF(3), ot[0]), C1, 8);  KRD(kro_, 5); GAPB(ot[1] = MFMA32(VFR(7), PAF(3), ot[1]), C1, 12); \
    if (wid < 4) SP_BAR(3); else SP_BAR(2); ROT3();                                         \
    if (resc) { _Pragma("unroll") for (int r = 0; r < 16; ++r) { ot[0][r] *= alpha; ot[1][r] *= alpha; } }         \
    } while (0)
    int t = 1;
    for (; t + 5 < NT; t += 2) {
        STEP(pB0, pB1, pA0, pA1, t, false);
        STEP(pA0, pA1, pB0, pB1, t + 1, false);
    }
    for (; t + 1 < NT; t += 2) {
        STEP(pB0, pB1, pA0, pA1, t, true);
        STEP(pA0, pA1, pB0, pB1, t + 1, true);
    }
    STEP(pB0, pB1, pA0, pA1, NT - 1, true);
    { float sacc = 0.f;
#pragma unroll
      for (int r = 0; r < 16; ++r) sacc += pB0[r] + pB1[r];
      l += sacc;
      pw0 = (u32x4){PKW(pB0, 0), PKW(pB0, 2), PKW(pB0, 4), PKW(pB0, 6)}; pw1 = (u32x4){PKW(pB0, 8), PKW(pB0, 10), PKW(pB0, 12), PKW(pB0, 14)};
      pw2 = (u32x4){PKW(pB1, 0), PKW(pB1, 2), PKW(pB1, 4), PKW(pB1, 6)}; pw3 = (u32x4){PKW(pB1, 8), PKW(pB1, 10), PKW(pB1, 12), PKW(pB1, 14)};
      const LAS char* vp_ = vp0 + sp * VBYTES;
#pragma unroll
      for (int i = 0; i < 8; ++i) VRD(i);
      ot[0] = MFMA32(VFR(0), PAF(0), ot[0]); ot[1] = MFMA32(VFR(4), PAF(0), ot[1]); ot[0] = MFMA32(VFR(1), PAF(1), ot[0]); ot[1] = MFMA32(VFR(5), PAF(1), ot[1]);
      ot[0] = MFMA32(VFR(2), PAF(2), ot[0]); ot[1] = MFMA32(VFR(6), PAF(2), ot[1]); ot[0] = MFMA32(VFR(3), PAF(3), ot[0]); ot[1] = MFMA32(VFR(7), PAF(3), ot[1]); }
    l = xsum32(l);
    const float rl = 1.f / l;
    bf16_t* orow = Op + (size_t)(q0 + qrel) * opitch;
#pragma unroll
    for (int db = 0; db < 2; ++db)
#pragma unroll
        for (int g = 0; g < 4; ++g) { u32x2 w; w.x = cvt_pk_bf16(ot[db][4 * g] * rl, ot[db][4 * g + 1] * rl); w.y = cvt_pk_bf16(ot[db][4 * g + 2] * rl, ot[db][4 * g + 3] * rl);
            *(GAS u32x2*)(orow + 32 * db + 8 * g + 4 * hi) = w; }
    SP_BAR(0);
#undef ROT3
#undef STEP
#undef GAPA
#undef GAPB
#undef EX
#undef KRD
#undef VRD
#undef VFR
#undef PAF
#undef PKW
#undef KLD2
#undef SP_BAR
#undef SP_DMAV
#undef SP_DMAK
#undef SP_DMA
}
template <int DK, bool MOBA>
DI void attn_unit(LAS unsigned char* lds, const bf16_t* Qp, int qpitch, const bf16_t* Kp, int kpitch, const bf16_t* Vp, int vpitch,
                  bf16_t* Op, int opitch, int qb, const float* kpart_b  ) {
    constexpr int NKS = DK / 16, KCH = DK / 8, KBYTES = KCH * 1024, VBYTES = 8192;
    constexpr int OFF_K0 = 0, OFF_K1 = KBYTES, OFF_V0 = 2 * KBYTES, OFF_V1 = 2 * KBYTES + VBYTES, OFF_KM = 2 * KBYTES + 2 * VBYTES;
    int tid_o = threadIdx.x; asm volatile("" : "+v"(tid_o));
    const int tid = tid_o, lane = tid & 63, r32 = lane & 31, hi = lane >> 5; const int wid = __builtin_amdgcn_readfirstlane(tid >> 6);
    const int q0 = qb * 256, NT = 4 * qb + 4;
    bf16x8 qf[NKS];
    { const bf16_t* qrow = Qp + (size_t)(q0 + wid * 32 + r32) * qpitch + hi * 8;
#pragma unroll
      for (int ks = 0; ks < NKS; ++ks) qf[ks] = *(const bf16x8*)(qrow + ks * 16); }
    unsigned selmask = 0u;
    if constexpr (MOBA) {
        const int own = qb;
        if (own > 0) {
            LAS float* km = (LAS float*)(lds + OFF_KM);
            for (int e = tid; e < own * 64; e += NTHR) { const int n = e >> 6, d = e & 63; const float* kp = kpart_b + (size_t)n * 4 * 512 + d;
                km[e] = (kp[0] + kp[512] + kp[1024] + kp[1536]) * (1.f / 256.f); }
            __syncthreads();
            float qv[NKS][8];
#pragma unroll
            for (int ks = 0; ks < NKS; ++ks)
#pragma unroll
                for (int j = 0; j < 8; ++j) qv[ks][j] = bf1((bf16_t)qf[ks][j]);
            float v0 = -INFINITY, v1 = -INFINITY, v2 = -INFINITY; int i0 = -1, i1 = -1, i2 = -1;
            for (int n = 0; n < own; ++n) {
                float g = 0.f;
#pragma unroll
                for (int ks = 0; ks < NKS; ++ks) { const f32x4 ka = *(const LAS f32x4*)(km + n * 64 + ks * 16 + hi * 8), kb = *(const LAS f32x4*)(km + n * 64 + ks * 16 + hi * 8 + 4);
                    g += qv[ks][0] * ka[0] + qv[ks][1] * ka[1] + qv[ks][2] * ka[2] + qv[ks][3] * ka[3] + qv[ks][4] * kb[0] + qv[ks][5] * kb[1] + qv[ks][6] * kb[2] + qv[ks][7] * kb[3]; }
                g = xsum32(g);
                if (DBG_MOBA_NOISE > 0.f) g += DBG_MOBA_NOISE * 1.7320508f * hash_noise((unsigned)(((size_t)(Qp - (const bf16_t*)0) >> 3) * 31u + (unsigned)((q0 + wid * 32 + r32) * 32 + n)));
                if (g > v0) { v2 = v1; i2 = i1; v1 = v0; i1 = i0; v0 = g; i0 = n; }
                else if (g > v1) { v2 = v1; i2 = i1; v1 = g; i1 = n; }
                else if (g > v2) { v2 = g; i2 = n; }
            }
            if (i0 >= 0) selmask |= 1u << i0;
            if (i1 >= 0) selmask |= 1u << i1;
            if (i2 >= 0) selmask |= 1u << i2;
            __syncthreads();
        }
    }
    const bf16_t* kg0 = Kp + (size_t)lane * kpitch + wid * 8;
    const bf16_t* kg1 = Kp + (size_t)lane * kpitch + (8 + (wid & 3)) * 8;
    const int vrow = tid >> 3, vpc = tid & 7;
    const bf16_t* vg = Vp + (size_t)vrow * vpitch + vpc * 8;
    const int kdst0 = wid * 1024 + lane * 16, kdst1 = (8 + (wid & 3)) * 1024 + lane * 16, vdst = (vpc >> 2) * 4096 + vrow * 64 + (vpc & 3) * 16;
    u32x4 sk0, sk1 = (u32x4){0u, 0u, 0u, 0u}, sv;
    sk0 = *(const u32x4*)kg0; if (DK == 96 && wid < 4) sk1 = *(const u32x4*)kg1; sv = *(const u32x4*)vg;
    *(LAS u32x4*)(lds + OFF_K0 + kdst0) = sk0; if (DK == 96 && wid < 4) *(LAS u32x4*)(lds + OFF_K0 + kdst1) = sk1; *(LAS u32x4*)(lds + OFF_V0 + vdst) = sv;
    float m = -1e30f, l = 0.f; f32x16 ot[2]; ot[0] = f32x16{}; ot[1] = f32x16{};
    const int qrel = wid * 32 + r32;
    const int vq = (lane & 15) >> 2, vp = lane & 3, vblk = (lane >> 4) & 1;
    const int vbase = (4 * hi + vq) * 64 + vblk * 32 + vp * 8;
    for (int t = 0; t < NT; ++t) {
        __syncthreads();
        const int cur = t & 1;
        const bool more = (t + 1 < NT);
        if (more) { const size_t ro = (size_t)(t + 1) * 64; sk0 = *(const u32x4*)(kg0 + ro * kpitch); if (DK == 96 && wid < 4) sk1 = *(const u32x4*)(kg1 + ro * kpitch); sv = *(const u32x4*)(vg + ro * vpitch); }
        const LAS unsigned char* Kb = lds + (cur ? OFF_K1 : OFF_K0); const LAS unsigned char* Vb = lds + (cur ? OFF_V1 : OFF_V0);
        const int jb = t - 4 * qb;
        bool active = true; bool lane_sel = true;
        if (jb >= 0) { if (64 * jb > wid * 32 + 31) active = false; }
        else if constexpr (MOBA) { lane_sel = (selmask >> (t >> 2)) & 1u; active = __any(lane_sel); }
        if (active) {
            f32x16 s0 = f32x16{}, s1 = f32x16{};
#pragma unroll
            for (int ks = 0; ks < NKS; ++ks) {
                const bf16x8 ka = *(const LAS bf16x8*)(Kb + (2 * ks + hi) * 1024 + r32 * 16), kb = *(const LAS bf16x8*)(Kb + (2 * ks + hi) * 1024 + (32 + r32) * 16);
                s0 = MFMA32(ka, qf[ks], s0); s1 = MFMA32(kb, qf[ks], s1);
            }
            if (jb >= 0) { if (64 * jb + 63 > wid * 32) { const int kb0 = 64 * jb + 4 * hi;
#pragma unroll
                for (int r = 0; r < 16; ++r) { const int kv = kb0 + (r & 3) + 8 * (r >> 2); if (kv > qrel) s0[r] = -INFINITY; if (kv + 32 > qrel) s1[r] = -INFINITY; } } }
            else if constexpr (MOBA) { if (!lane_sel) {
#pragma unroll
                for (int r = 0; r < 16; ++r) { s0[r] = -INFINITY; s1[r] = -INFINITY; } } }
            float tm = s0[0];
#pragma unroll
            for (int r = 1; r < 16; ++r) tm = fmaxf(tm, s0[r]);
#pragma unroll
            for (int r = 0; r < 16; ++r) tm = fmaxf(tm, s1[r]);
            tm = xmax32(tm);
            const float mn = fmaxf(m, tm);
            if (__any(tm > m + ATTN_THR)) {
            const float alpha = __builtin_amdgcn_exp2f(m - mn); l *= alpha;
#pragma unroll
                for (int r = 0; r < 16; ++r) { ot[0][r] *= alpha; ot[1][r] *= alpha; }
                m = mn; }
            float ls = 0.f;
#pragma unroll
            for (int r = 0; r < 16; ++r) { s0[r] = __builtin_amdgcn_exp2f(s0[r] - m); s1[r] = __builtin_amdgcn_exp2f(s1[r] - m); ls += s0[r] + s1[r]; }
            l += ls;
            bf16x8 pf[4];
#pragma unroll
            for (int s = 0; s < 4; ++s) { u32x4 w;
                if (s < 2) { w.x = cvt_pk_bf16(s0[8 * s], s0[8 * s + 1]); w.y = cvt_pk_bf16(s0[8 * s + 2], s0[8 * s + 3]); w.z = cvt_pk_bf16(s0[8 * s + 4], s0[8 * s + 5]); w.w = cvt_pk_bf16(s0[8 * s + 6], s0[8 * s + 7]); }
                else { const int q = s - 2; w.x = cvt_pk_bf16(s1[8 * q], s1[8 * q + 1]); w.y = cvt_pk_bf16(s1[8 * q + 2], s1[8 * q + 3]); w.z = cvt_pk_bf16(s1[8 * q + 4], s1[8 * q + 5]); w.w = cvt_pk_bf16(s1[8 * q + 6], s1[8 * q + 7]); }
                pf[s] = __builtin_bit_cast(bf16x8, w); }
#pragma unroll
            for (int db = 0; db < 2; ++db)
#pragma unroll
                for (int s = 0; s < 4; ++s) { const LAS char* vpn = (const LAS char*)Vb + db * 4096 + s * 1024 + vbase;
                    const s16x4 lo = vtr(vpn), hi4 = vtr(vpn + 512);
                    const bf16x8 vf = (bf16x8){lo[0], lo[1], lo[2], lo[3], hi4[0], hi4[1], hi4[2], hi4[3]};
                    ot[db] = MFMA32(vf, pf[s], ot[db]); }
        }
        if (more) { const int nb = cur ^ 1;
            *(LAS u32x4*)(lds + (nb ? OFF_K1 : OFF_K0) + kdst0) = sk0; if (DK == 96 && wid < 4) *(LAS u32x4*)(lds + (nb ? OFF_K1 : OFF_K0) + kdst1) = sk1; *(LAS u32x4*)(lds + (nb ? OFF_V1 : OFF_V0) + vdst) = sv; }
    }
    l = xsum32(l);
    const float rl = 1.f / l;
    bf16_t* orow = Op + (size_t)(q0 + qrel) * opitch;
#pragma unroll
    for (int db = 0; db < 2; ++db)
#pragma unroll
        for (int g = 0; g < 4; ++g) { u32x2 w; w.x = cvt_pk_bf16(ot[db][4 * g] * rl, ot[db][4 * g + 1] * rl); w.y = cvt_pk_bf16(ot[db][4 * g + 2] * rl, ot[db][4 * g + 3] * rl);
            *(u32x2*)(orow + 32 * db + 8 * g + 4 * hi) = w; }
    __syncthreads();
}

DI void moba_select_wg(LAS unsigned char* lds, int unit0  , const bf16_t* MQ, const float* kpart, unsigned* msel, unsigned* ment, unsigned* mcnt, int tid, int wave, int lane) {
    const int bh = unit0 >> 7, b = bh >> 3, h = bh & 7; const int c = (unit0 & 127) + wave, q0 = 64 * c, own = q0 >> 8;
    const int own_max = (64 * ((unit0 & 127) + 7)) >> 8;
    LAS float* km = (LAS float*)lds;
    const float* kpart_b = kpart + (size_t)b * 32 * 4 * 512 + h * 64;
    for (int e = tid; e < own_max * 64; e += NTHR) { const int n = e >> 6, d = e & 63; const float* kp = kpart_b + (size_t)n * 4 * 512 + d; km[e] = (kp[0] + kp[512] + kp[1024] + kp[1536]) * (1.f / 256.f); }
    __syncthreads();
    const int q = q0 + lane; const size_t row = (size_t)b * SEQ + q;
    float qv[64];
    { const bf16_t* qp = MQ + row * 512 + h * 64;
#pragma unroll
      for (int k = 0; k < 8; ++k) { const u32x4 w = ldg_u4(qp + 8 * k); qv[8 * k] = bf_lo(w.x); qv[8 * k + 1] = bf_hi(w.x); qv[8 * k + 2] = bf_lo(w.y); qv[8 * k + 3] = bf_hi(w.y);
          qv[8 * k + 4] = bf_lo(w.z); qv[8 * k + 5] = bf_hi(w.z); qv[8 * k + 6] = bf_lo(w.w); qv[8 * k + 7] = bf_hi(w.w); } }
    float v0 = -INFINITY, v1 = -INFINITY, v2 = -INFINITY; int i0 = -1, i1 = -1, i2 = -1;
    for (int n = 0; n < own; ++n) { float g = 0.f;
#pragma unroll
        for (int k = 0; k < 16; ++k) { const f32x4 kk = *(const LAS f32x4*)(km + n * 64 + 4 * k); g += qv[4 * k] * kk[0] + qv[4 * k + 1] * kk[1] + qv[4 * k + 2] * kk[2] + qv[4 * k + 3] * kk[3]; }
        if (g > v0) { v2 = v1; i2 = i1; v1 = v0; i1 = i0; v0 = g; i0 = n; }
        else if (g > v1) { v2 = v1; i2 = i1; v1 = g; i1 = n; }
        else if (g > v2) { v2 = g; i2 = n; } }
    const int nsel = (i0 >= 0) + (i1 >= 0) + (i2 >= 0);
    msel[(size_t)bh * SEQ + q] = (unsigned)(i0 & 255) | ((unsigned)(i1 & 255) << 8) | ((unsigned)(i2 & 255) << 16) | ((unsigned)nsel << 24);
    int r0 = 0, r1 = 0, r2 = 0, mycnt = 0;
    for (int n = 0; n < own; ++n) { const unsigned long long mk = __ballot(i0 == n || i1 == n || i2 == n);
        const int rk = (int)__builtin_amdgcn_mbcnt_hi((unsigned)(mk >> 32), __builtin_amdgcn_mbcnt_lo((unsigned)mk, 0u));
        if (i0 == n) r0 = rk; if (i1 == n) r1 = rk; if (i2 == n) r2 = rk; if (lane == n) mycnt = __builtin_popcountll(mk); }
    unsigned base = 0u;
    if (lane < own && mycnt > 0) base = __hip_atomic_fetch_add(mcnt + bh * 32 + lane, (unsigned)mycnt, __ATOMIC_RELAXED, __HIP_MEMORY_SCOPE_AGENT);
    const unsigned b0 = (unsigned)bperm((int)base, i0 & 63), b1 = (unsigned)bperm((int)base, i1 & 63), b2 = (unsigned)bperm((int)base, i2 & 63);
    if (i0 >= 0) *(GAS unsigned*)(ment + ((size_t)bh * 32 + i0) * 8192 + b0 + r0) = (unsigned)q | (0u << 13);
    if (i1 >= 0) *(GAS unsigned*)(ment + ((size_t)bh * 32 + i1) * 8192 + b1 + r1) = (unsigned)q | (1u << 13);
    if (i2 >= 0) *(GAS unsigned*)(ment + ((size_t)bh * 32 + i2) * 8192 + b2 + r2) = (unsigned)q | (2u << 13);
    __syncthreads();
}
template <bool GATHER>
DI void moba_part_unit(LAS unsigned char* lds, int bh, int blk, const unsigned* ent, int e0, int ecnt, const bf16_t* MQ, const bf16_t* MK, const bf16_t* PROJ, f32x2* PM, bf16_t* PO) {
    constexpr int NKS = 4, KBYTES = 8192, VBYTES = 8192;
    constexpr int OFF_K0 = 0, OFF_K1 = KBYTES, OFF_V0 = 2 * KBYTES, OFF_V1 = 2 * KBYTES + VBYTES;
    int tid_o = threadIdx.x; asm volatile("" : "+v"(tid_o));
    const int tid = tid_o, lane = tid & 63, r32 = lane & 31, hi = lane >> 5; const int wid = __builtin_amdgcn_readfirstlane(tid >> 6);
    const int b = bh >> 3, h = bh & 7; const size_t rb = (size_t)b * SEQ;
    int myq, slot; bool valid = true;
    if constexpr (GATHER) { const int ei = e0 + wid * 32 + r32; valid = ei < ecnt; const unsigned ew = valid ? *(const GAS unsigned*)(ent + ei) : 0u; myq = (int)(ew & 8191u); slot = (int)(ew >> 13); }
    else { myq = blk * 256 + wid * 32 + r32; slot = 3; }
    bf16x8 qf[NKS];
    { const bf16_t* qrow = MQ + (rb + myq) * 512 + h * 64 + hi * 8;
#pragma unroll
      for (int ks = 0; ks < NKS; ++ks) qf[ks] = *(const bf16x8*)(qrow + ks * 16); }
    const bf16_t* Kp = MK + (rb + (size_t)blk * 256) * 512 + h * 64; const bf16_t* Vp = PROJ + (rb + (size_t)blk * 256) * NPROJP + 1696 + h * 64;
    const bf16_t* kg0 = Kp + (size_t)lane * 512 + wid * 8;
    const int vrow = tid >> 3, vpc = tid & 7;
    const bf16_t* vg = Vp + (size_t)vrow * NPROJP + vpc * 8;
    const int kdst0 = wid * 1024 + lane * 16, vdst = (vpc >> 2) * 4096 + vrow * 64 + (vpc & 3) * 16;
    u32x4 sk0, sv;
    sk0 = *(const u32x4*)kg0; sv = *(const u32x4*)vg;
    *(LAS u32x4*)(lds + OFF_K0 + kdst0) = sk0; *(LAS u32x4*)(lds + OFF_V0 + vdst) = sv;
    float m = -1e30f, l = 0.f; f32x16 ot[2]; ot[0] = f32x16{}; ot[1] = f32x16{};
    const int qrel = wid * 32 + r32;
    const int vq = (lane & 15) >> 2, vp = lane & 3, vblk = (lane >> 4) & 1;
    const int vbase = (4 * hi + vq) * 64 + vblk * 32 + vp * 8;
    for (int t = 0; t < 4; ++t) {
        __syncthreads();
        const int cur = t & 1; const bool more = (t + 1 < 4);
        if (more) { const size_t ro = (size_t)(t + 1) * 64; sk0 = *(const u32x4*)(kg0 + ro * 512); sv = *(const u32x4*)(vg + ro * NPROJP); }
        const LAS unsigned char* Kb = lds + (cur ? OFF_K1 : OFF_K0); const LAS unsigned char* Vb = lds + (cur ? OFF_V1 : OFF_V0);
        bool active = true;
        if (!GATHER) { if (64 * t > wid * 32 + 31) active = false; }
        if (active) {
            f32x16 s0 = f32x16{}, s1 = f32x16{};
#pragma unroll
            for (int ks = 0; ks < NKS; ++ks) {
                const bf16x8 ka = *(const LAS bf16x8*)(Kb + (2 * ks + hi) * 1024 + r32 * 16), kb = *(const LAS bf16x8*)(Kb + (2 * ks + hi) * 1024 + (32 + r32) * 16);
                s0 = MFMA32(ka, qf[ks], s0); s1 = MFMA32(kb, qf[ks], s1); }
            if (!GATHER) { if (64 * t + 63 > wid * 32) { const int kb0 = 64 * t + 4 * hi;
#pragma unroll
                for (int r = 0; r < 16; ++r) { const int kv = kb0 + (r & 3) + 8 * (r >> 2); if (kv > qrel) s0[r] = -INFINITY; if (kv + 32 > qrel) s1[r] = -INFINITY; } } }
            float tm = s0[0];
#pragma unroll
            for (int r = 1; r < 16; ++r) tm = fmaxf(tm, s0[r]);
#pragma unroll
            for (int r = 0; r < 16; ++r) tm = fmaxf(tm, s1[r]);
            tm = xmax32(tm);
            const float mn = fmaxf(m, tm);
            if (__any(tm > m + ATTN_THR)) {
            const float alpha = __builtin_amdgcn_exp2f(m - mn); l *= alpha;
#pragma unroll
                for (int r = 0; r < 16; ++r) { ot[0][r] *= alpha; ot[1][r] *= alpha; }
                m = mn; }
            float ls = 0.f;
#pragma unroll
            for (int r = 0; r < 16; ++r) { s0[r] = __builtin_amdgcn_exp2f(s0[r] - m); s1[r] = __builtin_amdgcn_exp2f(s1[r] - m); ls += s0[r] + s1[r]; }
            l += ls;
            bf16x8 pf[4];
#pragma unroll
            for (int s = 0; s < 4; ++s) { u32x4 w;
                if (s < 2) { w.x = cvt_pk_bf16(s0[8 * s], s0[8 * s + 1]); w.y = cvt_pk_bf16(s0[8 * s + 2], s0[8 * s + 3]); w.z = cvt_pk_bf16(s0[8 * s + 4], s0[8 * s + 5]); w.w = cvt_pk_bf16(s0[8 * s + 6], s0[8 * s + 7]); }
                else { const int q = s - 2; w.x = cvt_pk_bf16(s1[8 * q], s1[8 * q + 1]); w.y = cvt_pk_bf16(s1[8 * q + 2], s1[8 * q + 3]); w.z = cvt_pk_bf16(s1[8 * q + 4], s1[8 * q + 5]); w.w = cvt_pk_bf16(s1[8 * q + 6], s1[8 * q + 7]); }
                pf[s] = __builtin_bit_cast(bf16x8, w); }
#pragma unroll
            for (int db = 0; db < 2; ++db)
#pragma unroll
                for (int s = 0; s < 4; ++s) { const LAS char* vpn = (const LAS char*)Vb + db * 4096 + s * 1024 + vbase;
                    const s16x4 lo = vtr(vpn), hi4 = vtr(vpn + 512);
                    const bf16x8 vf = (bf16x8){lo[0], lo[1], lo[2], lo[3], hi4[0], hi4[1], hi4[2], hi4[3]};
                    ot[db] = MFMA32(vf, pf[s], ot[db]); }
        }
        if (more) { const int nb = cur ^ 1; *(LAS u32x4*)(lds + (nb ? OFF_K1 : OFF_K0) + kdst0) = sk0; *(LAS u32x4*)(lds + (nb ? OFF_V1 : OFF_V0) + vdst) = sv; }
    }
    l = xsum32(l);
    const float rl = 1.f / l;
    if (valid) { const size_t pi = ((size_t)bh * SEQ + myq) * 4 + slot;
        if (hi == 0) PM[pi] = (f32x2){m, l};
        bf16_t* orow = PO + pi * 64;
#pragma unroll
        for (int db = 0; db < 2; ++db)
#pragma unroll
            for (int g = 0; g < 4; ++g) { u32x2 w; w.x = cvt_pk_bf16(ot[db][4 * g] * rl, ot[db][4 * g + 1] * rl); w.y = cvt_pk_bf16(ot[db][4 * g + 2] * rl, ot[db][4 * g + 3] * rl);
                *(u32x2*)(orow + 32 * db + 8 * g + 4 * hi) = w; } }
    __syncthreads();
}
template <int NI>
DI void moba_merge(const int (&gi8s)[NI], const bool (&ok)[NI], const unsigned* msel, const f32x2* PM, const bf16_t* PO, bf16_t* OB) {
    unsigned ms[NI]; f32x2 ml[NI][4]; u32x4 po[NI][4];
#pragma unroll
    for (int t = 0; t < NI; ++t) { const int gi = gi8s[t] >> 3, k = gi8s[t] & 7; const size_t pi = (size_t)gi * 4; ms[t] = (unsigned)ldg_i(msel + gi);
#pragma unroll
        for (int j = 0; j < 4; ++j) { ml[t][j] = *(const GAS f32x2*)(PM + pi + j); po[t][j] = ldg_u4(PO + (pi + j) * 64 + 8 * k); } }
#pragma unroll
    for (int t = 0; t < NI; ++t) { if (!ok[t]) continue;
        const int gi = gi8s[t] >> 3, k = gi8s[t] & 7; const int bh = gi >> 13, q = gi & 8191, b = bh >> 3, h = bh & 7;
        const int nsel = (int)(ms[t] >> 24) & 3;
        float mj[4], wj[4]; float M = -1e30f;
#pragma unroll
        for (int j = 0; j < 4; ++j) { const bool use = (j == 3) || (j < nsel); mj[j] = use ? ml[t][j].x : -1e30f; wj[j] = use ? ml[t][j].y : 0.f; M = fmaxf(M, mj[j]); }
        float ws_ = 0.f;
#pragma unroll
        for (int j = 0; j < 4; ++j) { wj[j] = (wj[j] > 0.f) ? wj[j] * __builtin_amdgcn_exp2f(mj[j] - M) : 0.f; ws_ += wj[j]; }
        const float rinv = 1.f / ws_;
        float acc[8] = {0.f, 0.f, 0.f, 0.f, 0.f, 0.f, 0.f, 0.f};
#pragma unroll
        for (int j = 0; j < 4; ++j) { const bool on = wj[j] > 0.f; const float f = wj[j] * rinv; const u32x4 w = po[t][j];
            acc[0] += on ? f * bf_lo(w.x) : 0.f; acc[1] += on ? f * bf_hi(w.x) : 0.f; acc[2] += on ? f * bf_lo(w.y) : 0.f; acc[3] += on ? f * bf_hi(w.y) : 0.f;
            acc[4] += on ? f * bf_lo(w.z) : 0.f; acc[5] += on ? f * bf_hi(w.z) : 0.f; acc[6] += on ? f * bf_lo(w.w) : 0.f; acc[7] += on ? f * bf_hi(w.w) : 0.f; }
        u32x4 o; o.x = cvt_pk_bf16(acc[0], acc[1]); o.y = cvt_pk_bf16(acc[2], acc[3]); o.z = cvt_pk_bf16(acc[4], acc[5]); o.w = cvt_pk_bf16(acc[6], acc[7]);
        stg_u4(OB + ((size_t)b * SEQ + q) * 1024 + 512 + h * 64 + 8 * k, o); }
}

DI float naive_attn_sample(int smp, int mode, const bf16_t* QM, const bf16_t* KM, const bf16_t* VM, const bf16_t* MQ, const bf16_t* MK, const bf16_t* PROJ, const float* kpart, const bf16_t* OB, int lane) {
    const int b = smp & 1, h = (smp >> 1) & 7, qi = smp >> 4;
    const int special[24] = {0, 1, 31, 32, 63, 64, 127, 128, 255, 256, 257, 319, 320, 511, 512, 767, 768, 1023, 1024, 4095, 4096, 4097, 8190, 8191};
    int q = 0;
#pragma unroll
    for (int i = 0; i < 24; ++i) if (qi == i) q = special[i];
    if (qi >= 24) { unsigned x = (unsigned)qi * 2654435761u; x ^= x >> 15; q = (int)(x % 8192u); }
    const size_t rb = (size_t)b * SEQ; const int own = q >> 8;
    const int DKn = (mode == 1) ? 96 : 64;
    const bf16_t* qp = (mode == 1) ? QM + (rb + q) * 768 + h * 96 : MQ + (rb + q) * 512 + h * 64;
    float m = -1e30f, sum = 0.f; float acc[64];
#pragma unroll
    for (int d = 0; d < 64; ++d) acc[d] = 0.f;
    unsigned selmask = 0u;
    if (mode == 2 && own > 0) {
        float g = -INFINITY;
        if (lane < own) { g = 0.f; const float* kp = kpart + (size_t)b * 32 * 4 * 512 + (size_t)lane * 4 * 512 + h * 64;
            for (int d = 0; d < 64; ++d) g += bf1(qp[d]) * ((kp[d] + kp[512 + d] + kp[1024 + d] + kp[1536 + d]) * (1.f / 256.f)); }
        for (int r = 0; r < 3 && r < own; ++r) { const float mx = wave_max_all(g); const unsigned long long bm = __ballot(g == mx); const int w = __builtin_ctzll(bm); selmask |= 1u << w; if (lane == w) g = -INFINITY; }
    }
    const int nkeys = q + 1;
    for (int k0 = 0; k0 < nkeys; k0 += 64) { const int key = k0 + lane; bool use = key < nkeys;
        if (mode == 2) { const int kb = key >> 8; use = use && (kb == own || ((selmask >> kb) & 1u)); }
        const unsigned long long any = __ballot(use);
        if (!any) continue;
        if (use) { float sc = 0.f;
            const bf16_t* kp = (mode == 1) ? KM + (rb + key) * 768 + h * 96 : MK + (rb + key) * 512 + h * 64;
            for (int d = 0; d < DKn; ++d) sc += bf1(qp[d]) * bf1(kp[d]);
            const bf16_t* vp = (mode == 1) ? VM + (rb + key) * 512 + h * 64 : PROJ + (rb + key) * NPROJP + 1696 + h * 64;
            const float mn = fmaxf(m, sc), al = __builtin_amdgcn_exp2f(m - mn), pp = __builtin_amdgcn_exp2f(sc - mn);
            sum = sum * al + pp;
#pragma unroll
            for (int d = 0; d < 64; ++d) acc[d] = acc[d] * al + pp * bf1(vp[d]);
            m = mn; } }
    const float M = wave_max_all(m), f = __builtin_amdgcn_exp2f(m - M);
    const float tot = wave_sum(sum * f);
    float dmax = 0.f;
    const bf16_t* op = OB + (rb + q) * 1024 + ((mode == 1) ? h * 64 : 512 + h * 64);
#pragma unroll
    for (int d = 0; d < 64; ++d) { const float o = wave_sum(acc[d] * f) / tot; const float df = fabsf(o - bf1(op[d])); dmax = (df == df) ? fmaxf(dmax, df) : 1e30f; }
    return dmax;
}

DI void dwconv_unit(LAS unsigned char* lds, int unit, const bf16_t* ug, const float (&w)[31][2], float b0, float b1, float g0, float g1, float be0, float be1, bf16_t* y, int tid) {
    const int row0 = unit * 16, tb = row0 % SEQ;
    for (int c = tid; c < 46 * 128; c += NTHR) { const int r = c >> 7, pc = c & 127; const int trel = tb - 30 + r;
        u32x4 v = (u32x4){0u, 0u, 0u, 0u};
        if (trel >= 0) v = *(const u32x4*)(ug + (size_t)(row0 - 30 + r) * DM + pc * 8);
        *(LAS u32x4*)(lds + r * 2048 + pc * 16) = v; }
    __syncthreads();
    unsigned xs[46];
#pragma unroll
    for (int r = 0; r < 46; ++r) xs[r] = *(const LAS unsigned*)(lds + r * 2048 + tid * 4);
    float a0[16], a1[16];
#pragma unroll
    for (int i = 0; i < 16; ++i) { float s0 = b0, s1 = b1;
#pragma unroll
        for (int j = 0; j < 31; ++j) { s0 += w[j][0] * bf_lo(xs[i + j]); s1 += w[j][1] * bf_hi(xs[i + j]); }
        a0[i] = s0; a1[i] = s1; }
    __syncthreads();
    LAS float* red = (LAS float*)lds;
    const int lane = tid & 63, wave = tid >> 6;
#pragma unroll
    for (int i = 0; i < 16; ++i) { const float s = wave_sum(a0[i] + a1[i]), q = wave_sum(a0[i] * a0[i] + a1[i] * a1[i]);
        if (lane == 0) { red[wave * 32 + i] = s; red[wave * 32 + 16 + i] = q; } }
    __syncthreads();
    if (tid < 32) { float t = 0.f;
#pragma unroll
        for (int wv = 0; wv < 8; ++wv) t += red[wv * 32 + tid];
        red[256 + tid] = t; }
    __syncthreads();
#pragma unroll
    for (int i = 0; i < 16; ++i) { const float s = red[256 + i], q = red[256 + 16 + i];
        const float mean = s * (1.f / DM), var = fmaxf(q * (1.f / DM) - mean * mean, 0.f), rstd = rsqrtf(var + NORM_EPS);
        const float z0 = (a0[i] - mean) * rstd * g0 + be0, z1 = (a1[i] - mean) * rstd * g1 + be1;
        const float o0 = z0 / (1.f + __expf(-z0)), o1 = z1 / (1.f + __expf(-z1));
        *(unsigned*)(y + (size_t)(row0 + i) * DM + 2 * tid) = cvt_pk_bf16(o0, o1); }
    __syncthreads();
}

#define CE_DESC(a, b) do { const float _h = fmaxf((a), (b)), _l = fminf((a), (b)); (a) = _h; (b) = _l; } while (0)
DI void sort16_desc(float (&a)[16]) {
#pragma unroll
    for (int p = 1; p < 16; p <<= 1)
#pragma unroll
        for (int k = p; k >= 1; k >>= 1)
#pragma unroll
            for (int j = k % p; j <= 15 - k; j += 2 * k)
#pragma unroll
                for (int i = 0; i <= (k - 1 < 15 - j - k ? k - 1 : 15 - j - k); ++i)
                    if ((i + j) / (2 * p) == (i + j + k) / (2 * p)) CE_DESC(a[i + j], a[i + j + k]);
}
DI void merge16_desc(float (&a)[16], const float (&b)[16]) {
#pragma unroll
    for (int i = 0; i < 16; ++i) a[i] = fmaxf(a[i], b[15 - i]);
#pragma unroll
    for (int j = 8; j > 0; j >>= 1)
#pragma unroll
        for (int i = 0; i < 16; ++i) { const int p = i ^ j; if (p > i) CE_DESC(a[i], a[p]); }
}
DI void top16_of_64(float (&g0)[16], float (&g1)[16], float (&g2)[16], float (&g3)[16]) {
    sort16_desc(g0); sort16_desc(g1); sort16_desc(g2); sort16_desc(g3);
    merge16_desc(g0, g1); merge16_desc(g2, g3); merge16_desc(g0, g2);
}
DI float pack_key(float v, unsigned code, unsigned mask) { return __builtin_bit_cast(float, (__builtin_bit_cast(unsigned, v) & ~mask) | code); }

DI void peer_topk_unit(const LAS unsigned char* sk, LAS unsigned* dec  , const bf16_t* q2, int tile, int h, int* idx, float* gate, int lane) {
    const int r32 = lane & 31, hi = lane >> 5; const int tok = tile * 32 + r32;
    float L[2][16];
#pragma unroll
    for (int c = 0; c < 2; ++c) {
        bf16x8 qf[8];
        const bf16_t* qrow = q2 + (size_t)tok * 2048 + (h * 2 + c) * 128 + hi * 8;
#pragma unroll
        for (int ks = 0; ks < 8; ++ks) qf[ks] = *(const bf16x8*)(qrow + ks * 16);
        f32x16 acc[4];
#pragma unroll
        for (int kt = 0; kt < 4; ++kt) { acc[kt] = f32x16{};
#pragma unroll
            for (int ks = 0; ks < 8; ++ks) { const bf16x8 a = *(const LAS bf16x8*)(sk + c * 32768 + (2 * ks + hi) * 2048 + (32 * kt + r32) * 16); acc[kt] = MFMA32(a, qf[ks], acc[kt]); } }
        float g[4][16];
#pragma unroll
        for (int kt = 0; kt < 4; ++kt)
#pragma unroll
            for (int r = 0; r < 16; ++r) { const int key = 32 * kt + (r & 3) + 8 * (r >> 2) + 4 * hi; float sc_ = acc[kt][r]; if (DBG_PEER_NOISE > 0.f) sc_ += DBG_PEER_NOISE * 1.7320508f * hash_noise((unsigned)(((tok * 8 + h) * 2 + c) * 128 + key));
                g[kt][r] = pack_key(sc_, 127u - (unsigned)key, 127u); }
        top16_of_64(g[0], g[1], g[2], g[3]);
        float other[16];
#pragma unroll
        for (int i = 0; i < 16; ++i) other[i] = xchg32(g[0][i], lane < 32);
        merge16_desc(g[0], other);
#pragma unroll
        for (int i = 0; i < 16; ++i) L[c][i] = g[0][i];
    }
#pragma unroll
    for (int c = 0; c < 2; ++c)
#pragma unroll
        for (int q = 0; q < 4; ++q) { unsigned w = 0u;
#pragma unroll
            for (int e = 0; e < 4; ++e) w |= (127u - (__builtin_bit_cast(unsigned, L[c][4 * q + e]) & 127u)) << (8 * e);
            dec[(c * 4 + q) * 64 + lane] = w; }
    const float PAD = -3.0e38f;
    float c0[16], c1[16], c2[16], c3[16];
#define CAND(i, j) pack_key(L[0][i] + L[1][j], 255u - (unsigned)(16 * (i) + (j)), 255u)
#pragma unroll
    for (int j = 0; j < 16; ++j) c0[j] = CAND(0, j);
#pragma unroll
    for (int j = 0; j < 8; ++j) c1[j] = CAND(1, j);
#pragma unroll
    for (int j = 0; j < 5; ++j) c1[8 + j] = CAND(2, j);
    c1[13] = PAD; c1[14] = PAD; c1[15] = PAD;
#pragma unroll
    for (int j = 0; j < 4; ++j) c2[j] = CAND(3, j);
#pragma unroll
    for (int j = 0; j < 3; ++j) c2[4 + j] = CAND(4, j);
    c2[7] = CAND(5, 0); c2[8] = CAND(5, 1); c2[9] = CAND(6, 0); c2[10] = CAND(6, 1); c2[11] = CAND(7, 0); c2[12] = CAND(7, 1);
    c2[13] = PAD; c2[14] = PAD; c2[15] = PAD;
#pragma unroll
    for (int i = 0; i < 8; ++i) { c3[i] = CAND(8 + i, 0); c3[8 + i] = PAD; }
#undef CAND
    sort16_desc(c1); sort16_desc(c2);
    merge16_desc(c0, c1); merge16_desc(c2, c3); merge16_desc(c0, c2);
    float e[16], sum = 0.f;
#pragma unroll
    for (int k = 0; k < 16; ++k) { e[k] = __builtin_amdgcn_exp2f((c0[k] - c0[0]) * LOG2E); sum += e[k]; }
    const float rs = 1.f / sum;
    LDS_WAIT();
    int ids[16];
#pragma unroll
    for (int k = 0; k < 16; ++k) { const unsigned code = 255u - (__builtin_bit_cast(unsigned, c0[k]) & 255u); const unsigned i = code >> 4, j = code & 15u;
        const unsigned w1 = dec[(i >> 2) * 64 + lane], w2 = dec[(4 + (j >> 2)) * 64 + lane];
        ids[k] = (int)(((w1 >> (8 * (i & 3))) & 127u) * 128u + ((w2 >> (8 * (j & 3))) & 127u)); }
    if (hi == 0) {
        int* ip = idx + (size_t)tok * 128 + h * 16; float* gp = gate + (size_t)tok * 128 + h * 16;
#pragma unroll
        for (int q = 0; q < 4; ++q) { *(int4*)(ip + 4 * q) = make_int4(ids[4 * q], ids[4 * q + 1], ids[4 * q + 2], ids[4 * q + 3]);
            *(f32x4*)(gp + 4 * q) = (f32x4){e[4 * q] * rs, e[4 * q + 1] * rs, e[4 * q + 2] * rs, e[4 * q + 3] * rs}; }
    }
    LDS_WAIT();
}

DI int wave_red63_i(int v) {
    v += __builtin_amdgcn_update_dpp(0, v, 0xB1, 0xF, 0xF, false);
    v += __builtin_amdgcn_update_dpp(0, v, 0x4E, 0xF, 0xF, false);
    v += __builtin_amdgcn_update_dpp(0, v, 0x141, 0xF, 0xF, false);
    v += __builtin_amdgcn_update_dpp(0, v, 0x140, 0xF, 0xF, false);
    v += __builtin_amdgcn_update_dpp(0, v, 0x142, 0xA, 0xF, false);
    v += __builtin_amdgcn_update_dpp(0, v, 0x143, 0xC, 0xF, false);
    return __builtin_amdgcn_readlane(v, 63);
}
template <int NR>
DI void quant_rows(const float* src, unsigned char* dst, float* scale_out, int off, int lane, bool colslice, int erow) {
    f32x4 v[NR][4];
#pragma unroll
    for (int r = 0; r < NR; ++r)
#pragma unroll
        for (int q = 0; q < 4; ++q) v[r][q] = __builtin_nontemporal_load((const GAS f32x4*)(src + (size_t)r * 1024 + 256 * q + 4 * lane));
#pragma unroll
    for (int r = 0; r < NR; ++r) {
        float am = 0.f;
#pragma unroll
        for (int q = 0; q < 4; ++q)
#pragma unroll
            for (int e = 0; e < 4; ++e) am = fmaxf(am, fabsf(v[r][q][e]));
        am = wave_max_all(am);
        const float inv = am > 0.f ? 127.f / am : 0.f;
#pragma unroll
        for (int q = 0; q < 4; ++q) { const unsigned o = pack4_i8(v[r][q][0], v[r][q][1], v[r][q][2], v[r][q][3], inv, off);
            if (colslice) *(GAS unsigned*)(dst + ((size_t)(2 * q + (lane >> 5)) * 16384 + (size_t)(erow + r)) * 128 + 4 * (lane & 31)) = o;
            else *(GAS unsigned*)(dst + (size_t)r * 1024 + 256 * q + 4 * lane) = o; }
        if (lane == 0) scale_out[r] = am * (1.f / 127.f);
    }
}

DI void peer_build_lists(int tok0, const int* idx, unsigned* ent, unsigned* cnt, volatile LAS unsigned* wtot, int wave, int lane, const float* hrows, const float* gain, unsigned char* xq, float* sx) {
    int id0[8], id1[8], r0[8], r1[8], c0s[8], c1s[8], st[8]; int tot = 0;
#pragma unroll
    for (int i = 0; i < 8; ++i) { id0[i] = ldg_i(idx + (size_t)(tok0 + i) * 128 + lane); id1[i] = ldg_i(idx + (size_t)(tok0 + i) * 128 + 64 + lane); }
#pragma unroll
    for (int i = 0; i < 8; ++i) { const int x0 = id0[i] >> 11, x1 = id1[i] >> 11; r0[i] = 0; r1[i] = 0; c0s[i] = 0; c1s[i] = 0; st[i] = tot;
#pragma unroll
        for (int x = 0; x < 8; ++x) { const unsigned long long m0 = __ballot(x0 == x), m1 = __ballot(x1 == x);
            const int c0 = __builtin_popcountll(m0), c1 = __builtin_popcountll(m1);
            const int b0 = (int)__builtin_amdgcn_mbcnt_hi((unsigned)(m0 >> 32), __builtin_amdgcn_mbcnt_lo((unsigned)m0, 0u));
            const int b1 = (int)__builtin_amdgcn_mbcnt_hi((unsigned)(m1 >> 32), __builtin_amdgcn_mbcnt_lo((unsigned)m1, 0u));
            if (x0 == x) { r0[i] = b0; c0s[i] = c0 + c1; } if (x1 == x) { r1[i] = c0 + b1; c1s[i] = c0 + c1; } if (lane == x) tot += (c0 + c1 + 3) & ~3; } }
#pragma unroll 4
    for (int i = 0; i < 8; ++i) { const float* xr = hrows + (size_t)(tok0 + i) * DM; f32x4 v[4]; float sq = 0.f;
#pragma unroll
        for (int jj = 0; jj < 4; ++jj) { v[jj] = ldg_f4(xr + 4 * lane + 256 * jj); sq += (v[jj].x * v[jj].x + v[jj].y * v[jj].y) + (v[jj].z * v[jj].z + v[jj].w * v[jj].w); }
        const float r = rsqrtf(wave_sum(sq) * (1.f / DM) + NORM_EPS); float am = 0.f;
#pragma unroll
        for (int jj = 0; jj < 4; ++jj) { v[jj] = v[jj] * r * ldg_f4(gain + 4 * lane + 256 * jj); am = fmaxf(fmaxf(am, fabsf(v[jj].x)), fmaxf(fmaxf(fabsf(v[jj].y), fabsf(v[jj].z)), fabsf(v[jj].w))); }
        am = wave_max_all(am); const float inv = am > 0.f ? 127.f / am : 0.f;
#pragma unroll
        for (int jj = 0; jj < 4; ++jj) *(GAS unsigned*)(xq + (size_t)(tok0 + i) * 1024 + 4 * lane + 256 * jj) = pack4_i8(v[jj].x, v[jj].y, v[jj].z, v[jj].w, inv, 0);
        if (lane == 0) sx[tok0 + i] = am * (1.f / 127.f); }
    unsigned base = 0u;
    if (lane < 8) wtot[wave * 8 + lane] = (unsigned)tot;
    __syncthreads();
    if (wave == 0 && lane < 8) { unsigned sum = 0u;
#pragma unroll
        for (int w = 0; w < NWAVES; ++w) sum += wtot[w * 8 + lane];
        wtot[64 + lane] = __hip_atomic_fetch_add(cnt + lane * 64, sum, __ATOMIC_RELAXED, __HIP_MEMORY_SCOPE_AGENT); }
    __syncthreads();
    if (lane < 8) { base = wtot[64 + lane];
        for (int w = 0; w < wave; ++w) base += wtot[w * 8 + lane]; }
    __syncthreads();
#pragma unroll
    for (int i = 0; i < 8; ++i) { const int x0 = id0[i] >> 11, x1 = id1[i] >> 11; const int bs = (int)base + st[i];
        const unsigned g0 = (unsigned)bperm(bs, x0), g1 = (unsigned)bperm(bs, x1);
        const unsigned w0 = ((unsigned)(tok0 + i) << 18) | ((unsigned)lane << 11) | ((unsigned)id0[i] & 2047u), w1 = ((unsigned)(tok0 + i) << 18) | ((unsigned)(64 + lane) << 11) | ((unsigned)id1[i] & 2047u);
        GAS unsigned* e0 = (GAS unsigned*)(ent + (size_t)x0 * ENT_CAP + g0); GAS unsigned* e1 = (GAS unsigned*)(ent + (size_t)x1 * ENT_CAP + g1);
        e0[r0[i]] = w0; e1[r1[i]] = w1;
        { const int c = c0s[i], np = ((c + 3) & ~3) - c; for (int k = r0[i]; k < np; k += c) e0[c + k] = w0; }
        { const int c = c1s[i], np = ((c + 3) & ~3) - c; for (int k = r1[i]; k < np; k += c) e1[c + k] = w1; } }
}
DI int xsum16_32_i(int v) {
    auto a = __builtin_amdgcn_permlane16_swap((unsigned)v, (unsigned)v, false, false); const unsigned a0 = a[0], a1 = a[1];
    v = (int)a0 + (int)a1;
    auto b = __builtin_amdgcn_permlane32_swap((unsigned)v, (unsigned)v, false, false); const unsigned b0 = b[0], b1 = b[1];
    return (int)b0 + (int)b1;
}
DI void peer_u_slice(const unsigned* ent, int e_lo, int e_hi, const unsigned char* U8s, const float* sus, const float* svs, const float* gate, const unsigned char* XQ, const float* SX, float* WV, int lane_in) {
    int lane = lane_in; asm volatile("" : "+v"(lane));
    const __amdgpu_buffer_rsrc_t urs = mk_rsrc(U8s), xrs = mk_rsrc(XQ);
    for (int sb = e_lo; sb < e_hi; sb += 64) {
        const int myi = sb + lane; const bool valid = myi < e_hi;
        const unsigned ew = valid ? *(const GAS unsigned*)(ent + myi) : 0u;
        const int mt = (int)(ew >> 18), me = (int)(ew & 2047u);
        const float sc = ldg_f(sus + me) * ldg_f(SX + mt);
        const float gsv = ldg_f(gate + (size_t)mt * 128 + ((ew >> 11) & 127u)) * ldg_f(svs + me);
        float res = 0.f;
        u32x4 Au[4], Bu[4], Ax, Bx; const bool b0 = lane & 1, b1 = lane & 2; const int lane16 = 16 * lane;
#define PU_LOAD(bu, bx, k) do { _Pragma("unroll") for (int i_ = 0; i_ < 4; ++i_) { const unsigned w_ = (unsigned)__builtin_amdgcn_readlane((int)ew, 4 * (k) + i_); \
            bu[i_] = ldb_u4s(urs, lane16, (int)((w_ & 2047u) << 10)); if (i_ == 0) bx = ldb_u4s(xrs, lane16, (int)((w_ >> 18) << 10)); } } while (0)
#define PU_COMP(bu, bx, k) do { int d_[4]; _Pragma("unroll") for (int i_ = 0; i_ < 4; ++i_) { int t_ = 0; \
            t_ = __builtin_amdgcn_sdot4((int)bu[i_].x, (int)bx.x, t_, false); t_ = __builtin_amdgcn_sdot4((int)bu[i_].y, (int)bx.y, t_, false); \
            t_ = __builtin_amdgcn_sdot4((int)bu[i_].z, (int)bx.z, t_, false); t_ = __builtin_amdgcn_sdot4((int)bu[i_].w, (int)bx.w, t_, false); d_[i_] = t_; } \
              \
            const int k01_ = b0 ? d_[1] : d_[0], s01_ = b0 ? d_[0] : d_[1], k23_ = b0 ? d_[3] : d_[2], s23_ = b0 ? d_[2] : d_[3]; \
            const int p01_ = k01_ + __builtin_amdgcn_update_dpp(0, s01_, 0xB1, 0xF, 0xF, false), p23_ = k23_ + __builtin_amdgcn_update_dpp(0, s23_, 0xB1, 0xF, 0xF, false); \
            const int kq_ = b1 ? p23_ : p01_, sq_ = b1 ? p01_ : p23_; \
            int v_ = kq_ + __builtin_amdgcn_update_dpp(0, sq_, 0x4E, 0xF, 0xF, false); \
            v_ += __builtin_amdgcn_update_dpp(0, v_, 0x124, 0xF, 0xF, false);     \
            v_ += __builtin_amdgcn_update_dpp(0, v_, 0x128, 0xF, 0xF, false);     \
            v_ = xsum16_32_i(v_); \
            if ((lane >> 2) == (k)) res = (float)v_; } while (0)
        PU_LOAD(Au, Ax, 0);
#pragma nounroll
        for (int k = 0; k < 16; k += 2) {
            PU_LOAD(Bu, Bx, k + 1);
            __builtin_amdgcn_sched_barrier(0);
            PU_COMP(Au, Ax, k);
            __builtin_amdgcn_sched_barrier(0);
            const int kn = (k + 2 < 16) ? k + 2 : 15;
            PU_LOAD(Au, Ax, kn);
            __builtin_amdgcn_sched_barrier(0);
            PU_COMP(Bu, Bx, k + 1);
            __builtin_amdgcn_sched_barrier(0);
        }
#undef PU_LOAD
#undef PU_COMP
        if (valid) { const float a_ = res * sc; *(GAS float*)(WV + (size_t)mt * 128 + ((ew >> 11) & 127u)) = gsv * 0.5f * a_ * (1.f + erff(a_ * 0.70710678118654752f)); }
    }
}
DI void ubfma4(float (&o)[16], int base, unsigned w, float wt) {
    o[base + 0] += wt * (float)(w & 255u); o[base + 1] += wt * (float)((w >> 8) & 255u); o[base + 2] += wt * (float)((w >> 16) & 255u); o[base + 3] += wt * (float)(w >> 24);
}
DI float xsum16_32(float v) {
    auto a = __builtin_amdgcn_permlane16_swap(__float_as_uint(v), __float_as_uint(v), false, false);
    const unsigned a0 = a[0], a1 = a[1];
    v = __uint_as_float(a0) + __uint_as_float(a1);
    auto b = __builtin_amdgcn_permlane32_swap(__float_as_uint(v), __float_as_uint(v), false, false);
    const unsigned b0 = b[0], b1 = b[1];
    return __uint_as_float(b0) + __uint_as_float(b1);
}
#define DPP_ADD(v, ctrl) ((v) + __builtin_bit_cast(float, __builtin_amdgcn_update_dpp(0, __builtin_bit_cast(int, (v)), (ctrl), 0xF, 0xF, false)))
DI float wave_sum_valu(float v) {
    v = DPP_ADD(v, 0xB1); v = DPP_ADD(v, 0x4E); v = DPP_ADD(v, 0x141); v = DPP_ADD(v, 0x140);
    return xsum16_32(v);
}
DI void tdot4(int (&acc)[16], int base, unsigned r0, unsigned r1, unsigned r2, unsigned r3, int P) {
    const unsigned t01l = __builtin_amdgcn_perm(r1, r0, 0x05010400u), t01h = __builtin_amdgcn_perm(r1, r0, 0x07030602u);
    const unsigned t23l = __builtin_amdgcn_perm(r3, r2, 0x05010400u), t23h = __builtin_amdgcn_perm(r3, r2, 0x07030602u);
    acc[base + 0] = __builtin_amdgcn_sdot4((int)__builtin_amdgcn_perm(t23l, t01l, 0x05040100u), P, acc[base + 0], false);
    acc[base + 1] = __builtin_amdgcn_sdot4((int)__builtin_amdgcn_perm(t23l, t01l, 0x07060302u), P, acc[base + 1], false);
    acc[base + 2] = __builtin_amdgcn_sdot4((int)__builtin_amdgcn_perm(t23h, t01h, 0x05040100u), P, acc[base + 2], false);
    acc[base + 3] = __builtin_amdgcn_sdot4((int)__builtin_amdgcn_perm(t23h, t01h, 0x07060302u), P, acc[base + 3], false);
}
DI void peer_v_cols(int x, int t0, int tstep, const int* IDX, const float* WV, const unsigned char* Vx, const float* hin, float* hout, bf16_t* hb, float* ss, int lane_in) {
    int lane = lane_in; asm volatile("" : "+v"(lane));
    const int j = lane >> 3, c = lane & 7;
    if (t0 >= TT) return;
    int a0, a1, b0 = 0, b1 = 0, n0 = 0, n1 = 0; float aw0, aw1, bw0 = 0.f, bw1 = 0.f, nw0 = 0.f, nw1 = 0.f;
    u32x4 RA[16], RB[16]; f32x2 H;
    const __amdgpu_buffer_rsrc_t vrs = mk_rsrc(Vx);
    const bool j0 = lane & 8, j1 = lane & 16, j2 = lane & 32;
    const int mycol = 128 * x + 16 * c + (j0 ? 8 : 0) + (j1 ? 4 : 0) + (j2 ? 2 : 0);
#define PV_IDX(t, i0, i1, w0, w1) do { i0 = ldg_i(IDX + (size_t)(t) * 128 + lane); i1 = ldg_i(IDX + (size_t)(t) * 128 + 64 + lane); w0 = ldg_f(WV + (size_t)(t) * 128 + lane); w1 = ldg_f(WV + (size_t)(t) * 128 + 64 + lane); } while (0)
#define PV_ROWS(R, i0, i1) do { _Pragma("unroll") for (int i_ = 0; i_ < 16; ++i_) { const int e_ = bperm(i_ < 8 ? i0 : i1, 32 * ((i_ >> 2) & 1) + 4 * j + (i_ & 3)); R[i_] = ldb_u4(vrs, e_ * 128 + 16 * c); } } while (0)
#define PV_HLD(t) do { H = *(const GAS f32x2*)(hin + (size_t)(t) * DM + mycol); } while (0)
#define PV_TOKEN(R, w0, w1, t) do { int acc[16]; _Pragma("unroll") for (int k_ = 0; k_ < 16; ++k_) acc[k_] = 0; \
        float wm = fmaxf(fabsf(w0), fabsf(w1)); \
        wm = fmaxf(wm, __builtin_bit_cast(float, __builtin_amdgcn_update_dpp(0, __builtin_bit_cast(int, wm), 0xB1, 0xF, 0xF, false))); \
        wm = fmaxf(wm, __builtin_bit_cast(float, __builtin_amdgcn_update_dpp(0, __builtin_bit_cast(int, wm), 0x4E, 0xF, 0xF, false))); \
        wm = fmaxf(wm, __builtin_bit_cast(float, __builtin_amdgcn_update_dpp(0, __builtin_bit_cast(int, wm), 0x141, 0xF, 0xF, false))); \
        wm = fmaxf(wm, __builtin_bit_cast(float, __builtin_amdgcn_update_dpp(0, __builtin_bit_cast(int, wm), 0x140, 0xF, 0xF, false))); \
        { auto pa_ = __builtin_amdgcn_permlane16_swap(__float_as_uint(wm), __float_as_uint(wm), false, false); const unsigned p0_ = pa_[0], p1_ = pa_[1]; wm = fmaxf(__uint_as_float(p0_), __uint_as_float(p1_)); \
          auto pb_ = __builtin_amdgcn_permlane32_swap(__float_as_uint(wm), __float_as_uint(wm), false, false); const unsigned q0_ = pb_[0], q1_ = pb_[1]; wm = fmaxf(__uint_as_float(q0_), __uint_as_float(q1_)); } \
        const float winv_ = wm > 0.f ? 127.f / wm : 0.f, wsc_ = wm * (1.f / 127.f); \
        const int qq0_ = __float2int_rn(w0 * winv_) & 255, qq1_ = __float2int_rn(w1 * winv_) & 255; \
        const int D0_ = __builtin_amdgcn_update_dpp(0, qq0_, 0x00, 0xF, 0xF, false) | (__builtin_amdgcn_update_dpp(0, qq0_, 0x55, 0xF, 0xF, false) << 8) | (__builtin_amdgcn_update_dpp(0, qq0_, 0xAA, 0xF, 0xF, false) << 16) | (__builtin_amdgcn_update_dpp(0, qq0_, 0xFF, 0xF, 0xF, false) << 24); \
        const int D1_ = __builtin_amdgcn_update_dpp(0, qq1_, 0x00, 0xF, 0xF, false) | (__builtin_amdgcn_update_dpp(0, qq1_, 0x55, 0xF, 0xF, false) << 8) | (__builtin_amdgcn_update_dpp(0, qq1_, 0xAA, 0xF, 0xF, false) << 16) | (__builtin_amdgcn_update_dpp(0, qq1_, 0xFF, 0xF, 0xF, false) << 24); \
        _Pragma("unroll") for (int g_ = 0; g_ < 4; ++g_) { const int P_ = bperm(g_ < 2 ? D0_ : D1_, 32 * (g_ & 1) + 4 * j); \
            tdot4(acc, 0, R[4 * g_].x, R[4 * g_ + 1].x, R[4 * g_ + 2].x, R[4 * g_ + 3].x, P_); tdot4(acc, 4, R[4 * g_].y, R[4 * g_ + 1].y, R[4 * g_ + 2].y, R[4 * g_ + 3].y, P_); \
            tdot4(acc, 8, R[4 * g_].z, R[4 * g_ + 1].z, R[4 * g_ + 2].z, R[4 * g_ + 3].z, P_); tdot4(acc, 12, R[4 * g_].w, R[4 * g_ + 1].w, R[4 * g_ + 2].w, R[4 * g_ + 3].w, P_); } \
          \
        int k8_[8]; _Pragma("unroll") for (int i_ = 0; i_ < 8; ++i_) { const int kp_ = j0 ? acc[8 + i_] : acc[i_], sd_ = j0 ? acc[i_] : acc[8 + i_]; k8_[i_] = kp_ + __builtin_amdgcn_update_dpp(0, sd_, 0x128, 0xF, 0xF, false); } \
        int k4_[4]; _Pragma("unroll") for (int i_ = 0; i_ < 4; ++i_) { const int kp_ = j1 ? k8_[4 + i_] : k8_[i_], sd_ = j1 ? k8_[i_] : k8_[4 + i_]; \
            auto sw_ = __builtin_amdgcn_permlane16_swap((unsigned)sd_, (unsigned)sd_, false, false); const unsigned e0_ = sw_[0], e1_ = sw_[1]; k4_[i_] = kp_ + (int)(j1 ? e0_ : e1_); } \
        int k2_[2]; _Pragma("unroll") for (int i_ = 0; i_ < 2; ++i_) { const int kp_ = j2 ? k4_[2 + i_] : k4_[i_], sd_ = j2 ? k4_[i_] : k4_[2 + i_]; \
            auto sw_ = __builtin_amdgcn_permlane32_swap((unsigned)sd_, (unsigned)sd_, false, false); const unsigned e0_ = sw_[0], e1_ = sw_[1]; k2_[i_] = kp_ + (int)(j2 ? e0_ : e1_); } \
        f32x2 hn_; hn_.x = H.x + (float)k2_[0] * wsc_; hn_.y = H.y + (float)k2_[1] * wsc_; \
        const float sq_ = wave_sum_valu(hn_.x * hn_.x + hn_.y * hn_.y); \
        { const size_t off_ = (size_t)(t) * DM + mycol; *(GAS f32x2*)(hout + off_) = hn_; *(GAS unsigned*)(hb + off_) = cvt_pk_bf16(hn_.x, hn_.y); \
          if (lane == 0) *(GAS float*)(ss + (size_t)(t) * 8 + x) = sq_; } } while (0)
#define PV_TC(tt) ((tt) < TT ? (tt) : t0)
    int t = t0;
    PV_IDX(t, a0, a1, aw0, aw1);
    PV_IDX(PV_TC(t + tstep), b0, b1, bw0, bw1);
    PV_ROWS(RA, a0, a1);
    PV_HLD(t);
#pragma nounroll
    for (; t < TT; t += 2 * tstep) {
        const int tB = t + tstep, tA2 = t + 2 * tstep, tB2 = t + 3 * tstep;
        PV_ROWS(RB, b0, b1);
        PV_IDX(PV_TC(tA2), n0, n1, nw0, nw1);
        __builtin_amdgcn_sched_barrier(0);
        PV_TOKEN(RA, aw0, aw1, t);
        __builtin_amdgcn_sched_barrier(0);
        PV_HLD(PV_TC(tB));
        a0 = n0; a1 = n1; aw0 = nw0; aw1 = nw1; PV_ROWS(RA, a0, a1);
        PV_IDX(PV_TC(tB2), n0, n1, nw0, nw1);
        __builtin_amdgcn_sched_barrier(0);
        if (tB < TT) PV_TOKEN(RB, bw0, bw1, tB);
        __builtin_amdgcn_sched_barrier(0);
        PV_HLD(PV_TC(tA2));
        b0 = n0; b1 = n1; bw0 = nw0; bw1 = nw1;
    }
#undef PV_TC
#undef PV_IDX
#undef PV_ROWS
#undef PV_HLD
#undef PV_TOKEN
}
DI void final_norm_row(int row, const float* h, const float* ss, const float* gain, float* out, int lane, float pscale, float poff) {
    const float r = row_rms_scale(ss, row);
#pragma unroll
    for (int q = 0; q < 4; ++q) { f32x4 v = ldg_f4(h + (size_t)row * DM + 4 * lane + 256 * q) * r * ldg_f4(gain + 4 * lane + 256 * q) * pscale;
        if (q == 0 && row == 0 && lane == 0) v[0] += poff; stg_f4(out + (size_t)row * DM + 4 * lane + 256 * q, v); }
}

#define PHASE_BEGIN() \
    int tid = threadIdx.x; asm volatile("" : "+v"(tid)); \
    const int lane = tid & 63; const int wave = __builtin_amdgcn_readfirstlane(tid >> 6); \
    unsigned char* ws = p.ws; asm volatile("" : "+s"(ws)); \
    const int gw = vcu * NWAVES + wave, NGW = G * NWAVES; (void)lane; (void)gw; (void)NGW
__global__ void __launch_bounds__(NTHR, 2) fwd_kernel(Params p) {
    extern __shared__ __attribute__((aligned(16))) unsigned char lds_raw[];
    LAS unsigned char* lds = (LAS unsigned char*)lds_raw;
    const int G = gridDim.x; int bx = blockIdx.x; int vcu = (G % 8 == 0) ? (bx % 8) * (G / 8) + bx / 8 : bx;
    bool xloc = false; unsigned xl_n = 1u, xl_gen = 0u;
    for (int u = threadIdx.x; u < (LDS_BYTES - RING_BYTES) / 4; u += NTHR) ((LAS unsigned*)(lds + RING_BYTES))[u] = 0u;
    __syncthreads();
    XcdBarrier bar; bar.bar = (unsigned*)(p.ws + WS_CTL) + CW_BAR; bar.x = 0; bar.st = nullptr;
    const int lo = p.ph_lo, hi = p.ph_hi;
    if ((hi - lo) > 1) bar = xcd_barrier_post((unsigned*)(p.ws + WS_CTL) + CW_BAR, (volatile LAS unsigned*)(lds + MISC_OFF) + 8);
    int ph = 0;
    if (PROBE_ON && blockIdx.x == 0 && threadIdx.x == 0) ((unsigned long long*)((unsigned*)(p.ws + WS_CTL) + CW_TS))[0] = __builtin_amdgcn_s_memrealtime();
#define IN(k) (lo <= (k) && (k) < hi)
#define SEAM() do { if (IN(ph) && IN(ph + 1)) xcd_barrier(bar); ++ph; \
    if (PROBE_ON && blockIdx.x == 0 && threadIdx.x == 0) ((unsigned long long*)((unsigned*)(p.ws + WS_CTL) + CW_TS))[ph] = __builtin_amdgcn_s_memrealtime(); } while (0)
#define SEAM_X() do { if (IN(ph) && IN(ph + 1)) { if (xloc) xcd_local_barrier(bar, xl_n, ++xl_gen); else xcd_barrier(bar); } ++ph; \
    if (PROBE_ON && blockIdx.x == 0 && threadIdx.x == 0) ((unsigned long long*)((unsigned*)(p.ws + WS_CTL) + CW_TS))[ph] = __builtin_amdgcn_s_memrealtime(); } while (0)

    if (PH_ON(0) && IN(ph)) {
        PHASE_BEGIN();
        LAS float* scr = (LAS float*)(lds + wave * 16384);
        constexpr int I_IN = 16 * 69, I_UQ = 6 * 24, I_UKV = 4 * 32, I_SQ = 16 * 32, I_CIN = 16 * 64, I_PQ = 16 * 64;
        constexpr int PER2 = I_IN + I_UQ + I_UKV + I_SQ + I_CIN + I_SQ;
        constexpr int NITEMS = 2 * PER2 + 4 * I_PQ;
        for (int it = gw; it < NITEMS; it += NGW) {
            if (it < 2 * PER2) { const int i = it / PER2; int r = it % PER2;
                if (r < I_IN) { transpose_item<0>(p.in[5] + (size_t)i * 1024 * NPROJ, 1024, NPROJ, (bf16_t*)(ws + WS_WIN) + (size_t)i * NPROJP * 1024, scr, r, lane, p.in[2] + (2 * i) * DM); continue; } r -= I_IN;
                if (r < I_UQ) { transpose_item<0>(p.in[7] + (size_t)i * 384 * 768, 384, 768, (bf16_t*)(ws + WS_WUQ) + (size_t)i * 768 * 384, scr, r, lane); continue; } r -= I_UQ;
                if (r < I_UKV) { transpose_item<0>(p.in[9] + (size_t)i * 256 * 1024, 256, 1024, (bf16_t*)(ws + WS_WUKV) + (size_t)i * 1024 * 256, scr, r, lane); continue; } r -= I_UKV;
                if (r < I_SQ) { transpose_item<0>(p.in[10] + (size_t)i * 1024 * 1024, 1024, 1024, (bf16_t*)(ws + WS_WOUT) + (size_t)i * 1024 * 1024, scr, r, lane); continue; } r -= I_SQ;
                if (r < I_CIN) { transpose_item<1>(p.in[11] + (size_t)i * 1024 * 2048, 1024, 2048, (bf16_t*)(ws + WS_WCIN) + (size_t)i * 2048 * 1024, scr, r, lane, p.in[2] + (2 * i + 1) * DM); continue; } r -= I_CIN;
                transpose_item<0>(p.in[17] + (size_t)i * 1024 * 1024, 1024, 1024, (bf16_t*)(ws + WS_WCOUT) + (size_t)i * 1024 * 1024, scr, r, lane);
            } else { const int r2 = it - 2 * PER2, l = r2 / I_PQ, r = r2 % I_PQ;
                transpose_item<0>(p.in[19] + (size_t)l * 1024 * 2048, 1024, 2048, (bf16_t*)(ws + WS_WPQ) + (size_t)l * 2048 * 1024, scr, r, lane, p.in[3] + l * DM); }
        }
        { const size_t gt = (size_t)vcu * NTHR + tid, NGT = (size_t)G * NTHR; const size_t n_sub = (size_t)4 * 8 * 2 * 128 * 128 / 8;
          for (size_t i = gt; i < n_sub; i += NGT) { const float* src = p.in[20]; bf16_t* dst = (bf16_t*)(ws + WS_SUBK);
              const f32x4 a = *(const f32x4*)(src + i * 8), b = *(const f32x4*)(src + i * 8 + 4);
              u32x4 o; o.x = cvt_pk_bf16(a[0], a[1]); o.y = cvt_pk_bf16(a[2], a[3]); o.z = cvt_pk_bf16(b[0], b[1]); o.w = cvt_pk_bf16(b[2], b[3]);
              *(u32x4*)(dst + i * 8) = o; } }
        for (int row = 4 * gw; row < 131072; row += 4 * NGW) {
            if (row < 65536) quant_rows<4>(p.in[21] + (size_t)row * 1024, ws + WS_U8 + (size_t)row * 1024, (float*)(ws + WS_SU) + row, 0, lane, false, 0);
            else { const int r2 = row - 65536; quant_rows<4>(p.in[22] + (size_t)r2 * 1024, ws + WS_V8 + (size_t)(r2 >> 14) * 16384 * 1024, (float*)(ws + WS_SV) + r2, 0, lane, true, r2 & 16383); }
        }
        { const int* positions = (const int*)p.in[1];
          float* cosr = (float*)(ws + WS_COSR); float* sinr = (float*)(ws + WS_SINR); float* cosm = (float*)(ws + WS_COSM); float* sinm = (float*)(ws + WS_SINM);
          const int gt = vcu * NTHR + tid, NGT = G * NTHR;
          for (int i = gt; i < TT * 8; i += NGT) { const int row = i & (TT - 1), kg = __builtin_amdgcn_readfirstlane(i >> 14); const double pos = (double)positions[row];
              for (int j = 0; j < 6; ++j) { const int k = kg * 6 + j; const double inv = (k < 16) ? p.inv_r[k & 15] : p.inv_m[(k - 16) & 31];
                  double rev = pos * inv * 0.15915494309189533577; rev -= floor(rev);
                  const float rf = (float)rev; const float c = __builtin_amdgcn_cosf(rf), sn = __builtin_amdgcn_sinf(rf);
                  if (k < 16) { cosr[row * 16 + k] = c; sinr[row * 16 + k] = sn; } else { cosm[row * 32 + (k - 16)] = c; sinm[row * 32 + (k - 16)] = sn; } } } }
        for (int m0 = gw; m0 < TT; m0 += 4 * NGW) { f32x4 v[4][4];
#pragma unroll
            for (int k = 0; k < 4; ++k) { const int m = m0 + k * NGW < TT ? m0 + k * NGW : m0;
#pragma unroll
                for (int j = 0; j < 4; ++j) v[k][j] = ldg_f4(p.in[0] + (size_t)m * DM + 4 * lane + 256 * j); }
#pragma unroll
            for (int k = 0; k < 4; ++k) { const int m = m0 + k * NGW; if (m < TT) { bf16_t* hb = (bf16_t*)(ws + WS_HB) + (size_t)m * DM; float sq = 0.f;
#pragma unroll
                for (int j = 0; j < 4; ++j) { const f32x4 x = v[k][j]; sq += (x.x * x.x + x.y * x.y) + (x.z * x.z + x.w * x.w);
                    u32x2 o; o.x = cvt_pk_bf16(x.x, x.y); o.y = cvt_pk_bf16(x.z, x.w); *(GAS u32x2*)(hb + 4 * lane + 256 * j) = o; }
                sq = wave_sum(sq); if (lane < 8) ((GAS float*)(ws + WS_SS))[(size_t)m * 8 + lane] = (lane == 0) ? sq : 0.f; } } }
    }
    SEAM();
    if ((hi - lo) > 1 && IN(0) && IN(1)) {
        volatile LAS unsigned* st = (volatile LAS unsigned*)(lds + MISC_OFF) + 8;
        const unsigned nl = st[0], rk = st[2], un = st[3];
        if (un != 0u && (G % 8) == 0) { const int xcc = (int)bar.x; bx = (int)rk * 8 + xcc; vcu = xcc * (G / 8) + (int)rk; xloc = true; xl_n = nl; }
        bx = __builtin_amdgcn_readfirstlane(bx); vcu = __builtin_amdgcn_readfirstlane(vcu);
    }

    for (int layer = 0; layer < 4; ++layer) {
        const int li = layer >> 1;
        if ((layer & 1) == 0) {
            if (PH_ON(1) && IN(ph)) { PHASE_BEGIN();
                pg8::Gemm g{(const bf16_t*)(ws + WS_HB), (const bf16_t*)(ws + WS_WIN) + (size_t)li * NPROJP * 1024, TT, NPROJP, 1024}; pg8::StaticOrder S; S.init(TT, NPROJP, G, bx);
                EpiPlain E{(bf16_t*)(ws + WS_PROJ), NPROJP, (const float*)(ws + WS_SS), 8}; pg8::gemm_phase<EpiPlain, pg8::StaticOrder, true, true>(lds, g, S, E); }
            SEAM_X();
            if (PH_ON(2) && IN(ph)) { PHASE_BEGIN();
                for (int u = vcu; u < TT / 64; u += G)
                    token_prep_unit(lds, u, (const bf16_t*)(ws + WS_PROJ), p.in[6] + li * 384, p.in[8] + li * 256, (const float*)(ws + WS_COSR), (const float*)(ws + WS_SINR), (const float*)(ws + WS_COSM), (const float*)(ws + WS_SINM),
                                    (bf16_t*)(ws + WS_CQN), (bf16_t*)(ws + WS_CKVN), (bf16_t*)(ws + WS_KM), (bf16_t*)(ws + WS_MQ), (bf16_t*)(ws + WS_MK), (float*)(ws + WS_KPART), wave, lane); }
            SEAM();
            if (PH_ON(3) && IN(ph)) { PHASE_BEGIN();
#if MOBA_GATHER
                for (int u0 = 8 * vcu; u0 < 2048; u0 += 8 * G)
                    moba_select_wg(lds, u0, (const bf16_t*)(ws + WS_MQ), (const float*)(ws + WS_KPART), (unsigned*)(ws + WS_MSEL), (unsigned*)(ws + WS_MENT), (unsigned*)(ws + WS_CTL) + CW_MCNT + li * 512, tid, wave, lane);
#endif
#if !defined(E3_SKIP_A)
                { pg8::Gemm g{(const bf16_t*)(ws + WS_CQN), (const bf16_t*)(ws + WS_WUQ) + (size_t)li * 768 * 384, TT, 768, 384}; pg8::StaticOrder S; S.init(TT, 768, G, bx);
                  EpiQup E{(bf16_t*)(ws + WS_QM), (const float*)(ws + WS_COSR), (const float*)(ws + WS_SINR), 0.10206207261596577f * LOG2E}; pg8::gemm_phase<EpiQup, pg8::StaticOrder, true, true>(lds, g, S, E); }
#endif
#if !defined(E3_SKIP_B)
                { pg8::Gemm g{(const bf16_t*)(ws + WS_CKVN), (const bf16_t*)(ws + WS_WUKV) + (size_t)li * 1024 * 256, TT, 1024, 256}; pg8::StaticOrder S; S.init(TT, 1024, G, bx);
                  EpiKVup E{(bf16_t*)(ws + WS_KM), (bf16_t*)(ws + WS_VM)}; pg8::gemm_phase<EpiKVup, pg8::StaticOrder, true, true>(lds, g, S, E); }
#endif
            }
            SEAM();
            if (PH_ON(4) && IN(ph)) { PHASE_BEGIN();
                bf16_t* QM = (bf16_t*)(ws + WS_QM); bf16_t* KM = (bf16_t*)(ws + WS_KM); bf16_t* VM = (bf16_t*)(ws + WS_VM); bf16_t* MQ = (bf16_t*)(ws + WS_MQ); bf16_t* MK = (bf16_t*)(ws + WS_MK);
                bf16_t* OB = (bf16_t*)(ws + WS_OB); const bf16_t* PROJ = (const bf16_t*)(ws + WS_PROJ); const float* kpart = (const float*)(ws + WS_KPART);
                for (int v = vcu; v < 256; v += G) { const int bh = v >> 4, s = v & 15, b = bh >> 3, h = bh & 7; const size_t rb = (size_t)b * SEQ;
                    for (int k = 0; k < 2; ++k) { const int qb = k ? 31 - s : s;
#if ATTN_SP
                        attn_unit_sp<96>(lds, QM + rb * 768 + h * 96, 768, KM + rb * 768 + h * 96, 768, VM + rb * 512 + h * 64, 512, OB + rb * 1024 + h * 64, 1024, qb);
#else
                        attn_unit<96, false>(lds, QM + rb * 768 + h * 96, 768, KM + rb * 768 + h * 96, 768, VM + rb * 512 + h * 64, 512, OB + rb * 1024 + h * 64, 1024, qb, nullptr);
#endif
#if MOBA_GATHER
                        moba_part_unit<false>(lds, bh, qb, nullptr, 0, 0, MQ, MK, PROJ, (f32x2*)(ws + WS_PM), (bf16_t*)(ws + WS_PO));
#if DBG_MOBA_CHECK
                        attn_unit<64, true>(lds, MQ + rb * 512 + h * 64, 512, MK + rb * 512 + h * 64, 512, PROJ + rb * NPROJP + 1696 + h * 64, NPROJP, (bf16_t*)(ws + WS_ENT) + rb * 1024 + 512 + h * 64, 1024, qb,
                                            kpart + (size_t)b * 32 * 4 * 512 + h * 64);
#endif
#else
                        attn_unit<64, true>(lds, MQ + rb * 512 + h * 64, 512, MK + rb * 512 + h * 64, 512, PROJ + rb * NPROJP + 1696 + h * 64, NPROJP, OB + rb * 1024 + 512 + h * 64, 1024, qb,
                                            kpart + (size_t)b * 32 * 4 * 512 + h * 64);
#endif
                    } }
#if MOBA_GATHER
                { LAS unsigned* pre = (LAS unsigned*)(lds + 65536);
                  const unsigned* mc = (const unsigned*)(ws + WS_CTL) + CW_MCNT + li * 512;
                  __syncthreads();
                  if (tid < 512) pre[tid + 1] = (__hip_atomic_load(mc + tid, __ATOMIC_RELAXED, __HIP_MEMORY_SCOPE_AGENT) + 255u) >> 8;
                  if (tid == 0) pre[0] = 0u;
                  __syncthreads();
                  if (tid == 0) { unsigned acc = 0u; for (int i = 1; i <= 512; ++i) { acc += pre[i]; pre[i] = acc; } }
                  __syncthreads();
                  const int nunits = (int)pre[512];
                  for (int u = vcu; u < nunits; u += G) { int lo_ = 0, hi_ = 512;
                      while (hi_ - lo_ > 1) { const int mid = (lo_ + hi_) >> 1; if ((int)pre[mid] <= u) lo_ = mid; else hi_ = mid; }
                      const int L = lo_, chunk = u - (int)pre[L]; const int cnt = (int)__hip_atomic_load(mc + L, __ATOMIC_RELAXED, __HIP_MEMORY_SCOPE_AGENT);
                      moba_part_unit<true>(lds, L >> 5, L & 31, (const unsigned*)(ws + WS_MENT) + (size_t)L * 8192, chunk * 256, cnt, MQ, MK, PROJ, (f32x2*)(ws + WS_PM), (bf16_t*)(ws + WS_PO)); } }
#endif
            }
            SEAM();
#if MOBA_GATHER
            if (PH_ON(4) && IN(ph)) { PHASE_BEGIN();
                for (int gi = vcu * NTHR + tid; gi < 16 * SEQ * 8; gi += 4 * G * NTHR) {
                    int g4[4]; bool ok4[4];
#pragma unroll
                    for (int t = 0; t < 4; ++t) { const int g = gi + t * G * NTHR; ok4[t] = g < 16 * SEQ * 8; g4[t] = ok4[t] ? g : gi; }
                    moba_merge<4>(g4, ok4, (const unsigned*)(ws + WS_MSEL), (const f32x2*)(ws + WS_PM), (const bf16_t*)(ws + WS_PO), (bf16_t*)(ws + WS_OB)); }
            }
            SEAM();
#endif
            if (PH_ON(5) && IN(ph)) { PHASE_BEGIN();
#if DBG_NAIVE_CHECK
                for (int smp = gw; smp < 2048; smp += NGW) { const float dm = naive_attn_sample(smp, DBG_NAIVE_CHECK, (const bf16_t*)(ws + WS_QM), (const bf16_t*)(ws + WS_KM), (const bf16_t*)(ws + WS_VM), (const bf16_t*)(ws + WS_MQ),
                        (const bf16_t*)(ws + WS_MK), (const bf16_t*)(ws + WS_PROJ), (const float*)(ws + WS_KPART), (const bf16_t*)(ws + WS_OB), lane);
                    if (lane == 0) atomicMax((unsigned*)(ws + WS_CTL) + CW_DIFF, __float_as_uint(dm)); }
#endif
#if DBG_MOBA_CHECK
                { float dmax = 0.f; const bf16_t* OBc = (const bf16_t*)(ws + WS_OB); const bf16_t* OB2 = (const bf16_t*)(ws + WS_ENT);
                  for (size_t e = (size_t)vcu * NTHR + tid; e < (size_t)TT * 512; e += (size_t)G * NTHR) { const size_t off = (e >> 9) * 1024 + 512 + (e & 511);
                      const float df = fabsf(bf1(OBc[off]) - bf1(OB2[off]) * DBG_CTRL_SCALE); dmax = (df == df) ? fmaxf(dmax, df) : 1e30f; }
                  dmax = wave_max_all(dmax); if (lane == 0) atomicMax((unsigned*)(ws + WS_CTL) + CW_DIFF, __float_as_uint(dmax)); }
#endif
                pg8::Gemm g{(const bf16_t*)(ws + WS_OB), (const bf16_t*)(ws + WS_WOUT) + (size_t)li * 1024 * 1024, TT, 1024, 1024}; pg8::StaticOrder S; S.init(TT, 1024, G, bx);
                EpiResid E{layer == 0 ? p.in[0] : (const float*)(ws + WS_H1), (float*)(ws + WS_H0), nullptr, DBG_SKIP_ATTN, (bf16_t*)(ws + WS_HN), (float*)(ws + WS_SS16)}; pg8::gemm_phase<EpiResid, pg8::StaticOrder, true, true>(lds, g, S, E); }
            SEAM_X();
        } else {
            if (PH_ON(6) && IN(ph)) { PHASE_BEGIN();
                pg8::Gemm g{(const bf16_t*)(ws + WS_HB), (const bf16_t*)(ws + WS_WCIN) + (size_t)li * 2048 * 1024, TT, 2048, 1024}; pg8::StaticOrder S; S.init(TT, 2048, G, bx);
                EpiGlu E{(bf16_t*)(ws + WS_UG), p.in[12] + li * 2048, (const float*)(ws + WS_SS)}; pg8::gemm_phase<EpiGlu, pg8::StaticOrder, true, true>(lds, g, S, E); }
            SEAM();
            if (PH_ON(7) && IN(ph)) { PHASE_BEGIN();
                float w[31][2];
                const float* wd = p.in[13] + (size_t)li * 31 * 1024;
#pragma unroll
                for (int j = 0; j < 31; ++j) { const f32x2 t2 = *(const f32x2*)(wd + j * 1024 + 2 * tid); w[j][0] = t2.x; w[j][1] = t2.y; }
                const f32x2 bb = *(const f32x2*)(p.in[14] + li * 1024 + 2 * tid), gg = *(const f32x2*)(p.in[15] + li * 1024 + 2 * tid), be = *(const f32x2*)(p.in[16] + li * 1024 + 2 * tid);
                { const int nu = (TT / 16 + G - 1) / G;
                  for (int u = vcu * nu; u < (vcu + 1) * nu && u < TT / 16; ++u) dwconv_unit(lds, u, (const bf16_t*)(ws + WS_UG), w, bb.x, bb.y, gg.x, gg.y, be.x, be.y, (bf16_t*)(ws + WS_YB), tid); }
            }
            SEAM_X();
            if (PH_ON(8) && IN(ph)) { PHASE_BEGIN();
                pg8::Gemm g{(const bf16_t*)(ws + WS_YB), (const bf16_t*)(ws + WS_WCOUT) + (size_t)li * 1024 * 1024, TT, 1024, 1024}; pg8::StaticOrder S; S.init(TT, 1024, G, bx);
                EpiResid E{(const float*)(ws + WS_H1), (float*)(ws + WS_H0), p.in[18] + li * 1024, DBG_SKIP_CONV, (bf16_t*)(ws + WS_HN), (float*)(ws + WS_SS16)}; pg8::gemm_phase<EpiResid, pg8::StaticOrder, true, true>(lds, g, S, E); }
            SEAM_X();
        }
        if (PH_ON(10) && IN(ph)) { PHASE_BEGIN();
            pg8::Gemm g{(const bf16_t*)(ws + WS_HN), (const bf16_t*)(ws + WS_WPQ) + (size_t)layer * 2048 * 1024, TT, 2048, 1024}; pg8::StaticOrder S; S.init(TT, 2048, G, bx);
            EpiPlain E{(bf16_t*)(ws + WS_Q2), 2048, (const float*)(ws + WS_SS16), 16}; pg8::gemm_phase<EpiPlain, pg8::StaticOrder, true, true>(lds, g, S, E); }
        SEAM_X();
        if (PH_ON(11) && IN(ph)) { PHASE_BEGIN();
            const bf16_t* subk = (const bf16_t*)(ws + WS_SUBK) + (size_t)layer * 8 * 2 * 128 * 128;
            LAS unsigned* dec = (LAS unsigned*)(lds + 65536 + wave * 2048);
            for (int v = vcu; v < 256; v += G) { const int h = v & 7, tg = v >> 3;
                for (int e = tid; e < 2 * 128 * 16; e += NTHR) { const int c = e >> 11, key = (e >> 4) & 127, ch = e & 15;
                    *(LAS u32x4*)(lds + c * 32768 + ch * 2048 + key * 16) = *(const u32x4*)(subk + ((size_t)(h * 2 + c) * 128 + key) * 128 + ch * 8); }
                __syncthreads();
                for (int i = 0; i < 2; ++i) peer_topk_unit(lds, dec, (const bf16_t*)(ws + WS_Q2), tg * 16 + wave * 2 + i, h, (int*)(ws + WS_IDX), (float*)(ws + WS_GATE), lane);
                __syncthreads();
            }
        }
        SEAM_X();
        if (PH_ON(13) && IN(ph)) { PHASE_BEGIN();
            for (int tok = 8 * gw; tok < TT; tok += 8 * NGW) peer_build_lists(tok, (const int*)(ws + WS_IDX), (unsigned*)(ws + WS_ENT), (unsigned*)(ws + WS_CTL) + CW_CNT + layer * 8 * 64, (volatile LAS unsigned*)lds, wave, lane, (const float*)(ws + WS_H0), p.in[3] + layer * DM, ws + WS_XQ, (float*)(ws + WS_SX)); }
        SEAM();
        if (PH_ON(14) && IN(ph)) { PHASE_BEGIN();
            const int x = bx & 7, rank = bx >> 3, nrank = (G - x + 7) >> 3;
            const int n = (int)__hip_atomic_load((unsigned*)(ws + WS_CTL) + CW_CNT + (layer * 8 + x) * 64, __ATOMIC_RELAXED, __HIP_MEMORY_SCOPE_AGENT);
            const int nws = nrank * NWAVES, wsl = rank * NWAVES + wave;
            const int per = (((n + nws - 1) / nws) + 63) & ~63;
            const int e_lo = wsl * per, e_hi = (e_lo + per < n) ? e_lo + per : n;
            for (int rep = 0; rep < REP_U; ++rep) if (e_lo < n) peer_u_slice((const unsigned*)(ws + WS_ENT) + (size_t)x * ENT_CAP, e_lo, e_hi, ws + WS_U8 + ((size_t)layer * 16384 + (size_t)x * 2048) * 1024,
                                       (const float*)(ws + WS_SU) + layer * 16384 + x * 2048, (const float*)(ws + WS_SV) + layer * 16384 + x * 2048, (const float*)(ws + WS_GATE), ws + WS_XQ, (const float*)(ws + WS_SX), (float*)(ws + WS_ACT), lane);
        }
        SEAM();
        if (PH_ON(12) && IN(ph)) { PHASE_BEGIN();
            const int x = bx & 7, rank = bx >> 3, nrank = (G - x + 7) >> 3;
            for (int rep = 0; rep < REP_V; ++rep) peer_v_cols(x, rank * NWAVES + wave, nrank * NWAVES, (const int*)(ws + WS_IDX), (const float*)(ws + WS_ACT), ws + WS_V8 + ((size_t)layer * 8 + x) * 16384 * 128,
                        (const float*)(ws + WS_H0), (float*)(ws + WS_H1), (bf16_t*)(ws + WS_HB), (float*)(ws + WS_SS), lane);
        }
        SEAM();
    }
    if (PH_ON(15) && IN(ph)) { PHASE_BEGIN();
        float pscale = 1.f, poff = 0.f;
        if (PROBE_ON) { const unsigned long long* ts = (const unsigned long long*)((const unsigned*)(ws + WS_CTL) + CW_TS); unsigned long long ta = 0ull, tb = 0ull;
            for (int k = 0; k < 38; ++k) { const unsigned long long d = ts[k + 1] - ts[k]; if ((PROBE_SELA >> k) & 1ull) ta += d; if ((PROBE_SELB >> k) & 1ull) tb += d; }
            pscale = 1.f + sqrtf((float)ta * 1e-8f);
            poff = (float)tb * 1e-4f; }
        if (DBG_MOBA_CHECK || DBG_NAIVE_CHECK) poff = 1000.f * __uint_as_float(__hip_atomic_load((unsigned*)(ws + WS_CTL) + CW_DIFF, __ATOMIC_RELAXED, __HIP_MEMORY_SCOPE_AGENT));
        { const float* hh = (const float*)(ws + WS_H1); const float* ssp = (const float*)(ws + WS_SS); f32x4 gn[4];
#pragma unroll
          for (int q = 0; q < 4; ++q) gn[q] = ldg_f4(p.in[4] + 4 * lane + 256 * q);
          for (int m0 = gw; m0 < TT; m0 += 4 * NGW) { f32x4 v[4][4], sa[4], sb[4];
#pragma unroll
              for (int k = 0; k < 4; ++k) { const int m = m0 + k * NGW < TT ? m0 + k * NGW : m0; sa[k] = ldg_f4(ssp + (size_t)m * 8); sb[k] = ldg_f4(ssp + (size_t)m * 8 + 4);
#pragma unroll
                  for (int q = 0; q < 4; ++q) v[k][q] = ldg_f4(hh + (size_t)m * DM + 4 * lane + 256 * q); }
#pragma unroll
              for (int k = 0; k < 4; ++k) { const int m = m0 + k * NGW; if (m < TT) {
                  const float r = rsqrtf(((sa[k][0] + sa[k][1]) + (sa[k][2] + sa[k][3]) + (sb[k][0] + sb[k][1]) + (sb[k][2] + sb[k][3])) * (1.f / DM) + NORM_EPS);
#pragma unroll
                  for (int q = 0; q < 4; ++q) { f32x4 o = v[k][q] * r * gn[q] * pscale; if (q == 0 && m == 0 && lane == 0) o[0] += poff; stg_f4(p.out + (size_t)m * DM + 4 * lane + 256 * q, o); } } } } }
    }
    SEAM();
#undef IN
#undef SEAM
}

extern "C" void kernel_launch(void* const* d_in, const int* in_sizes, int n_in, void* d_out, int out_size, void* d_ws, size_t ws_size, hipStream_t stream) {
    static int grid = 0;
    if (grid == 0) {
        if (n_in != 23 || out_size != TT * DM || ws_size < WS_END) { fprintf(stderr, "kernel_launch: unexpected shapes (n_in %d out %d ws %zu)\n", n_in, out_size, ws_size); grid = -1; return; }
        int dev = 0, cus = 0, per_cu = 0;
        if (hipGetDevice(&dev) != hipSuccess || hipDeviceGetAttribute(&cus, hipDeviceAttributeMultiprocessorCount, dev) != hipSuccess) { grid = -1; return; }
        if (hipFuncSetAttribute((const void*)fwd_kernel, hipFuncAttributeMaxDynamicSharedMemorySize, LDS_BYTES) != hipSuccess) { fprintf(stderr, "kernel_launch: hipFuncSetAttribute failed\n"); grid = -1; return; }
        if (hipOccupancyMaxActiveBlocksPerMultiprocessor(&per_cu, (const void*)fwd_kernel, NTHR, LDS_BYTES) != hipSuccess || per_cu < 1) fprintf(stderr, "kernel_launch: occupancy query says %d\n", per_cu);
        (void)hipGetLastError();
        grid = cus;
    }
    if (grid < 0) return;
    (void)hipMemsetAsync((char*)d_ws + WS_CTL, 0, CTL_ZERO_BYTES, stream);
    Params p;
    memset(&p, 0, sizeof(p));
    for (int i = 0; i < 23; ++i) p.in[i] = (const float*)d_in[i];
    p.out = (float*)d_out; p.ws = (unsigned char*)d_ws;
    for (int k = 0; k < 16; ++k) p.inv_r[k] = pow(10000.0, -(double)(2 * k) / 32.0);
    for (int k = 0; k < 32; ++k) p.inv_m[k] = pow(10000.0, -(double)(2 * k) / 64.0);
#if MK_ONE_LAUNCH
    p.ph_lo = 0; p.ph_hi = 1000;
    hipLaunchKernelGGL(fwd_kernel, dim3(grid), dim3(NTHR), LDS_BYTES, stream, p);
#else
    for (int k = 0; k < 40; ++k) { p.ph_lo = k; p.ph_hi = k + 1; hipLaunchKernelGGL(fwd_kernel, dim3(grid), dim3(NTHR), LDS_BYTES, stream, p); }
#endif
}
```

```cpp
#include <hip/hip_runtime.h>
#include <cstdio>
#include <cstdint>
#include <cstring>
#include <cmath>

#ifndef ATTN_SP
#define ATTN_SP 1
#endif
#ifndef REP_EPI
#define REP_EPI 0
#endif
#ifndef PHMASK
#define PHMASK 0xFFFF
#endif
#define PH_ON(n) ((PHMASK >> (n)) & 1)
#ifndef DBG_SKIP_ATTN
#define DBG_SKIP_ATTN 0
#endif
#ifndef DBG_SKIP_CONV
#define DBG_SKIP_CONV 0
#endif
#ifndef DBG_SKIP_PEER
#define DBG_SKIP_PEER 0
#endif
#ifndef PROBE_SELA
#define PROBE_SELA 0ull
#endif
#ifndef PROBE_SELB
#define PROBE_SELB 0ull
#endif
#define PROBE_ON ((PROBE_SELA | PROBE_SELB) != 0ull)
constexpr int CW_TS = 16384;
#ifndef PGR
#define PGR 4
#endif
#ifndef DBG_PEER_NOISE
#define DBG_PEER_NOISE 0.0f
#endif
#ifndef DBG_MOBA_NOISE
#define DBG_MOBA_NOISE 0.0f
#endif
#ifndef REP_V
#define REP_V 1
#endif
#ifndef REP_U
#define REP_U 1
#endif
#ifndef DBG_VREP
#define DBG_VREP 0
#endif
#ifndef DBG_VREP_MASK
#define DBG_VREP_MASK 1023
#endif
#ifndef MOBA_GATHER
#define MOBA_GATHER 1
#endif
#ifndef DBG_MOBA_CHECK
#define DBG_MOBA_CHECK 0
#endif
#ifndef DBG_NAIVE_CHECK
#define DBG_NAIVE_CHECK 0
#endif
#ifndef DBG_CTRL_SCALE
#define DBG_CTRL_SCALE 1.0f
#endif
constexpr int CW_DIFF = 20480;
#ifndef MK_ONE_LAUNCH
#define MK_ONE_LAUNCH 1
#endif

#define LAS __attribute__((address_space(3)))
#define GAS __attribute__((address_space(1)))
typedef unsigned short bf16_t;
typedef short bf16x8 __attribute__((ext_vector_type(8)));
typedef short s16x4 __attribute__((ext_vector_type(4)));
typedef short v4i16_t __attribute__((ext_vector_type(4)));
typedef float f32x2 __attribute__((ext_vector_type(2)));
typedef float f32x4 __attribute__((ext_vector_type(4)));
typedef float f32x16 __attribute__((ext_vector_type(16)));
typedef unsigned u32x2 __attribute__((ext_vector_type(2)));
typedef unsigned u32x4 __attribute__((ext_vector_type(4)));
#define DI __device__ __forceinline__

constexpr int TT = 16384, SEQ = 8192, DM = 1024;
constexpr int NPROJ = 2208, NPROJP = 2304;
constexpr float NORM_EPS = 1e-6f;
constexpr float LOG2E = 1.4426950408889634f;
constexpr int NWAVES = 8, NTHR = 512;

constexpr size_t MiB = 1u << 20;
constexpr size_t WS_CTL = 0, CTL_ZERO_BYTES = 1 * MiB;
constexpr size_t WS_COSR = 2 * MiB, WS_SINR = 3 * MiB, WS_COSM = 4 * MiB, WS_SINM = 6 * MiB;
constexpr size_t WS_KPART = 8 * MiB;
constexpr size_t WS_WIN = 10 * MiB;
constexpr size_t WS_WUQ = 19 * MiB;
constexpr size_t WS_WUKV = 21 * MiB;
constexpr size_t WS_WOUT = 22 * MiB;
constexpr size_t WS_WCIN = 26 * MiB;
constexpr size_t WS_WCOUT = 34 * MiB;
constexpr size_t WS_WPQ = 38 * MiB;
constexpr size_t WS_SUBK = 54 * MiB;
constexpr size_t WS_SU = 56 * MiB;
constexpr size_t WS_SV = 57 * MiB;
constexpr size_t WS_U8 = 64 * MiB;
constexpr size_t WS_V8 = 128 * MiB;
constexpr size_t WS_H0 = 320 * MiB;
constexpr size_t WS_H1 = 384 * MiB;
constexpr size_t WS_HN = 448 * MiB;
constexpr size_t WS_PROJ = 480 * MiB;
constexpr size_t WS_CQN = 552 * MiB;
constexpr size_t WS_CKVN = 564 * MiB;
constexpr size_t WS_QM = 572 * MiB;
constexpr size_t WS_KM = 596 * MiB;
constexpr size_t WS_VM = 620 * MiB;
constexpr size_t WS_MQ = 636 * MiB;
constexpr size_t WS_MK = 652 * MiB;
constexpr size_t WS_OB = 668 * MiB;
constexpr size_t WS_Q2 = 700 * MiB;
constexpr size_t WS_IDX = 764 * MiB;
constexpr size_t WS_GATE = 772 * MiB;
constexpr size_t WS_UG = 780 * MiB;
constexpr size_t WS_YB = 812 * MiB;
constexpr size_t WS_XQ = 844 * MiB;
constexpr size_t WS_SX = 860 * MiB;
constexpr size_t WS_ACT = 861 * MiB;
constexpr size_t WS_ENT = 872 * MiB;
constexpr size_t WS_HB = 936 * MiB;
constexpr size_t WS_SS = 968 * MiB;
constexpr size_t WS_SS16 = 969 * MiB;
constexpr size_t WS_MENT = WS_Q2;
constexpr size_t WS_PM = WS_Q2 + 16 * MiB;
constexpr size_t WS_MSEL = WS_Q2 + 20 * MiB;
constexpr size_t WS_PO = WS_UG;
constexpr size_t WS_END = 970 * MiB;
constexpr int CW_MCNT = 32768;
constexpr int ENT_CAP = 1 << 21;
constexpr int CW_CNT = 24576;
constexpr int CW_BAR = 4096;

constexpr int RING_BYTES = 131072;
constexpr int MISC_OFF = RING_BYTES + 320;
constexpr int LDS_BYTES = 147456;

typedef __bf16 bf16n2 __attribute__((ext_vector_type(2)));
typedef float f32n2 __attribute__((ext_vector_type(2)));
DI unsigned cvt_pk_bf16_b(float lo, float hi) { const f32n2 v = {lo, hi}; return __builtin_bit_cast(unsigned, __builtin_convertvector(v, bf16n2)); }
DI unsigned cvt_pk_bf16(float lo, float hi) { unsigned r; asm volatile("v_cvt_pk_bf16_f32 %0, %1, %2" : "=v"(r) : "v"(lo), "v"(hi)); return r; }
DI float bf_lo(unsigned u) { return __builtin_bit_cast(float, u << 16); }
DI float bf_hi(unsigned u) { return __builtin_bit_cast(float, u & 0xffff0000u); }
DI float bf1(bf16_t b) { return __builtin_bit_cast(float, ((unsigned)b) << 16); }
#define DPP_F(v, ctrl) __builtin_bit_cast(float, __builtin_amdgcn_update_dpp(0, __builtin_bit_cast(int, (v)), (ctrl), 0xF, 0xF, false))
DI float wave_sum(float v) {
    v += DPP_F(v, 0xB1); v += DPP_F(v, 0x4E); v += DPP_F(v, 0x141); v += DPP_F(v, 0x140);
    auto a = __builtin_amdgcn_permlane16_swap(__float_as_uint(v), __float_as_uint(v), false, false); const unsigned a0 = a[0], a1 = a[1];
    v = __uint_as_float(a0) + __uint_as_float(a1);
    auto b = __builtin_amdgcn_permlane32_swap(__float_as_uint(v), __float_as_uint(v), false, false); const unsigned b0 = b[0], b1 = b[1];
    return __uint_as_float(b0) + __uint_as_float(b1);
}
DI int bperm(int v, int src) { return __builtin_amdgcn_ds_bpermute(src << 2, v); }
DI float xchg32(float v, bool lo_half) {
    auto a = __builtin_amdgcn_permlane32_swap(__float_as_uint(v), __float_as_uint(v), false, false); const unsigned a0 = a[0], a1 = a[1];
    return __uint_as_float(lo_half ? a1 : a0);
}
DI float xsum_16_32(float v) {
    auto a = __builtin_amdgcn_permlane16_swap(__float_as_uint(v), __float_as_uint(v), false, false); const unsigned a0 = a[0], a1 = a[1];
    v = __uint_as_float(a0) + __uint_as_float(a1);
    auto b = __builtin_amdgcn_permlane32_swap(__float_as_uint(v), __float_as_uint(v), false, false); const unsigned b0 = b[0], b1 = b[1];
    return __uint_as_float(b0) + __uint_as_float(b1);
}
#define LDS_WAIT() asm volatile("s_waitcnt lgkmcnt(0)" ::: "memory")
DI unsigned pack4_i8(float a, float b, float c, float d, float inv, int off) {
    const int qa = __float2int_rn(a * inv) + off, qb = __float2int_rn(b * inv) + off, qc = __float2int_rn(c * inv) + off, qd = __float2int_rn(d * inv) + off;
    return (unsigned)(qa & 255) | ((unsigned)(qb & 255) << 8) | ((unsigned)(qc & 255) << 16) | ((unsigned)(qd & 255) << 24);
}
DI float wave_max_all(float v) {
    v = fmaxf(v, DPP_F(v, 0xB1)); v = fmaxf(v, DPP_F(v, 0x4E)); v = fmaxf(v, DPP_F(v, 0x141)); v = fmaxf(v, DPP_F(v, 0x140));
    auto a = __builtin_amdgcn_permlane16_swap(__float_as_uint(v), __float_as_uint(v), false, false); const unsigned a0 = a[0], a1 = a[1];
    v = fmaxf(__uint_as_float(a0), __uint_as_float(a1));
    auto b = __builtin_amdgcn_permlane32_swap(__float_as_uint(v), __float_as_uint(v), false, false); const unsigned b0 = b[0], b1 = b[1];
    return fmaxf(__uint_as_float(b0), __uint_as_float(b1));
}
DI float hash_noise(unsigned a) { a ^= a >> 16; a *= 0x7feb352du; a ^= a >> 15; a *= 0x846ca68bu; a ^= a >> 16; return (float)(a >> 8) * (1.f / 8388608.f) - 1.f; }
DI u32x4 ldg_u4(const void* p) { return *(const GAS u32x4*)p; }
DI f32x4 ldg_f4(const void* p) { return *(const GAS f32x4*)p; }
DI f32x2 ldg_f2(const void* p) { return *(const GAS f32x2*)p; }
DI float ldg_f(const void* p) { return *(const GAS float*)p; }
DI int ldg_i(const void* p) { return *(const GAS int*)p; }
DI void stg_u4(void* p, u32x4 v) { *(GAS u32x4*)p = v; }
DI void stg_f4(void* p, f32x4 v) { *(GAS f32x4*)p = v; }
DI __amdgpu_buffer_rsrc_t mk_rsrc(const void* p) {
    const unsigned long long a = (unsigned long long)p; const unsigned lo = __builtin_amdgcn_readfirstlane((unsigned)a), hi = __builtin_amdgcn_readfirstlane((unsigned)(a >> 32));
    return __builtin_amdgcn_make_buffer_rsrc((void*)(((unsigned long long)hi << 32) | lo), 0, 0x7fffffff, 0x00020000);
}
DI u32x4 ldb_u4(__amdgpu_buffer_rsrc_t rs, int off) { return __builtin_bit_cast(u32x4, __builtin_amdgcn_raw_buffer_load_b128(rs, off, 0, 0)); }
DI u32x4 ldb_u4s(__amdgpu_buffer_rsrc_t rs, int voff, int soff) { return __builtin_bit_cast(u32x4, __builtin_amdgcn_raw_buffer_load_b128(rs, voff, soff, 0)); }

namespace pg8 {
constexpr int BM = 256, BK = 64, HALF = 128, HTB = HALF * BK * 2, STAGE_BYTES = 8 * HTB, NXCD = 8, WGM = 8;
__host__ __device__ __forceinline__ int lds_byte(int r, int c) { const int st = (r >> 4) * 2 + (c >> 5), rr = r & 15, cc = c & 31, ob = rr * 64 + cc * 2; return st * 1024 + (ob ^ (((ob >> 9) & 1) << 5)); }
__host__ __device__ __forceinline__ void stage_rc(int b, int& R, int& C) { const int st = b / 1024, sb = b % 1024, swz = sb ^ (((sb >> 9) & 1) << 5); R = (st >> 1) * 16 + swz / 64; C = (st & 1) * 32 + (swz % 64) / 2; }
__host__ __device__ __forceinline__ int perm32(int rho) { const int n = rho >> 4, i = rho & 15; return 8 * (i >> 2) + 4 * n + (i & 3); }
struct Unit { int pm, pn; };
struct Gemm { const bf16_t* A; const bf16_t* Bt; int M, N, K; };
struct StaticOrder {
    int nM, nN, nwg, G, c;
    __host__ __device__ void init(int M, int N, int G_, int c_) { nM = M / BM; nN = N / BM; nwg = nM * nN; G = G_; c = c_; }
    __host__ __device__ bool next(int i, Unit& u) const {
        const long L = (long)i * G + c; if (L >= nwg) return false;
        int wgid = (int)L; { const int q = nwg / NXCD, r = nwg % NXCD, xcd = wgid % NXCD, off = wgid / NXCD; wgid = (xcd < r ? xcd * (q + 1) : r * (q + 1) + (xcd - r) * q) + off; }
        const int nig = WGM * nN, gid = wgid / nig, fm = gid * WGM, gsz = (nM - fm) < WGM ? (nM - fm) : WGM;
        u.pm = fm + ((wgid % nig) % gsz); u.pn = (wgid % nig) / gsz; return true;
    }
    __device__ __forceinline__ void a_ready(const Unit&) const {}
    __device__ __forceinline__ void done(const Unit&) const {}
};
template <class Epi, class Sched, bool ALIGN_EPI = false, bool SP2 = false>
__device__ __forceinline__ void gemm_phase(LAS unsigned char* lds, const Gemm g, const Sched& S, const Epi& E) {
    int tid_o = threadIdx.x; asm volatile("" : "+v"(tid_o));
    const int tid = tid_o, wid = __builtin_amdgcn_readfirstlane(tid >> 6), lane = tid & 63, wr = wid >> 2, wc = wid & 3, fr = lane & 15, fq = lane >> 4;
    const int K = g.K, nt = K / BK;
    unsigned voffA[2], voffB[2];
#pragma unroll
    for (int i = 0; i < 2; ++i) { int R, C; stage_rc(tid * 16 + i * 8192, R, C); const int Rb = Epi::PERM ? ((R & ~31) + perm32(R & 31)) : R;
        voffA[i] = (unsigned)(R * K + C) * 2u; voffB[i] = (unsigned)(Rb * K + C) * 2u; }
    const size_t kstep = (size_t)(BK * 2);
    const size_t hstep = (size_t)HALF * K * 2;
    const size_t tstep = 2 * hstep;
    const unsigned ldsw = (unsigned)wid * 1024u;
    const int aoff = lds_byte(wr * 64 + fr, fq * 8), boff = lds_byte(wc * 32 + fr, fq * 8);
#define PG8_SA(b, h) (((b) * 2 + (h)) * HTB)
#define PG8_SB(b, h) ((4 + (b) * 2 + (h)) * HTB)
#define PG8_STAGE(bufoff, gbase, voff) do { _Pragma("unroll") for (int _i = 0; _i < 2; ++_i) \
        __builtin_amdgcn_global_load_lds((const unsigned*)((const char*)(gbase) + (voff)[_i]), (LAS unsigned*)(lds + (bufoff) + ldsw + _i * 8192), 16, 0, 0); } while (0)
#define PG8_LDA(dst, b, h) do { _Pragma("unroll") for (int m = 0; m < 4; ++m) _Pragma("unroll") for (int k = 0; k < 2; ++k) dst[m][k] = *(const LAS bf16x8*)(lds + PG8_SA(b, h) + aoff + m * 2048 + k * 1024); } while (0)
#define PG8_LDB(dst, b, h) do { _Pragma("unroll") for (int n = 0; n < 2; ++n) _Pragma("unroll") for (int k = 0; k < 2; ++k) dst[n][k] = *(const LAS bf16x8*)(lds + PG8_SB(b, h) + boff + n * 2048 + k * 1024); } while (0)
#define PG8_MMA(ai, bj, At, Bt) do { __builtin_amdgcn_s_setprio(1); _Pragma("unroll") for (int m = 0; m < 4; ++m) _Pragma("unroll") for (int n = 0; n < 2; ++n) _Pragma("unroll") for (int k = 0; k < 2; ++k) \
        acc[ai][bj][m][n] = __builtin_amdgcn_mfma_f32_16x16x32_bf16(Bt[n][k], At[m][k], acc[ai][bj][m][n], 0, 0, 0); __builtin_amdgcn_s_setprio(0); } while (0)
#define PG8_WAIT_V(n) asm volatile("s_waitcnt vmcnt(" #n ")" ::: "memory")
#define PG8_WAIT_L(n) asm volatile("s_waitcnt lgkmcnt(" #n ")" ::: "memory")
#define PG8_BAR __builtin_amdgcn_s_barrier()
#define PG8_SCHED __builtin_amdgcn_sched_barrier(0)
    Unit cur, nxt; int ui = 0;
    if (!S.next(0, cur)) return;
    f32x4 acc[2][2][4][2];
#pragma unroll
    for (int a = 0; a < 2; ++a)
#pragma unroll
        for (int b = 0; b < 2; ++b)
#pragma unroll
            for (int m = 0; m < 4; ++m)
#pragma unroll
                for (int n = 0; n < 2; ++n) acc[a][b][m][n] = (f32x4){0.f, 0.f, 0.f, 0.f};
    bf16x8 At[4][2], B0[2][2], B1[2][2];
    const char* cA = (const char*)g.A + (size_t)cur.pm * tstep; const char* cB = (const char*)g.Bt + (size_t)cur.pn * tstep;
    S.a_ready(cur);
    if constexpr (SP2) {
        PG8_STAGE(PG8_SB(0, 0), cB, voffB); PG8_STAGE(PG8_SB(0, 1), cB + hstep, voffB); PG8_STAGE(PG8_SA(0, 0), cA, voffA); PG8_STAGE(PG8_SA(0, 1), cA + hstep, voffA);
        if (wr == 1) PG8_BAR;
        PG8_WAIT_V(2); PG8_BAR;
        PG8_STAGE(PG8_SB(1, 0), cB + kstep, voffB); PG8_STAGE(PG8_SA(1, 0), cA + kstep, voffA); PG8_STAGE(PG8_SB(1, 1), cB + hstep + kstep, voffB);
        PG8_WAIT_V(6); PG8_BAR;
    } else {
        PG8_STAGE(PG8_SB(0, 0), cB, voffB); PG8_STAGE(PG8_SA(0, 0), cA, voffA); PG8_STAGE(PG8_SB(0, 1), cB + hstep, voffB); PG8_STAGE(PG8_SA(0, 1), cA + hstep, voffA);
        if (wr == 1) PG8_BAR;
        PG8_WAIT_V(4); PG8_BAR;
        PG8_STAGE(PG8_SB(1, 0), cB + kstep, voffB); PG8_STAGE(PG8_SA(1, 0), cA + kstep, voffA); PG8_STAGE(PG8_SB(1, 1), cB + hstep + kstep, voffB);
        PG8_WAIT_V(6); PG8_BAR;
    }
    for (;;) {
        const bool has_next = S.next(ui + 1, nxt);
        const char* nA = has_next ? (const char*)g.A + (size_t)nxt.pm * tstep : cA; const char* nB = has_next ? (const char*)g.Bt + (size_t)nxt.pn * tstep : cB;
#pragma nounroll
        for (int t = 0; t < nt; t += 2) {
            const bool last = (t == nt - 2);
            const char* a1 = cA + (size_t)(t + 1) * kstep;
            const char* a2 = last ? nA : cA + (size_t)(t + 2) * kstep; const char* b2 = last ? nB : cB + (size_t)(t + 2) * kstep;
            const char* a3 = a2 + kstep; const char* b3 = b2 + kstep;
            if (last && has_next) S.a_ready(nxt);
            if constexpr (SP2) {
            PG8_LDB(B0, 0, 0); PG8_LDB(B1, 0, 1); PG8_SCHED; PG8_LDA(At, 0, 0); PG8_STAGE(PG8_SA(1, 1), a1 + hstep, voffA);
            PG8_WAIT_V(8); PG8_WAIT_L(0); PG8_BAR; PG8_MMA(0, 0, At, B0); PG8_MMA(0, 1, At, B1); PG8_BAR; PG8_SCHED;
            PG8_LDA(At, 0, 1); PG8_STAGE(PG8_SB(0, 0), b2, voffB); PG8_STAGE(PG8_SB(0, 1), b2 + hstep, voffB); PG8_STAGE(PG8_SA(0, 0), a2, voffA);
            PG8_WAIT_V(8); PG8_WAIT_L(0); PG8_BAR; PG8_MMA(1, 0, At, B0); PG8_MMA(1, 1, At, B1); PG8_BAR; PG8_SCHED;
            PG8_LDB(B0, 1, 0); PG8_LDB(B1, 1, 1); PG8_SCHED; PG8_LDA(At, 1, 0); PG8_STAGE(PG8_SA(0, 1), a2 + hstep, voffA);
            PG8_WAIT_V(8); PG8_WAIT_L(0); PG8_BAR; PG8_MMA(0, 0, At, B0); PG8_MMA(0, 1, At, B1); PG8_BAR; PG8_SCHED;
            PG8_LDA(At, 1, 1); PG8_STAGE(PG8_SB(1, 0), b3, voffB); PG8_STAGE(PG8_SB(1, 1), b3 + hstep, voffB); PG8_STAGE(PG8_SA(1, 0), a3, voffA);
            PG8_WAIT_V(8); PG8_WAIT_L(0); PG8_BAR; PG8_MMA(1, 0, At, B0); PG8_MMA(1, 1, At, B1); PG8_BAR; PG8_SCHED;
            } else {
            PG8_LDB(B0, 0, 0); PG8_SCHED; PG8_LDA(At, 0, 0); PG8_STAGE(PG8_SA(1, 1), a1 + hstep, voffA);
            PG8_WAIT_L(8); PG8_BAR; PG8_WAIT_L(0); PG8_MMA(0, 0, At, B0); PG8_BAR; PG8_SCHED;
            PG8_LDB(B1, 0, 1); PG8_STAGE(PG8_SB(0, 0), b2, voffB);
            PG8_BAR; PG8_WAIT_L(0); PG8_MMA(0, 1, At, B1); PG8_BAR;
            PG8_LDA(At, 0, 1); PG8_STAGE(PG8_SA(0, 0), a2, voffA);
            PG8_BAR; PG8_WAIT_L(0); PG8_MMA(1, 0, At, B0); PG8_BAR; PG8_SCHED;
            PG8_STAGE(PG8_SB(0, 1), b2 + hstep, voffB);
            PG8_WAIT_V(6); PG8_BAR; PG8_MMA(1, 1, At, B1); PG8_BAR;
            PG8_LDB(B0, 1, 0); PG8_SCHED; PG8_LDA(At, 1, 0); PG8_STAGE(PG8_SA(0, 1), a2 + hstep, voffA);
            PG8_WAIT_L(8); PG8_BAR; PG8_WAIT_L(0); PG8_MMA(0, 0, At, B0); PG8_BAR; PG8_SCHED;
            PG8_LDB(B1, 1, 1); PG8_STAGE(PG8_SB(1, 0), b3, voffB);
            PG8_BAR; PG8_WAIT_L(0); PG8_MMA(0, 1, At, B1); PG8_BAR;
            PG8_LDA(At, 1, 1); PG8_STAGE(PG8_SA(1, 0), a3, voffA);
            PG8_BAR; PG8_WAIT_L(0); PG8_MMA(1, 0, At, B0); PG8_BAR; PG8_SCHED;
            PG8_STAGE(PG8_SB(1, 1), b3 + hstep, voffB);
            PG8_WAIT_V(6); PG8_BAR; PG8_MMA(1, 1, At, B1); PG8_BAR;
            }
        }
        if constexpr (ALIGN_EPI) { if (wr == 0) PG8_BAR; }
        E(acc, cur, wr, wc, fr, fq);
#if REP_EPI
        asm volatile("" ::: "memory"); E(acc, cur, wr, wc, fr, fq);
#endif
        S.done(cur);
        if (!has_next) break;
#pragma unroll
        for (int a = 0; a < 2; ++a)
#pragma unroll
            for (int b = 0; b < 2; ++b)
#pragma unroll
                for (int m = 0; m < 4; ++m)
#pragma unroll
                    for (int n = 0; n < 2; ++n) acc[a][b][m][n] = (f32x4){0.f, 0.f, 0.f, 0.f};
        cur = nxt; cA = nA; cB = nB; ++ui;
        if constexpr (ALIGN_EPI) { if (wr == 1) PG8_BAR; }
    }
    PG8_WAIT_V(0);
    if constexpr (!ALIGN_EPI) { if (wr == 0) PG8_BAR; }
    PG8_BAR;
#undef PG8_SA
#undef PG8_SB
#undef PG8_STAGE
#undef PG8_LDA
#undef PG8_LDB
#undef PG8_MMA
#undef PG8_WAIT_V
#undef PG8_WAIT_L
#undef PG8_BAR
#undef PG8_SCHED
}
}
typedef f32x4 AccT[2][2][4][2];

DI float row_rms_scale(const float* ss, int row) {
    const f32x4 a = ldg_f4(ss + (size_t)row * 8), b = ldg_f4(ss + (size_t)row * 8 + 4);
    return rsqrtf(((a[0] + a[1]) + (a[2] + a[3]) + (b[0] + b[1]) + (b[2] + b[3])) * (1.f / DM) + NORM_EPS);
}
DI float row_rms_scale16(const float* ss, int row) {
    const f32x4 a = ldg_f4(ss + (size_t)row * 16), b = ldg_f4(ss + (size_t)row * 16 + 4), c = ldg_f4(ss + (size_t)row * 16 + 8), d = ldg_f4(ss + (size_t)row * 16 + 12);
    return rsqrtf((((a[0] + a[1]) + (a[2] + a[3]) + (b[0] + b[1]) + (b[2] + b[3])) + ((c[0] + c[1]) + (c[2] + c[3]) + (d[0] + d[1]) + (d[2] + d[3]))) * (1.f / DM) + NORM_EPS);
}
template <int NSS> DI void row_scales8(const float* ss, int row0, int fq, float (&rs)[8]) {
    if constexpr (NSS == 16) { f32x4 q[8];
#pragma unroll
        for (int i = 0; i < 8; ++i) q[i] = ldg_f4(ss + (size_t)(row0 + (i >> 2) * 128 + (i & 3) * 16) * 16 + 4 * fq);
#pragma unroll
        for (int i = 0; i < 8; ++i) rs[i] = (q[i][0] + q[i][1]) + (q[i][2] + q[i][3]);
    } else { f32x2 q[8];
#pragma unroll
        for (int i = 0; i < 8; ++i) q[i] = ldg_f2(ss + (size_t)(row0 + (i >> 2) * 128 + (i & 3) * 16) * 8 + 2 * fq);
#pragma unroll
        for (int i = 0; i < 8; ++i) rs[i] = q[i][0] + q[i][1];
    }
#pragma unroll
    for (int i = 0; i < 8; ++i) rs[i] = rsqrtf(xsum_16_32(rs[i]) * (1.f / DM) + NORM_EPS);
}
struct EpiPlain {
    static constexpr bool PERM = true;
    bf16_t* O; int ldc; const float* ss; int nss;
    DI void operator()(const AccT& acc, const pg8::Unit& u, int wr, int wc, int fr_in, int fq_in) const {
        int t_e = threadIdx.x; asm volatile("" : "+v"(t_e)); const int fr = t_e & 15, fq = (t_e >> 4) & 3; (void)fr_in; (void)fq_in;
        const int row0 = u.pm * 256 + wr * 64 + fr, col0 = u.pn * 256 + wc * 32 + 8 * fq;
        float rs[8];
        if (nss == 16) row_scales8<16>(ss, row0, fq, rs); else row_scales8<8>(ss, row0, fq, rs);
#pragma unroll
        for (int ai = 0; ai < 2; ++ai)
#pragma unroll
            for (int m = 0; m < 4; ++m) { bf16_t* rowp = O + (size_t)(row0 + ai * 128 + m * 16) * ldc + col0;
#pragma unroll
                for (int bj = 0; bj < 2; ++bj) { const f32x4 v0 = acc[ai][bj][m][0] * rs[ai * 4 + m], v1 = acc[ai][bj][m][1] * rs[ai * 4 + m];
                    u32x4 w; w.x = cvt_pk_bf16(v0[0], v0[1]); w.y = cvt_pk_bf16(v0[2], v0[3]); w.z = cvt_pk_bf16(v1[0], v1[1]); w.w = cvt_pk_bf16(v1[2], v1[3]);
                    stg_u4(rowp + bj * 128, w); } }
    }
};
struct EpiResid {
    static constexpr bool PERM = true;
    const float* Hin; float* Hout; const float* bias; int zero; bf16_t* HBo; float* ss16;
    DI void operator()(const AccT& acc, const pg8::Unit& u, int wr, int wc, int fr_in, int fq_in) const {
        int t_e = threadIdx.x; asm volatile("" : "+v"(t_e)); const int fr = t_e & 15, fq = (t_e >> 4) & 3; (void)fr_in; (void)fq_in;
        const int row0 = u.pm * 256 + wr * 64 + fr, col0 = u.pn * 256 + wc * 32 + 8 * fq;
        f32x4 bv[2][2];
#pragma unroll
        for (int bj = 0; bj < 2; ++bj)
#pragma unroll
            for (int n = 0; n < 2; ++n) bv[bj][n] = bias ? ldg_f4(bias + col0 + bj * 128 + 4 * n) : (f32x4){0.f, 0.f, 0.f, 0.f};
        f32x4 hin[2][4][2][2];
#define RESID_LD(a) do { _Pragma("unroll") for (int m_ = 0; m_ < 4; ++m_) { const size_t ro_ = (size_t)(row0 + (a) * 128 + m_ * 16) * DM + col0; \
            _Pragma("unroll") for (int bj = 0; bj < 2; ++bj) _Pragma("unroll") for (int n = 0; n < 2; ++n) hin[a][m_][bj][n] = ldg_f4(Hin + ro_ + bj * 128 + 4 * n); } } while (0)
        RESID_LD(0); __builtin_amdgcn_sched_barrier(0);
#pragma unroll
        for (int i = 0; i < 8; ++i) { const int ai = i >> 2, m = i & 3; const int row = row0 + ai * 128 + m * 16; const size_t ro = (size_t)row * DM + col0; float sq = 0.f;
            if (i == 2) { __builtin_amdgcn_sched_barrier(0); RESID_LD(1); __builtin_amdgcn_sched_barrier(0); }
            if (i == 4) __builtin_amdgcn_sched_barrier(0);
#pragma unroll
            for (int bj = 0; bj < 2; ++bj) { f32x4 hv[2];
#pragma unroll
                for (int n = 0; n < 2; ++n) { const f32x4 h_in = hin[ai][m][bj][n];
                    hv[n] = zero ? h_in : (h_in + acc[ai][bj][m][n] + bv[bj][n]); stg_f4(Hout + ro + bj * 128 + 4 * n, hv[n]);
                    sq += (hv[n][0] * hv[n][0] + hv[n][1] * hv[n][1]) + (hv[n][2] * hv[n][2] + hv[n][3] * hv[n][3]); }
                u32x4 w; w.x = cvt_pk_bf16(hv[0][0], hv[0][1]); w.y = cvt_pk_bf16(hv[0][2], hv[0][3]); w.z = cvt_pk_bf16(hv[1][0], hv[1][1]); w.w = cvt_pk_bf16(hv[1][2], hv[1][3]);
                stg_u4(HBo + ro + bj * 128, w); }
            sq = xsum_16_32(sq);
            if (fq == 0) *(GAS float*)(ss16 + (size_t)row * 16 + u.pn * 4 + wc) = sq;
        }
#undef RESID_LD
    }
};
struct EpiGlu {
    static constexpr bool PERM = true;
    bf16_t* O; const float* bias; const float* ss;
    DI void operator()(const AccT& acc, const pg8::Unit& u, int wr, int wc, int fr_in, int fq_in) const {
        int t_e = threadIdx.x; asm volatile("" : "+v"(t_e)); const int fr = t_e & 15, fq = (t_e >> 4) & 3; (void)fr_in; (void)fq_in;
        const int row0 = u.pm * 256 + wr * 64 + fr, col0 = u.pn * 128 + wc * 32 + 8 * fq;
        f32x4 bu[2], bg[2];
#pragma unroll
        for (int n = 0; n < 2; ++n) { bu[n] = ldg_f4(bias + col0 + 4 * n); bg[n] = ldg_f4(bias + 1024 + col0 + 4 * n); }
        float rs8[8]; row_scales8<8>(ss, row0, fq, rs8);
#pragma unroll
        for (int ai = 0; ai < 2; ++ai)
#pragma unroll
            for (int m = 0; m < 4; ++m) { bf16_t* rowp = O + (size_t)(row0 + ai * 128 + m * 16) * DM + col0;
                const float rs = rs8[ai * 4 + m];
                float r[8];
#pragma unroll
                for (int n = 0; n < 2; ++n)
#pragma unroll
                    for (int e = 0; e < 4; ++e) { const float uu = acc[ai][0][m][n][e] * rs + bu[n][e], gg = acc[ai][1][m][n][e] * rs + bg[n][e];
                        r[4 * n + e] = uu / (1.f + __expf(-gg)); }
                u32x4 w; w.x = cvt_pk_bf16(r[0], r[1]); w.y = cvt_pk_bf16(r[2], r[3]); w.z = cvt_pk_bf16(r[4], r[5]); w.w = cvt_pk_bf16(r[6], r[7]);
                stg_u4(rowp, w); }
    }
};
struct EpiQup {
    static constexpr bool PERM = true;
    bf16_t* O; const float* cosr; const float* sinr; float qscale;
    DI void operator()(const AccT& acc, const pg8::Unit& u, int wr, int wc, int fr_in, int fq_in) const {
        int t_e = threadIdx.x; asm volatile("" : "+v"(t_e)); const int fr = t_e & 15, fq = (t_e >> 4) & 3; (void)fr_in; (void)fq_in;
        const int row0 = u.pm * 256 + wr * 64 + fr;
#pragma unroll
        for (int bj = 0; bj < 2; ++bj) {
            const int c32 = u.pn * 256 + bj * 128 + wc * 32;
            const bool rope = (c32 % 96) == 64;
#pragma unroll
            for (int ai = 0; ai < 2; ++ai)
#pragma unroll
                for (int m = 0; m < 4; ++m) { const int row = row0 + ai * 128 + m * 16;
                    float r[8];
#pragma unroll
                    for (int n = 0; n < 2; ++n)
#pragma unroll
                        for (int e = 0; e < 4; ++e) r[4 * n + e] = acc[ai][bj][m][n][e];
                    if (rope) {
                        const int i0 = 8 * (fq & 1);
                        const f32x4 c0 = *(const f32x4*)(cosr + (size_t)row * 16 + i0), c1 = *(const f32x4*)(cosr + (size_t)row * 16 + i0 + 4);
                        const f32x4 s0 = *(const f32x4*)(sinr + (size_t)row * 16 + i0), s1 = *(const f32x4*)(sinr + (size_t)row * 16 + i0 + 4);
#pragma unroll
                        for (int j = 0; j < 8; ++j) { const float own = r[j]; auto sw = __builtin_amdgcn_permlane32_swap(__float_as_uint(own), __float_as_uint(own), false, false); const unsigned sw0 = sw[0], sw1 = sw[1];
                            const float oth = __uint_as_float(fq < 2 ? sw1 : sw0);
                            const float c = j < 4 ? c0[j & 3] : c1[j & 3], s = j < 4 ? s0[j & 3] : s1[j & 3];
                            r[j] = (fq < 2) ? (own * c - oth * s) : (own * c + oth * s); }
                    }
                    u32x4 w; w.x = cvt_pk_bf16(r[0] * qscale, r[1] * qscale); w.y = cvt_pk_bf16(r[2] * qscale, r[3] * qscale);
                    w.z = cvt_pk_bf16(r[4] * qscale, r[5] * qscale); w.w = cvt_pk_bf16(r[6] * qscale, r[7] * qscale);
                    stg_u4(O + (size_t)row * 768 + c32 + 8 * fq, w);
                    asm volatile("" ::: "memory"); }
        }
    }
};
struct EpiKVup {
    static constexpr bool PERM = true;
    bf16_t* KM; bf16_t* VM;
    DI void operator()(const AccT& acc, const pg8::Unit& u, int wr, int wc, int fr_in, int fq_in) const {
        int t_e = threadIdx.x; asm volatile("" : "+v"(t_e)); const int fr = t_e & 15, fq = (t_e >> 4) & 3; (void)fr_in; (void)fq_in;
        const int row0 = u.pm * 256 + wr * 64 + fr;
#pragma unroll
        for (int bj = 0; bj < 2; ++bj) { const int head = 2 * u.pn + bj;
            bf16_t* base = (wc < 2) ? (KM + head * 96 + wc * 32 + 8 * fq) : (VM + head * 64 + (wc - 2) * 32 + 8 * fq);
            const int pitch = (wc < 2) ? 768 : 512;
#pragma unroll
            for (int ai = 0; ai < 2; ++ai)
#pragma unroll
                for (int m = 0; m < 4; ++m) { const int row = row0 + ai * 128 + m * 16; const f32x4 v0 = acc[ai][bj][m][0], v1 = acc[ai][bj][m][1];
                    u32x4 w; w.x = cvt_pk_bf16(v0[0], v0[1]); w.y = cvt_pk_bf16(v0[2], v0[3]); w.z = cvt_pk_bf16(v1[0], v1[1]); w.w = cvt_pk_bf16(v1[2], v1[3]);
                    stg_u4(base + (size_t)row * pitch, w); } }
    }
};

#define XB_TMO      128
#define XB_XCNT(j)  (256  + 64 * (j))
#define XB_XSUB(j)  (1280 + 64 * (j))
#define XB_XGEN(j)  (2304 + 64 * (j))
#define XB_TOP      3328
#define XB_TOPGEN   3392
#define XCD_BAR_WORDS 3456
#define XB_XLOC(j)  (3456 + 64 * (j))
#define XB_SPIN_CAP (1u << 18)
__device__ __forceinline__ unsigned xb_ld(unsigned* p)              { return __hip_atomic_load(p, __ATOMIC_RELAXED, __HIP_MEMORY_SCOPE_AGENT); }
__device__ __forceinline__ unsigned xb_add(unsigned* p, unsigned v) { return __hip_atomic_fetch_add(p, v, __ATOMIC_RELAXED, __HIP_MEMORY_SCOPE_AGENT); }
__device__ __forceinline__ unsigned xb_xcc_id() { return (unsigned)__builtin_amdgcn_s_getreg((3 << 11) | 20) & 0xFu; }
#define XB_SPIN(cond, bar) do { unsigned _sp = 0; while (cond) { __builtin_amdgcn_s_sleep(1); \
    if ((++_sp & 255u) == 0u) { if (xb_ld(&(bar)[XB_TMO])) break; if (_sp > XB_SPIN_CAP) { atomicAdd(&(bar)[XB_TMO], 1u); break; } } } } while (0)
struct XcdBarrier { unsigned* bar; unsigned x; volatile LAS unsigned* st; };
__device__ __forceinline__ XcdBarrier xcd_barrier_post(unsigned* bar, volatile LAS unsigned* st) {
    XcdBarrier b; b.bar = bar; b.x = xb_xcc_id(); b.st = st;
    if (threadIdx.x == 0) st[2] = xb_add(&bar[XB_XCNT(b.x)], 1u);
    return b;
}
__device__ __forceinline__ void xcd_barrier_complete(unsigned* bar, unsigned x, unsigned& nloc, unsigned& nx, unsigned& uni) {
    const unsigned G = gridDim.x * gridDim.y * gridDim.z;
    unsigned sum, cnt, mine, sp = 0u, even;
    for (;;) {
        sum = 0u; cnt = 0u; mine = 0u; even = 1u;
#pragma unroll
        for (unsigned j = 0; j < 16; ++j) { const unsigned c = xb_ld(&bar[XB_XCNT(j)]); sum += c; cnt += (c > 0u) ? 1u : 0u; mine = (j == x) ? c : mine;
            if (j < 8u ? (c * 8u != G) : (c != 0u)) even = 0u; }
        if (sum == G) break;
        __builtin_amdgcn_s_sleep(1);
        if ((++sp & 255u) == 0u) { if (xb_ld(&bar[XB_TMO])) break; if (sp > XB_SPIN_CAP) { atomicAdd(&bar[XB_TMO], 1u); break; } }
    }
    nloc = mine > 0u ? mine : 1u; nx = cnt > 0u ? cnt : 1u; uni = (sum == G) ? even : 0u;
}
__device__ __forceinline__ void xcd_barrier(const XcdBarrier& b) {
    asm volatile("s_waitcnt vmcnt(0)" ::: "memory");
    __syncthreads();
    if (threadIdx.x == 0) {
        unsigned* bar = b.bar;
        __builtin_amdgcn_s_waitcnt(0);
        unsigned nloc = b.st[0], nx = b.st[1];
        if (nloc == 0u) { unsigned uni; xcd_barrier_complete(bar, b.x, nloc, nx, uni); b.st[0] = nloc; b.st[1] = nx; b.st[3] = uni; }
        const unsigned old = xb_add(&bar[XB_XSUB(b.x)], 1u);
        const unsigned gen = old / nloc;
        if (old + 1u == (gen + 1u) * nloc) {
            __builtin_amdgcn_fence(__ATOMIC_RELEASE, "agent");
            asm volatile("s_waitcnt vmcnt(0)" ::: "memory");
            const unsigned og = xb_add(&bar[XB_TOP], 1u);
            const unsigned tg = og / nx;
            if (og + 1u == (tg + 1u) * nx) xb_add(&bar[XB_TOPGEN], 1u);
            else XB_SPIN(xb_ld(&bar[XB_TOPGEN]) == tg, bar);
            __builtin_amdgcn_fence(__ATOMIC_ACQUIRE, "agent");
            xb_add(&bar[XB_XGEN(b.x)], 1u);
            asm volatile("s_waitcnt vmcnt(0)" ::: "memory");
        } else {
            XB_SPIN(xb_ld(&bar[XB_XGEN(b.x)]) == gen, bar);
            __builtin_amdgcn_fence(__ATOMIC_ACQUIRE, "agent");
            asm volatile("s_waitcnt vmcnt(0)" ::: "memory");
        }
    }
    __syncthreads();
}

__device__ __forceinline__ void xcd_local_barrier(const XcdBarrier& b, unsigned nloc, unsigned lgen) {
    asm volatile("s_waitcnt vmcnt(0)" ::: "memory");
    __syncthreads();
    if (threadIdx.x == 0) {
        unsigned* bar = b.bar;
        (void)xb_add(&bar[XB_XLOC(b.x)], 1u);
        XB_SPIN(xb_ld(&bar[XB_XLOC(b.x)]) < lgen * nloc, bar);
        __builtin_amdgcn_fence(__ATOMIC_ACQUIRE, "agent");
        asm volatile("s_waitcnt vmcnt(0)" ::: "memory");
    }
    __syncthreads();
}

struct Params {
    const float* in[23];
    float* out;
    unsigned char* ws;
    double inv_r[16];
    double inv_m[32];
    int ph_lo, ph_hi;
};

template <int GLU>
DI void transpose_item(const float* W, int K, int N, bf16_t* WT, LAS float* scr, int item, int lane, const float* kgain = nullptr) {
    const int nblk = N / 32, kb = item / nblk, nb = item % nblk, k0 = 64 * kb, n0 = 32 * nb;
#pragma unroll 8
    for (int i = 0; i < 32; ++i) { const int kk = 2 * i + (lane >> 5); const float gk = kgain ? kgain[k0 + kk] : 1.f; scr[kk * 33 + (lane & 31)] = W[(size_t)(k0 + kk) * N + n0 + (lane & 31)] * gk; }
    LDS_WAIT(); asm volatile("" ::: "memory");
    const int c = lane & 7;
#pragma unroll
    for (int j = 0; j < 4; ++j) { const int n = (lane >> 3) + 8 * j; const LAS float* s = scr + (8 * c) * 33 + n;
        u32x4 o; o.x = cvt_pk_bf16(s[0 * 33], s[1 * 33]); o.y = cvt_pk_bf16(s[2 * 33], s[3 * 33]); o.z = cvt_pk_bf16(s[4 * 33], s[5 * 33]); o.w = cvt_pk_bf16(s[6 * 33], s[7 * 33]);
        int nn = n0 + n;
        if (GLU) nn = (nn < 1024) ? ((nn >> 7) * 256 + (nn & 127)) : (((nn - 1024) >> 7) * 256 + 128 + (nn & 127));
        *(u32x4*)(WT + (size_t)nn * K + k0 + 8 * c) = o; }
    LDS_WAIT(); asm volatile("" ::: "memory");
}
DI void rms_row_to_bf16(const float* xrow, const float* gain, bf16_t* orow, int lane) {
    const f32x4* xr = (const f32x4*)xrow + lane; const f32x4* gr = (const f32x4*)gain + lane;
    f32x4 v[4]; float s = 0.f;
#pragma unroll
    for (int j = 0; j < 4; ++j) { v[j] = xr[64 * j]; s += (v[j].x * v[j].x + v[j].y * v[j].y) + (v[j].z * v[j].z + v[j].w * v[j].w); }
    const float r = rsqrtf(wave_sum(s) * (1.f / DM) + NORM_EPS);
    u32x2* o8 = (u32x2*)orow + lane;
#pragma unroll
    for (int j = 0; j < 4; ++j) { const f32x4 g = gr[64 * j]; u32x2 o; o.x = cvt_pk_bf16(v[j].x * r * g.x, v[j].y * r * g.y); o.y = cvt_pk_bf16(v[j].z * r * g.z, v[j].w * r * g.w); o8[64 * j] = o; }
}

DI void rms_row_q(const float* xrow, const float* gain, bf16_t* orow, unsigned char* xq, float* sx, int lane) {
    f32x4 v[4]; float s = 0.f;
#pragma unroll
    for (int j = 0; j < 4; ++j) { v[j] = ldg_f4(xrow + 4 * lane + 256 * j); s += (v[j].x * v[j].x + v[j].y * v[j].y) + (v[j].z * v[j].z + v[j].w * v[j].w); }
    const float r = rsqrtf(wave_sum(s) * (1.f / DM) + NORM_EPS);
    float am = 0.f;
#pragma unroll
    for (int j = 0; j < 4; ++j) { const f32x4 g = ldg_f4(gain + 4 * lane + 256 * j); v[j] = v[j] * r * g;
        u32x2 o; o.x = cvt_pk_bf16(v[j].x, v[j].y); o.y = cvt_pk_bf16(v[j].z, v[j].w); *(GAS u32x2*)(orow + 4 * lane + 256 * j) = o;
        am = fmaxf(fmaxf(am, fabsf(v[j].x)), fmaxf(fmaxf(fabsf(v[j].y), fabsf(v[j].z)), fabsf(v[j].w))); }
    am = wave_max_all(am);
    const float inv = am > 0.f ? 127.f / am : 0.f;
#pragma unroll
    for (int j = 0; j < 4; ++j) *(GAS unsigned*)(xq + 4 * lane + 256 * j) = pack4_i8(v[j].x, v[j].y, v[j].z, v[j].w, inv, 0);
    if (lane == 0) *sx = am * (1.f / 127.f);
}

DI void token_prep_unit(LAS unsigned char* lds, int unit, const bf16_t* proj, const float* qn, const float* kvn,
                        const float* cosr, const float* sinr, const float* cosm, const float* sinm,
                        bf16_t* cqn, bf16_t* ckvn, bf16_t* KM, bf16_t* MQ, bf16_t* MK, float* kpart, int wave, int lane) {
    float ks1[4] = {0.f, 0.f, 0.f, 0.f}, ks2[4] = {0.f, 0.f, 0.f, 0.f};
    const float mscale = 0.125f * LOG2E;
    for (int i = 0; i < 8; ++i) {
        const int row = unit * 64 + wave * 8 + i;
        const bf16_t* P = proj + (size_t)row * NPROJP;
        { unsigned w[3]; float ss = 0.f;
#pragma unroll
          for (int j = 0; j < 3; ++j) { w[j] = *(const unsigned*)(P + 2 * lane + 128 * j); const float a = bf_lo(w[j]), b = bf_hi(w[j]); ss += a * a + b * b; }
          const float r = rsqrtf(wave_sum(ss) * (1.f / 384.f) + NORM_EPS);
#pragma unroll
          for (int j = 0; j < 3; ++j) { const f32x2 g = *(const f32x2*)(qn + 2 * lane + 128 * j);
              *(unsigned*)(cqn + (size_t)row * 384 + 2 * lane + 128 * j) = cvt_pk_bf16(bf_lo(w[j]) * r * g.x, bf_hi(w[j]) * r * g.y); } }
        { unsigned w[2]; float ss = 0.f;
#pragma unroll
          for (int j = 0; j < 2; ++j) { w[j] = *(const unsigned*)(P + 384 + 2 * lane + 128 * j); const float a = bf_lo(w[j]), b = bf_hi(w[j]); ss += a * a + b * b; }
          const float r = rsqrtf(wave_sum(ss) * (1.f / 256.f) + NORM_EPS);
#pragma unroll
          for (int j = 0; j < 2; ++j) { const f32x2 g = *(const f32x2*)(kvn + 2 * lane + 128 * j);
              *(unsigned*)(ckvn + (size_t)row * 256 + 2 * lane + 128 * j) = cvt_pk_bf16(bf_lo(w[j]) * r * g.x, bf_hi(w[j]) * r * g.y); } }
        { const int h = lane >> 3, i2 = 2 * (lane & 7);
          const unsigned x1 = *(const unsigned*)(P + 640 + i2), x2 = *(const unsigned*)(P + 656 + i2);
          const f32x2 c = *(const f32x2*)(cosr + (size_t)row * 16 + i2), s = *(const f32x2*)(sinr + (size_t)row * 16 + i2);
          const float a0 = bf_lo(x1), a1 = bf_hi(x1), b0 = bf_lo(x2), b1 = bf_hi(x2);
          *(unsigned*)(KM + (size_t)row * 768 + h * 96 + 64 + i2) = cvt_pk_bf16(a0 * c.x - b0 * s.x, a1 * c.y - b1 * s.y);
          *(unsigned*)(KM + (size_t)row * 768 + h * 96 + 80 + i2) = cvt_pk_bf16(b0 * c.x + a0 * s.x, b1 * c.y + a1 * s.y); }
        { const int hq = lane >> 3, i4 = 4 * (lane & 7);
          const f32x4 c = *(const f32x4*)(cosm + (size_t)row * 32 + i4), s = *(const f32x4*)(sinm + (size_t)row * 32 + i4);
          { const u32x2 x1 = *(const u32x2*)(P + 672 + hq * 64 + i4), x2 = *(const u32x2*)(P + 672 + hq * 64 + 32 + i4);
            const float a[4] = {bf_lo(x1.x), bf_hi(x1.x), bf_lo(x1.y), bf_hi(x1.y)}, b[4] = {bf_lo(x2.x), bf_hi(x2.x), bf_lo(x2.y), bf_hi(x2.y)};
            float y1[4], y2[4];
#pragma unroll
            for (int e = 0; e < 4; ++e) { y1[e] = (a[e] * c[e] - b[e] * s[e]) * mscale; y2[e] = (b[e] * c[e] + a[e] * s[e]) * mscale; }
            u32x2 o1, o2; o1.x = cvt_pk_bf16(y1[0], y1[1]); o1.y = cvt_pk_bf16(y1[2], y1[3]); o2.x = cvt_pk_bf16(y2[0], y2[1]); o2.y = cvt_pk_bf16(y2[2], y2[3]);
            *(u32x2*)(MQ + (size_t)row * 512 + hq * 64 + i4) = o1; *(u32x2*)(MQ + (size_t)row * 512 + hq * 64 + 32 + i4) = o2; }
          { const u32x2 x1 = *(const u32x2*)(P + 1184 + hq * 64 + i4), x2 = *(const u32x2*)(P + 1184 + hq * 64 + 32 + i4);
            const float a[4] = {bf_lo(x1.x), bf_hi(x1.x), bf_lo(x1.y), bf_hi(x1.y)}, b[4] = {bf_lo(x2.x), bf_hi(x2.x), bf_lo(x2.y), bf_hi(x2.y)};
            float y1[4], y2[4];
#pragma unroll
            for (int e = 0; e < 4; ++e) { y1[e] = a[e] * c[e] - b[e] * s[e]; y2[e] = b[e] * c[e] + a[e] * s[e]; ks1[e] += y1[e]; ks2[e] += y2[e]; }
            u32x2 o1, o2; o1.x = cvt_pk_bf16(y1[0], y1[1]); o1.y = cvt_pk_bf16(y1[2], y1[3]); o2.x = cvt_pk_bf16(y2[0], y2[1]); o2.y = cvt_pk_bf16(y2[2], y2[3]);
            *(u32x2*)(MK + (size_t)row * 512 + hq * 64 + i4) = o1; *(u32x2*)(MK + (size_t)row * 512 + hq * 64 + 32 + i4) = o2; } }
    }
    LAS float* red = (LAS float*)lds;
    { const int hq = lane >> 3, i4 = 4 * (lane & 7);
#pragma unroll
      for (int e = 0; e < 4; ++e) { red[wave * 512 + hq * 64 + i4 + e] = ks1[e]; red[wave * 512 + hq * 64 + 32 + i4 + e] = ks2[e]; } }
    __syncthreads();
    { const int tid = wave * 64 + lane; float s = 0.f;
#pragma unroll
      for (int w = 0; w < 8; ++w) s += red[w * 512 + tid];
      const int row0 = unit * 64, b = row0 / SEQ, t0 = row0 % SEQ, n = t0 / 256, part = (t0 % 256) / 64;
      kpart[((size_t)(b * 32 + n) * 4 + part) * 512 + tid] = s; }
    __syncthreads();
}

DI float xmax32(float v) {
    auto r = __builtin_amdgcn_permlane32_swap(__float_as_uint(v), __float_as_uint(v), false, false); const unsigned r0 = r[0], r1 = r[1];
    return fmaxf(__uint_as_float(r0), __uint_as_float(r1)); }
DI float xsum32(float v) {
    auto r = __builtin_amdgcn_permlane32_swap(__float_as_uint(v), __float_as_uint(v), false, false); const unsigned r0 = r[0], r1 = r[1];
    return __uint_as_float(r0) + __uint_as_float(r1); }
#ifndef ATTN_THR
#define ATTN_THR 8.0f
#endif
DI s16x4 vtr(const LAS char* p) { return __builtin_bit_cast(s16x4, __builtin_amdgcn_ds_read_tr16_b64_v4i16((LAS v4i16_t*)p)); }
#define MFMA32(a, b, c) __builtin_amdgcn_mfma_f32_32x32x16_bf16((a), (b), (c), 0, 0, 0)

#define SPB() __builtin_amdgcn_sched_barrier(0)
#define SPIN(x) asm volatile("" : "+v"(x))
#define MX3(a, b, c) fmaxf(fmaxf((a), (b)), (c))
DI float rowmax32(const f32x16& p0, const f32x16& p1) {
    float a = MX3(p0[0], p0[1], p1[0]), b = MX3(p0[2], p0[3], p1[1]); a = MX3(a, p1[2], p1[3]);
#pragma unroll
    for (int r = 4; r < 16; r += 4) { a = MX3(a, p0[r], p0[r + 1]); b = MX3(b, p0[r + 2], p0[r + 3]); a = MX3(a, p1[r], p1[r + 1]); b = MX3(b, p1[r + 2], p1[r + 3]); }
    return xmax32(fmaxf(a, b));
}
DI void cmask32(f32x16& p0, f32x16& p1, int jb, int qrel, int hi) {
    const int kb = 64 * jb + 4 * hi;
#pragma unroll
    for (int r = 0; r < 16; ++r) { const int kv = kb + (r & 3) + 8 * (r >> 2); if (kv > qrel) p0[r] = -INFINITY; if (kv + 32 > qrel) p1[r] = -INFINITY; }
}
DI void glds16_asm(const void* g, unsigned lds_base) {
    unsigned sv; asm volatile("s_mov_b32 %0, m0\n\ts_mov_b32 m0, %2\n\ts_nop 0\n\tglobal_load_lds_dwordx4 %1, off\n\ts_mov_b32 m0, %0" : "=&s"(sv) : "v"(g), "s"(lds_base) : "memory"); }
template <int DK>
DI void attn_unit_sp(LAS unsigned char* lds, const bf16_t* Qp, int qpitch, const bf16_t* Kp, int kpitch, const bf16_t* Vp, int vpitch, bf16_t* Op, int opitch, int qb) {
    static_assert(DK == 96, "12 K fragments");
    constexpr int NKS = DK / 16, KCH = DK / 8, KBYTES = KCH * 1024, VBYTES = 8192, OFF_K = 0, OFF_V = 3 * KBYTES;
    int tid_o = threadIdx.x; asm volatile("" : "+v"(tid_o));
    const int tid = tid_o, lane = tid & 63, r32 = lane & 31, hi = lane >> 5; const int wid = __builtin_amdgcn_readfirstlane(tid >> 6);
    const int q0 = qb * 256, NT = 4 * qb + 4;
    const bf16_t* kg0 = Kp + (size_t)lane * kpitch + wid * 8;
    const bf16_t* kg1 = Kp + (size_t)lane * kpitch + (8 + (wid & 3)) * 8;
    const bf16_t* vg = Vp + (size_t)(16 * (wid & 3) + (lane >> 2)) * vpitch + (wid >> 2) * 32 + (lane & 3) * 8;
    const int kd0 = OFF_K + wid * 1024, kd1 = OFF_K + (8 + (wid & 3)) * 1024, vd = OFF_V + wid * 1024;
    const unsigned lds0 = (unsigned)(size_t)lds;
#define SP_DMA(g, off) glds16_asm((g), (unsigned)__builtin_amdgcn_readfirstlane((int)(lds0 + (unsigned)(off))))
#define SP_DMAK(tk, slot) do { const size_t rk_ = (size_t)(tk) * 64 * kpitch; SP_DMA(kg0 + rk_, kd0 + (slot) * KBYTES); if (wid < 4) SP_DMA(kg1 + rk_, kd1 + (slot) * KBYTES); } while (0)
#define SP_DMAV(tv, slot) SP_DMA(vg + (size_t)(tv) * 64 * vpitch, vd + (slot) * VBYTES)
#define SP_BAR(N) asm volatile("s_waitcnt vmcnt(" #N ") lgkmcnt(0)\n\ts_barrier" ::: "memory")
#define KLD2(so, d0) do { kf[2 * (d0)] = *(const LAS bf16x8*)(kp0 + (so) + (d0) * 2048); kf[2 * (d0) + 1] = *(const LAS bf16x8*)(kp0 + (so) + (d0) * 2048 + 512); } while (0)
    SP_DMAK(0, 0); SP_DMAV(0, 0); SP_DMAK(1, 1); SP_DMAK(2, 2); SP_DMAV(1, 1);
    bf16x8 qf[NKS];
    { const bf16_t* qrow = Qp + (size_t)(q0 + wid * 32 + r32) * qpitch + hi * 8;
#pragma unroll
      for (int ks = 0; ks < NKS; ++ks) qf[ks] = *(const GAS bf16x8*)(qrow + ks * 16); }
    const int qrel = wid * 32 + r32;
    const LAS char* vp0 = (const LAS char*)lds + OFF_V + (4 * hi + ((lane & 15) >> 2)) * 64 + ((lane >> 4) & 1) * 32 + (lane & 3) * 8;
    const LAS char* kp0 = (const LAS char*)lds + OFF_K + hi * 1024 + r32 * 16;
    f32x16 pA0, pA1, pB0, pB1; bf16x8 kf[2 * NKS]; s16x4 vlo[8], vhi[8]; u32x4 pw0, pw1, pw2, pw3;
    f32x16 ot[2]; ot[0] = f32x16{}; ot[1] = f32x16{};
    float m, l = 0.f, alpha = 1.f; bool resc = false;
    SP_BAR(0);
#pragma unroll
    for (int d0 = 0; d0 < NKS; ++d0) KLD2(0, d0);
    pA0 = MFMA32(kf[0], qf[0], f32x16{}); pA1 = MFMA32(kf[1], qf[0], f32x16{});
#pragma unroll
    for (int d0 = 1; d0 < NKS; ++d0) { pA0 = MFMA32(kf[2 * d0], qf[d0], pA0); pA1 = MFMA32(kf[2 * d0 + 1], qf[d0], pA1); }
    if (NT == 4) cmask32(pA0, pA1, 0, qrel, hi);
    m = rowmax32(pA0, pA1);
#pragma unroll
    for (int r = 0; r < 16; ++r) { pA0[r] = __builtin_amdgcn_exp2f(pA0[r] - m); pA1[r] = __builtin_amdgcn_exp2f(pA1[r] - m); }
#pragma unroll
    for (int d0 = 0; d0 < NKS; ++d0) KLD2(KBYTES, d0);
    SP_BAR(0);
    SP_DMAK(3, 0);
    int sp = 0, sc = 1, sn = 2;
#define ROT3() do { const int t_ = sp; sp = sc; sc = sn; sn = t_; } while (0)
#define PKW(P, i) cvt_pk_bf16_b(P[i], P[(i) + 1])
#define PAF(k) __builtin_bit_cast(bf16x8, pw##k)
#define VFR(i) (bf16x8){vlo[i][0], vlo[i][1], vlo[i][2], vlo[i][3], vhi[i][0], vhi[i][1], vhi[i][2], vhi[i][3]}
#define VRD(i) do { vlo[i] = vtr(vp_ + (((i) >> 2) * 4096 + ((i) & 3) * 1024)); vhi[i] = vtr(vp_ + (((i) >> 2) * 4096 + ((i) & 3) * 1024 + 512)); } while (0)
#define KRD(KRO, d0) do { KLD2(KRO, d0); SPB(); } while (0)
#define EX(v) __builtin_amdgcn_exp2f((v) + nm)
#define GAPA(MF, a0, a1, a2, a3, W0, W1, PW) do { MF; sacc += a0; sacc += a1; sacc += a2; sacc += a3; W0; W1; SPIN(PW); SPIN(sacc); SPB(); } while (0)
#define GAPB(MF, X, i) do { MF; X[i] = EX(X[i]); X[(i) + 1] = EX(X[(i) + 1]); X[(i) + 2] = EX(X[(i) + 2]); X[(i) + 3] = EX(X[(i) + 3]); SPIN(X); SPB(); } while (0)
#define STEP(C0, C1, P0, P1, t, MASK) do { SPB(); \
    { const int tk_ = (t) + 3 < NT ? (t) + 3 : NT - 1, tv_ = (t) + 1 < NT ? (t) + 1 : NT - 1; SP_DMAK(tk_, sc); SP_DMAV(tv_, sn); } \
    const int kro_ = sn * KBYTES; \
    const LAS char* vp_ = vp0 + sp * VBYTES; \
    VRD(0); SPB(); float sacc = P0[0] + P0[1]; \
                    GAPA(C0 = MFMA32(kf[0], qf[0], f32x16{}), P0[2], P0[3], P0[4], P0[5],     pw0[0] = PKW(P0, 0),  pw0[1] = PKW(P0, 2),  pw0); \
    VRD(4); SPB(); GAPA(C1 = MFMA32(kf[1], qf[0], f32x16{}), P0[6], P0[7], P0[8], P0[9],     pw0[2] = PKW(P0, 4),  pw0[3] = PKW(P0, 6),  pw0); \
    VRD(1); SPB(); GAPA(C0 = MFMA32(kf[2], qf[1], C0),       P0[10], P0[11], P0[12], P0[13], pw1[0] = PKW(P0, 8),  pw1[1] = PKW(P0, 10), pw1); \
    VRD(5); SPB(); GAPA(C1 = MFMA32(kf[3], qf[1], C1),       P0[14], P0[15], P1[0], P1[1],   pw1[2] = PKW(P0, 12), pw1[3] = PKW(P0, 14), pw1); \
    VRD(2); SPB(); GAPA(C0 = MFMA32(kf[4], qf[2], C0),       P1[2], P1[3], P1[4], P1[5],     pw2[0] = PKW(P1, 0),  pw2[1] = PKW(P1, 2),  pw2); \
    VRD(6); SPB(); GAPA(C1 = MFMA32(kf[5], qf[2], C1),       P1[6], P1[7], P1[8], P1[9],     pw2[2] = PKW(P1, 4),  pw2[3] = PKW(P1, 6),  pw2); \
    VRD(3); SPB(); GAPA(C0 = MFMA32(kf[6], qf[3], C0),       P1[10], P1[11], P1[12], P1[13], pw3[0] = PKW(P1, 8),  pw3[1] = PKW(P1, 10), pw3); \
    VRD(7); SPB(); GAPA(C1 = MFMA32(kf[7], qf[3], C1),       P1[14], P1[15], 0.f, 0.f,       pw3[2] = PKW(P1, 12), pw3[3] = PKW(P1, 14), pw3); \
    C0 = MFMA32(kf[8], qf[4], C0); C1 = MFMA32(kf[9], qf[4], C1); C0 = MFMA32(kf[10], qf[5], C0); C1 = MFMA32(kf[11], qf[5], C1); SPB(); \
    l += sacc; \
    if (MASK) cmask32(C0, C1, (t) - (NT - 4), qrel, hi); \
    { const float rm = rowmax32(C0, C1) - m; resc = false;                                    \
      if (__builtin_expect(__any(rm > ATTN_THR), 0)) { const float dl = fmaxf(rm, 0.f); m += dl; alpha = __builtin_amdgcn_exp2f(-dl); l *= alpha; resc = true; } } \
    const float nm = -m; SPB(); \
                GAPB(ot[0] = MFMA32(VFR(0), PAF(0), ot[0]), C0, 0);              GAPB(ot[1] = MFMA32(VFR(4), PAF(0), ot[1]), C0, 4); \
    KRD(kro_, 0); GAPB(ot[0] = MFMA32(VFR(1), PAF(1), ot[0]), C0, 8);  KRD(kro_, 1); GAPB(ot[1] = MFMA32(VFR(5), PAF(1), ot[1]), C0, 12); \
    KRD(kro_, 2); GAPB(ot[0] = MFMA32(VFR(2), PAF(2), ot[0]), C1, 0);  KRD(kro_, 3); GAPB(ot[1] = MFMA32(VFR(6), PAF(2), ot[1]), C1, 4); \
    KRD(kro_, 4); GAPB(ot[0] = MFMA32(VFR(3), PAF(3), ot[0]), C1, 8);  KRD(kro_, 5); GAPB(ot[1] = MFMA32(VFR(7), PAF(3), ot[1]), C1, 12); \
    if (wid < 4) SP_BAR(3); else SP_BAR(2); ROT3();                                         \
    if (resc) { _Pragma("unroll") for (int r = 0; r < 16; ++r) { ot[0][r] *= alpha; ot[1][r] *= alpha; } }         \
    } while (0)
    int t = 1;
    for (; t + 5 < NT; t += 2) {
        STEP(pB0, pB1, pA0, pA1, t, false);
        STEP(pA0, pA1, pB0, pB1, t + 1, false);
    }
    for (; t + 1 < NT; t += 2) {
        STEP(pB0, pB1, pA0, pA1, t, true);
        STEP(pA0, pA1, pB0, pB1, t + 1, true);
    }
    STEP(pB0, pB1, pA0, pA1, NT - 1, true);
    { float sacc = 0.f;
#pragma unroll
      for (int r = 0; r < 16; ++r) sacc += pB0[r] + pB1[r];
      l += sacc;
      pw0 = (u32x4){PKW(pB0, 0), PKW(pB0, 2), PKW(pB0, 4), PKW(pB0, 6)}; pw1 = (u32x4){PKW(pB0, 8), PKW(pB0, 10), PKW(pB0, 12), PKW(pB0, 14)};
      pw2 = (u32x4){PKW(pB1, 0), PKW(pB1, 2), PKW(pB1, 4), PKW(pB1, 6)}; pw3 = (u32x4){PKW(pB1, 8), PKW(pB1, 10), PKW(pB1, 12), PKW(pB1, 14)};
      const LAS char* vp_ = vp0 + sp * VBYTES;
#pragma unroll
      for (int i = 0; i < 8; ++i) VRD(i);
      ot[0] = MFMA32(VFR(0), PAF(0), ot[0]); ot[1] = MFMA32(VFR(4), PAF(0), ot[1]); ot[0] = MFMA32(VFR(1), PAF(1), ot[0]); ot[1] = MFMA32(VFR(5), PAF(1), ot[1]);
      ot[0] = MFMA32(VFR(2), PAF(2), ot[0]); ot[1] = MFMA32(VFR(6), PAF(2), ot[1]); ot[0] = MFMA32(VFR(3), PAF(3), ot[0]); ot[1] = MFMA32(VFR(7), PAF(3), ot[1]); }
    l = xsum32(l);
    const float rl = 1.f / l;
    bf16_t* orow = Op + (size_t)(q0 + qrel) * opitch;
#pragma unroll
    for (int db = 0; db < 2; ++db)
#pragma unroll
        for (int g = 0; g < 4; ++g) { u32x2 w; w.x = cvt_pk_bf16(ot[db][4 * g] * rl, ot[db][4 * g + 1] * rl); w.y = cvt_pk_bf16(ot[db][4 * g + 2] * rl, ot[db][4 * g + 3] * rl);
            *(GAS u32x2*)(orow + 32 * db + 8 * g + 4 * hi) = w; }
    SP_BAR(0);
#undef ROT3
#undef STEP
#undef GAPA
#undef GAPB
#undef EX
#undef KRD
#undef VRD
#undef VFR
#undef PAF
#undef PKW
#undef KLD2
#undef SP_BAR
#undef SP_DMAV
#undef SP_DMAK
#undef SP_DMA
}
template <int DK, bool MOBA>
DI void attn_unit(LAS unsigned char* lds, const bf16_t* Qp, int qpitch, const bf16_t* Kp, int kpitch, const bf16_t* Vp, int vpitch,
                  bf16_t* Op, int opitch, int qb, const float* kpart_b  ) {
    constexpr int NKS = DK / 16, KCH = DK / 8, KBYTES = KCH * 1024, VBYTES = 8192;
    constexpr int OFF_K0 = 0, OFF_K1 = KBYTES, OFF_V0 = 2 * KBYTES, OFF_V1 = 2 * KBYTES + VBYTES, OFF_KM = 2 * KBYTES + 2 * VBYTES;
    int tid_o = threadIdx.x; asm volatile("" : "+v"(tid_o));
    const int tid = tid_o, lane = tid & 63, r32 = lane & 31, hi = lane >> 5; const int wid = __builtin_amdgcn_readfirstlane(tid >> 6);
    const int q0 = qb * 256, NT = 4 * qb + 4;
    bf16x8 qf[NKS];
    { const bf16_t* qrow = Qp + (size_t)(q0 + wid * 32 + r32) * qpitch + hi * 8;
#pragma unroll
      for (int ks = 0; ks < NKS; ++ks) qf[ks] = *(const bf16x8*)(qrow + ks * 16); }
    unsigned selmask = 0u;
    if constexpr (MOBA) {
        const int own = qb;
        if (own > 0) {
            LAS float* km = (LAS float*)(lds + OFF_KM);
            for (int e = tid; e < own * 64; e += NTHR) { const int n = e >> 6, d = e & 63; const float* kp = kpart_b + (size_t)n * 4 * 512 + d;
                km[e] = (kp[0] + kp[512] + kp[1024] + kp[1536]) * (1.f / 256.f); }
            __syncthreads();
            float qv[NKS][8];
#pragma unroll
            for (int ks = 0; ks < NKS; ++ks)
#pragma unroll
                for (int j = 0; j < 8; ++j) qv[ks][j] = bf1((bf16_t)qf[ks][j]);
            float v0 = -INFINITY, v1 = -INFINITY, v2 = -INFINITY; int i0 = -1, i1 = -1, i2 = -1;
            for (int n = 0; n < own; ++n) {
                float g = 0.f;
#pragma unroll
                for (int ks = 0; ks < NKS; ++ks) { const f32x4 ka = *(const LAS f32x4*)(km + n * 64 + ks * 16 + hi * 8), kb = *(const LAS f32x4*)(km + n * 64 + ks * 16 + hi * 8 + 4);
                    g += qv[ks][0] * ka[0] + qv[ks][1] * ka[1] + qv[ks][2] * ka[2] + qv[ks][3] * ka[3] + qv[ks][4] * kb[0] + qv[ks][5] * kb[1] + qv[ks][6] * kb[2] + qv[ks][7] * kb[3]; }
                g = xsum32(g);
                if (DBG_MOBA_NOISE > 0.f) g += DBG_MOBA_NOISE * 1.7320508f * hash_noise((unsigned)(((size_t)(Qp - (const bf16_t*)0) >> 3) * 31u + (unsigned)((q0 + wid * 32 + r32) * 32 + n)));
                if (g > v0) { v2 = v1; i2 = i1; v1 = v0; i1 = i0; v0 = g; i0 = n; }
                else if (g > v1) { v2 = v1; i2 = i1; v1 = g; i1 = n; }
                else if (g > v2) { v2 = g; i2 = n; }
            }
            if (i0 >= 0) selmask |= 1u << i0;
            if (i1 >= 0) selmask |= 1u << i1;
            if (i2 >= 0) selmask |= 1u << i2;
            __syncthreads();
        }
    }
    const bf16_t* kg0 = Kp + (size_t)lane * kpitch + wid * 8;
    const bf16_t* kg1 = Kp + (size_t)lane * kpitch + (8 + (wid & 3)) * 8;
    const int vrow = tid >> 3, vpc = tid & 7;
    const bf16_t* vg = Vp + (size_t)vrow * vpitch + vpc * 8;
    const int kdst0 = wid * 1024 + lane * 16, kdst1 = (8 + (wid & 3)) * 1024 + lane * 16, vdst = (vpc >> 2) * 4096 + vrow * 64 + (vpc & 3) * 16;
    u32x4 sk0, sk1 = (u32x4){0u, 0u, 0u, 0u}, sv;
    sk0 = *(const u32x4*)kg0; if (DK == 96 && wid < 4) sk1 = *(const u32x4*)kg1; sv = *(const u32x4*)vg;
    *(LAS u32x4*)(lds + OFF_K0 + kdst0) = sk0; if (DK == 96 && wid < 4) *(LAS u32x4*)(lds + OFF_K0 + kdst1) = sk1; *(LAS u32x4*)(lds + OFF_V0 + vdst) = sv;
    float m = -1e30f, l = 0.f; f32x16 ot[2]; ot[0] = f32x16{}; ot[1] = f32x16{};
    const int qrel = wid * 32 + r32;
    const int vq = (lane & 15) >> 2, vp = lane & 3, vblk = (lane >> 4) & 1;
    const int vbase = (4 * hi + vq) * 64 + vblk * 32 + vp * 8;
    for (int t = 0; t < NT; ++t) {
        __syncthreads();
        const int cur = t & 1;
        const bool more = (t + 1 < NT);
        if (more) { const size_t ro = (size_t)(t + 1) * 64; sk0 = *(const u32x4*)(kg0 + ro * kpitch); if (DK == 96 && wid < 4) sk1 = *(const u32x4*)(kg1 + ro * kpitch); sv = *(const u32x4*)(vg + ro * vpitch); }
        const LAS unsigned char* Kb = lds + (cur ? OFF_K1 : OFF_K0); const LAS unsigned char* Vb = lds + (cur ? OFF_V1 : OFF_V0);
        const int jb = t - 4 * qb;
        bool active = true; bool lane_sel = true;
        if (jb >= 0) { if (64 * jb > wid * 32 + 31) active = false; }
        else if constexpr (MOBA) { lane_sel = (selmask >> (t >> 2)) & 1u; active = __any(lane_sel); }
        if (active) {
            f32x16 s0 = f32x16{}, s1 = f32x16{};
#pragma unroll
            for (int ks = 0; ks < NKS; ++ks) {
                const bf16x8 ka = *(const LAS bf16x8*)(Kb + (2 * ks + hi) * 1024 + r32 * 16), kb = *(const LAS bf16x8*)(Kb + (2 * ks + hi) * 1024 + (32 + r32) * 16);
                s0 = MFMA32(ka, qf[ks], s0); s1 = MFMA32(kb, qf[ks], s1);
            }
            if (jb >= 0) { if (64 * jb + 63 > wid * 32) { const int kb0 = 64 * jb + 4 * hi;
#pragma unroll
                for (int r = 0; r < 16; ++r) { const int kv = kb0 + (r & 3) + 8 * (r >> 2); if (kv > qrel) s0[r] = -INFINITY; if (kv + 32 > qrel) s1[r] = -INFINITY; } } }
            else if constexpr (MOBA) { if (!lane_sel) {
#pragma unroll
                for (int r = 0; r < 16; ++r) { s0[r] = -INFINITY; s1[r] = -INFINITY; } } }
            float tm = s0[0];
#pragma unroll
            for (int r = 1; r < 16; ++r) tm = fmaxf(tm, s0[r]);
#pragma unroll
            for (int r = 0; r < 16; ++r) tm = fmaxf(tm, s1[r]);
            tm = xmax32(tm);
            const float mn = fmaxf(m, tm);
            if (__any(tm > m + ATTN_THR)) {
            const float alpha = __builtin_amdgcn_exp2f(m - mn); l *= alpha;
#pragma unroll
                for (int r = 0; r < 16; ++r) { ot[0][r] *= alpha; ot[1][r] *= alpha; }
                m = mn; }
            float ls = 0.f;
#pragma unroll
            for (int r = 0; r < 16; ++r) { s0[r] = __builtin_amdgcn_exp2f(s0[r] - m); s1[r] = __builtin_amdgcn_exp2f(s1[r] - m); ls += s0[r] + s1[r]; }
            l += ls;
            bf16x8 pf[4];
#pragma unroll
            for (int s = 0; s < 4; ++s) { u32x4 w;
                if (s < 2) { w.x = cvt_pk_bf16(s0[8 * s], s0[8 * s + 1]); w.y = cvt_pk_bf16(s0[8 * s + 2], s0[8 * s + 3]); w.z = cvt_pk_bf16(s0[8 * s + 4], s0[8 * s + 5]); w.w = cvt_pk_bf16(s0[8 * s + 6], s0[8 * s + 7]); }
                else { const int q = s - 2; w.x = cvt_pk_bf16(s1[8 * q], s1[8 * q + 1]); w.y = cvt_pk_bf16(s1[8 * q + 2], s1[8 * q + 3]); w.z = cvt_pk_bf16(s1[8 * q + 4], s1[8 * q + 5]); w.w = cvt_pk_bf16(s1[8 * q + 6], s1[8 * q + 7]); }
                pf[s] = __builtin_bit_cast(bf16x8, w); }
#pragma unroll
            for (int db = 0; db < 2; ++db)
#pragma unroll
                for (int s = 0; s < 4; ++s) { const LAS char* vpn = (const LAS char*)Vb + db * 4096 + s * 1024 + vbase;
                    const s16x4 lo = vtr(vpn), hi4 = vtr(vpn + 512);
                    const bf16x8 vf = (bf16x8){lo[0], lo[1], lo[2], lo[3], hi4[0], hi4[1], hi4[2], hi4[3]};
                    ot[db] = MFMA32(vf, pf[s], ot[db]); }
        }
        if (more) { const int nb = cur ^ 1;
            *(LAS u32x4*)(lds + (nb ? OFF_K1 : OFF_K0) + kdst0) = sk0; if (DK == 96 && wid < 4) *(LAS u32x4*)(lds + (nb ? OFF_K1 : OFF_K0) + kdst1) = sk1; *(LAS u32x4*)(lds + (nb ? OFF_V1 : OFF_V0) + vdst) = sv; }
    }
    l = xsum32(l);
    const float rl = 1.f / l;
    bf16_t* orow = Op + (size_t)(q0 + qrel) * opitch;
#pragma unroll
    for (int db = 0; db < 2; ++db)
#pragma unroll
        for (int g = 0; g < 4; ++g) { u32x2 w; w.x = cvt_pk_bf16(ot[db][4 * g] * rl, ot[db][4 * g + 1] * rl); w.y = cvt_pk_bf16(ot[db][4 * g + 2] * rl, ot[db][4 * g + 3] * rl);
            *(u32x2*)(orow + 32 * db + 8 * g + 4 * hi) = w; }
    __syncthreads();
}

DI void moba_select_wg(LAS unsigned char* lds, int unit0  , const bf16_t* MQ, const float* kpart, unsigned* msel, unsigned* ment, unsigned* mcnt, int tid, int wave, int lane) {
    const int bh = unit0 >> 7, b = bh >> 3, h = bh & 7; const int c = (unit0 & 127) + wave, q0 = 64 * c, own = q0 >> 8;
    const int own_max = (64 * ((unit0 & 127) + 7)) >> 8;
    LAS float* km = (LAS float*)lds;
    const float* kpart_b = kpart + (size_t)b * 32 * 4 * 512 + h * 64;
    for (int e = tid; e < own_max * 64; e += NTHR) { const int n = e >> 6, d = e & 63; const float* kp = kpart_b + (size_t)n * 4 * 512 + d; km[e] = (kp[0] + kp[512] + kp[1024] + kp[1536]) * (1.f / 256.f); }
    __syncthreads();
    const int q = q0 + lane; const size_t row = (size_t)b * SEQ + q;
    float qv[64];
    { const bf16_t* qp = MQ + row * 512 + h * 64;
#pragma unroll
      for (int k = 0; k < 8; ++k) { const u32x4 w = ldg_u4(qp + 8 * k); qv[8 * k] = bf_lo(w.x); qv[8 * k + 1] = bf_hi(w.x); qv[8 * k + 2] = bf_lo(w.y); qv[8 * k + 3] = bf_hi(w.y);
          qv[8 * k + 4] = bf_lo(w.z); qv[8 * k + 5] = bf_hi(w.z); qv[8 * k + 6] = bf_lo(w.w); qv[8 * k + 7] = bf_hi(w.w); } }
    float v0 = -INFINITY, v1 = -INFINITY, v2 = -INFINITY; int i0 = -1, i1 = -1, i2 = -1;
    for (int n = 0; n < own; ++n) { float g = 0.f;
#pragma unroll
        for (int k = 0; k < 16; ++k) { const f32x4 kk = *(const LAS f32x4*)(km + n * 64 + 4 * k); g += qv[4 * k] * kk[0] + qv[4 * k + 1] * kk[1] + qv[4 * k + 2] * kk[2] + qv[4 * k + 3] * kk[3]; }
        if (g > v0) { v2 = v1; i2 = i1; v1 = v0; i1 = i0; v0 = g; i0 = n; }
        else if (g > v1) { v2 = v1; i2 = i1; v1 = g; i1 = n; }
        else if (g > v2) { v2 = g; i2 = n; } }
    const int nsel = (i0 >= 0) + (i1 >= 0) + (i2 >= 0);
    msel[(size_t)bh * SEQ + q] = (unsigned)(i0 & 255) | ((unsigned)(i1 & 255) << 8) | ((unsigned)(i2 & 255) << 16) | ((unsigned)nsel << 24);
    int r0 = 0, r1 = 0, r2 = 0, mycnt = 0;
    for (int n = 0; n < own; ++n) { const unsigned long long mk = __ballot(i0 == n || i1 == n || i2 == n);
        const int rk = (int)__builtin_amdgcn_mbcnt_hi((unsigned)(mk >> 32), __builtin_amdgcn_mbcnt_lo((unsigned)mk, 0u));
        if (i0 == n) r0 = rk; if (i1 == n) r1 = rk; if (i2 == n) r2 = rk; if (lane == n) mycnt = __builtin_popcountll(mk); }
    unsigned base = 0u;
    if (lane < own && mycnt > 0) base = __hip_atomic_fetch_add(mcnt + bh * 32 + lane, (unsigned)mycnt, __ATOMIC_RELAXED, __HIP_MEMORY_SCOPE_AGENT);
    const unsigned b0 = (unsigned)bperm((int)base, i0 & 63), b1 = (unsigned)bperm((int)base, i1 & 63), b2 = (unsigned)bperm((int)base, i2 & 63);
    if (i0 >= 0) *(GAS unsigned*)(ment + ((size_t)bh * 32 + i0) * 8192 + b0 + r0) = (unsigned)q | (0u << 13);
    if (i1 >= 0) *(GAS unsigned*)(ment + ((size_t)bh * 32 + i1) * 8192 + b1 + r1) = (unsigned)q | (1u << 13);
    if (i2 >= 0) *(GAS unsigned*)(ment + ((size_t)bh * 32 + i2) * 8192 + b2 + r2) = (unsigned)q | (2u << 13);
    __syncthreads();
}
template <bool GATHER>
DI void moba_part_unit(LAS unsigned char* lds, int bh, int blk, const unsigned* ent, int e0, int ecnt, const bf16_t* MQ, const bf16_t* MK, const bf16_t* PROJ, f32x2* PM, bf16_t* PO,
                       bool pre_in, unsigned& ew_io, bf16x8 (&qf_io)[4], const unsigned* ent_nx, int e0_nx, int ecnt_nx, int bh_nx) {
    constexpr int NKS = 4, KBYTES = 8192, VBYTES = 8192;
    constexpr int OFF_K0 = 0, OFF_K1 = KBYTES, OFF_V0 = 2 * KBYTES, OFF_V1 = 2 * KBYTES + VBYTES;
    int tid_o = threadIdx.x; asm volatile("" : "+v"(tid_o));
    const int tid = tid_o, lane = tid & 63, r32 = lane & 31, hi = lane >> 5; const int wid = __builtin_amdgcn_readfirstlane(tid >> 6);
    const int b = bh >> 3, h = bh & 7; const size_t rb = (size_t)b * SEQ;
    int myq, slot; bool valid = true;
    if constexpr (GATHER) { const int ei = e0 + wid * 32 + r32; valid = ei < ecnt; const unsigned ew = pre_in ? ew_io : *(const GAS unsigned*)(ent + (valid ? ei : e0)); myq = (int)(ew & 8191u); slot = (int)(ew >> 13); }
    else { myq = blk * 256 + wid * 32 + r32; slot = 3; }
    bf16x8 qf[NKS];
    if (GATHER && pre_in) {
#pragma unroll
      for (int ks = 0; ks < NKS; ++ks) qf[ks] = qf_io[ks];
    } else { const bf16_t* qrow = MQ + (rb + myq) * 512 + h * 64 + hi * 8;
#pragma unroll
      for (int ks = 0; ks < NKS; ++ks) qf[ks] = *(const GAS bf16x8*)(qrow + ks * 16); }
    unsigned ew_nx = 0u;
    const bf16_t* Kp = MK + (rb + (size_t)blk * 256) * 512 + h * 64; const bf16_t* Vp = PROJ + (rb + (size_t)blk * 256) * NPROJP + 1696 + h * 64;
    const bf16_t* kg0 = Kp + (size_t)lane * 512 + wid * 8;
    const int vrow = tid >> 3, vpc = tid & 7;
    const bf16_t* vg = Vp + (size_t)vrow * NPROJP + vpc * 8;
    const int kdst0 = wid * 1024 + lane * 16, vdst = (vpc >> 2) * 4096 + vrow * 64 + (vpc & 3) * 16;
    u32x4 sk0, sv;
    sk0 = *(const u32x4*)kg0; sv = *(const u32x4*)vg;
    *(LAS u32x4*)(lds + OFF_K0 + kdst0) = sk0; *(LAS u32x4*)(lds + OFF_V0 + vdst) = sv;
    float m = -1e30f, l = 0.f; f32x16 ot[2]; ot[0] = f32x16{}; ot[1] = f32x16{};
    const int qrel = wid * 32 + r32;
    const int vq = (lane & 15) >> 2, vp = lane & 3, vblk = (lane >> 4) & 1;
    const int vbase = (4 * hi + vq) * 64 + vblk * 32 + vp * 8;
#pragma unroll
    for (int t = 0; t < 4; ++t) {
        __syncthreads();
        const int cur = t & 1; const bool more = (t + 1 < 4);
        if (more) { const size_t ro = (size_t)(t + 1) * 64; sk0 = *(const u32x4*)(kg0 + ro * 512); sv = *(const u32x4*)(vg + ro * NPROJP); }
        if constexpr (GATHER) {
            if (t == 0) { const int ein = e0_nx + wid * 32 + r32; ew_nx = *(const GAS unsigned*)(ent_nx + (ein < ecnt_nx ? ein : e0_nx)); }
            if (t == 2) { const bf16_t* qn = MQ + ((size_t)(bh_nx >> 3) * SEQ + (ew_nx & 8191u)) * 512 + (bh_nx & 7) * 64 + hi * 8;
#pragma unroll
                for (int ks = 0; ks < NKS; ++ks) qf_io[ks] = *(const GAS bf16x8*)(qn + ks * 16);
                ew_io = ew_nx; }
        }
        const LAS unsigned char* Kb = lds + (cur ? OFF_K1 : OFF_K0); const LAS unsigned char* Vb = lds + (cur ? OFF_V1 : OFF_V0);
        bool active = true;
        if (!GATHER) { if (64 * t > wid * 32 + 31) active = false; }
        if (active) {
            f32x16 s0 = f32x16{}, s1 = f32x16{};
#pragma unroll
            for (int ks = 0; ks < NKS; ++ks) {
                const bf16x8 ka = *(const LAS bf16x8*)(Kb + (2 * ks + hi) * 1024 + r32 * 16), kb = *(const LAS bf16x8*)(Kb + (2 * ks + hi) * 1024 + (32 + r32) * 16);
                s0 = MFMA32(ka, qf[ks], s0); s1 = MFMA32(kb, qf[ks], s1); }
            if (!GATHER) { if (64 * t + 63 > wid * 32) { const int kb0 = 64 * t + 4 * hi;
#pragma unroll
                for (int r = 0; r < 16; ++r) { const int kv = kb0 + (r & 3) + 8 * (r >> 2); if (kv > qrel) s0[r] = -INFINITY; if (kv + 32 > qrel) s1[r] = -INFINITY; } } }
            float tm = s0[0];
#pragma unroll
            for (int r = 1; r < 16; ++r) tm = fmaxf(tm, s0[r]);
#pragma unroll
            for (int r = 0; r < 16; ++r) tm = fmaxf(tm, s1[r]);
            tm = xmax32(tm);
            const float mn = fmaxf(m, tm);
            if (__any(tm > m + ATTN_THR)) {
            const float alpha = __builtin_amdgcn_exp2f(m - mn); l *= alpha;
#pragma unroll
                for (int r = 0; r < 16; ++r) { ot[0][r] *= alpha; ot[1][r] *= alpha; }
                m = mn; }
            float ls = 0.f;
#pragma unroll
            for (int r = 0; r < 16; ++r) { s0[r] = __builtin_amdgcn_exp2f(s0[r] - m); s1[r] = __builtin_amdgcn_exp2f(s1[r] - m); ls += s0[r] + s1[r]; }
            l += ls;
            bf16x8 pf[4];
#pragma unroll
            for (int s = 0; s < 4; ++s) { u32x4 w;
                if (s < 2) { w.x = cvt_pk_bf16(s0[8 * s], s0[8 * s + 1]); w.y = cvt_pk_bf16(s0[8 * s + 2], s0[8 * s + 3]); w.z = cvt_pk_bf16(s0[8 * s + 4], s0[8 * s + 5]); w.w = cvt_pk_bf16(s0[8 * s + 6], s0[8 * s + 7]); }
                else { const int q = s - 2; w.x = cvt_pk_bf16(s1[8 * q], s1[8 * q + 1]); w.y = cvt_pk_bf16(s1[8 * q + 2], s1[8 * q + 3]); w.z = cvt_pk_bf16(s1[8 * q + 4], s1[8 * q + 5]); w.w = cvt_pk_bf16(s1[8 * q + 6], s1[8 * q + 7]); }
                pf[s] = __builtin_bit_cast(bf16x8, w); }
#pragma unroll
            for (int db = 0; db < 2; ++db)
#pragma unroll
                for (int s = 0; s < 4; ++s) { const LAS char* vpn = (const LAS char*)Vb + db * 4096 + s * 1024 + vbase;
                    const s16x4 lo = vtr(vpn), hi4 = vtr(vpn + 512);
                    const bf16x8 vf = (bf16x8){lo[0], lo[1], lo[2], lo[3], hi4[0], hi4[1], hi4[2], hi4[3]};
                    ot[db] = MFMA32(vf, pf[s], ot[db]); }
        }
        if (more) { const int nb = cur ^ 1; *(LAS u32x4*)(lds + (nb ? OFF_K1 : OFF_K0) + kdst0) = sk0; *(LAS u32x4*)(lds + (nb ? OFF_V1 : OFF_V0) + vdst) = sv; }
    }
    l = xsum32(l);
    const float rl = 1.f / l;
    if (valid) { const size_t pi = ((size_t)bh * SEQ + myq) * 4 + slot;
        if (hi == 0) PM[pi] = (f32x2){m, l};
        bf16_t* orow = PO + pi * 64;
#pragma unroll
        for (int db = 0; db < 2; ++db)
#pragma unroll
            for (int g = 0; g < 4; ++g) { u32x2 w; w.x = cvt_pk_bf16(ot[db][4 * g] * rl, ot[db][4 * g + 1] * rl); w.y = cvt_pk_bf16(ot[db][4 * g + 2] * rl, ot[db][4 * g + 3] * rl);
                *(u32x2*)(orow + 32 * db + 8 * g + 4 * hi) = w; } }
    __syncthreads();
}
DI void moba_merge(int gi8, const unsigned* msel, const f32x2* PM, const bf16_t* PO, bf16_t* OB) {
    const int gi = gi8 >> 3, k = gi8 & 7;
    const int bh = gi >> 13, q = gi & 8191, b = bh >> 3, h = bh & 7;
    const size_t pi = (size_t)gi * 4;
    const unsigned ms = (unsigned)ldg_i(msel + gi);
    f32x2 ml[4]; u32x4 po[4];
#pragma unroll
    for (int j = 0; j < 4; ++j) { ml[j] = *(const GAS f32x2*)(PM + pi + j); po[j] = ldg_u4(PO + (pi + j) * 64 + 8 * k); }
    const int nsel = (int)(ms >> 24) & 3;
    float mj[4], wj[4]; float M = -1e30f;
#pragma unroll
    for (int j = 0; j < 4; ++j) { const bool use = (j == 3) || (j < nsel); mj[j] = use ? ml[j].x : -1e30f; wj[j] = use ? ml[j].y : 0.f; M = fmaxf(M, mj[j]); }
    float ws_ = 0.f;
#pragma unroll
    for (int j = 0; j < 4; ++j) { wj[j] = (wj[j] > 0.f) ? wj[j] * __builtin_amdgcn_exp2f(mj[j] - M) : 0.f; ws_ += wj[j]; }
    const float rinv = 1.f / ws_;
    float acc[8] = {0.f, 0.f, 0.f, 0.f, 0.f, 0.f, 0.f, 0.f};
#pragma unroll
    for (int j = 0; j < 4; ++j) { const bool on = wj[j] > 0.f; const float f = wj[j] * rinv; const u32x4 w = po[j];
        acc[0] += on ? f * bf_lo(w.x) : 0.f; acc[1] += on ? f * bf_hi(w.x) : 0.f; acc[2] += on ? f * bf_lo(w.y) : 0.f; acc[3] += on ? f * bf_hi(w.y) : 0.f;
        acc[4] += on ? f * bf_lo(w.z) : 0.f; acc[5] += on ? f * bf_hi(w.z) : 0.f; acc[6] += on ? f * bf_lo(w.w) : 0.f; acc[7] += on ? f * bf_hi(w.w) : 0.f; }
    u32x4 o; o.x = cvt_pk_bf16(acc[0], acc[1]); o.y = cvt_pk_bf16(acc[2], acc[3]); o.z = cvt_pk_bf16(acc[4], acc[5]); o.w = cvt_pk_bf16(acc[6], acc[7]);
    stg_u4(OB + ((size_t)b * SEQ + q) * 1024 + 512 + h * 64 + 8 * k, o);
}

DI float naive_attn_sample(int smp, int mode, const bf16_t* QM, const bf16_t* KM, const bf16_t* VM, const bf16_t* MQ, const bf16_t* MK, const bf16_t* PROJ, const float* kpart, const bf16_t* OB, int lane) {
    const int b = smp & 1, h = (smp >> 1) & 7, qi = smp >> 4;
    const int special[24] = {0, 1, 31, 32, 63, 64, 127, 128, 255, 256, 257, 319, 320, 511, 512, 767, 768, 1023, 1024, 4095, 4096, 4097, 8190, 8191};
    int q = 0;
#pragma unroll
    for (int i = 0; i < 24; ++i) if (qi == i) q = special[i];
    if (qi >= 24) { unsigned x = (unsigned)qi * 2654435761u; x ^= x >> 15; q = (int)(x % 8192u); }
    const size_t rb = (size_t)b * SEQ; const int own = q >> 8;
    const int DKn = (mode == 1) ? 96 : 64;
    const bf16_t* qp = (mode == 1) ? QM + (rb + q) * 768 + h * 96 : MQ + (rb + q) * 512 + h * 64;
    float m = -1e30f, sum = 0.f; float acc[64];
#pragma unroll
    for (int d = 0; d < 64; ++d) acc[d] = 0.f;
    unsigned selmask = 0u;
    if (mode == 2 && own > 0) {
        float g = -INFINITY;
        if (lane < own) { g = 0.f; const float* kp = kpart + (size_t)b * 32 * 4 * 512 + (size_t)lane * 4 * 512 + h * 64;
            for (int d = 0; d < 64; ++d) g += bf1(qp[d]) * ((kp[d] + kp[512 + d] + kp[1024 + d] + kp[1536 + d]) * (1.f / 256.f)); }
        for (int r = 0; r < 3 && r < own; ++r) { const float mx = wave_max_all(g); const unsigned long long bm = __ballot(g == mx); const int w = __builtin_ctzll(bm); selmask |= 1u << w; if (lane == w) g = -INFINITY; }
    }
    const int nkeys = q + 1;
    for (int k0 = 0; k0 < nkeys; k0 += 64) { const int key = k0 + lane; bool use = key < nkeys;
        if (mode == 2) { const int kb = key >> 8; use = use && (kb == own || ((selmask >> kb) & 1u)); }
        const unsigned long long any = __ballot(use);
        if (!any) continue;
        if (use) { float sc = 0.f;
            const bf16_t* kp = (mode == 1) ? KM + (rb + key) * 768 + h * 96 : MK + (rb + key) * 512 + h * 64;
            for (int d = 0; d < DKn; ++d) sc += bf1(qp[d]) * bf1(kp[d]);
            const bf16_t* vp = (mode == 1) ? VM + (rb + key) * 512 + h * 64 : PROJ + (rb + key) * NPROJP + 1696 + h * 64;
            const float mn = fmaxf(m, sc), al = __builtin_amdgcn_exp2f(m - mn), pp = __builtin_amdgcn_exp2f(sc - mn);
            sum = sum * al + pp;
#pragma unroll
            for (int d = 0; d < 64; ++d) acc[d] = acc[d] * al + pp * bf1(vp[d]);
            m = mn; } }
    const float M = wave_max_all(m), f = __builtin_amdgcn_exp2f(m - M);
    const float tot = wave_sum(sum * f);
    float dmax = 0.f;
    const bf16_t* op = OB + (rb + q) * 1024 + ((mode == 1) ? h * 64 : 512 + h * 64);
#pragma unroll
    for (int d = 0; d < 64; ++d) { const float o = wave_sum(acc[d] * f) / tot; const float df = fabsf(o - bf1(op[d])); dmax = (df == df) ? fmaxf(dmax, df) : 1e30f; }
    return dmax;
}

DI void dwconv_unit(LAS unsigned char* lds, int unit, const bf16_t* ug, const float (&w)[31][2], float b0, float b1, float g0, float g1, float be0, float be1, bf16_t* y, int tid) {
    const int row0 = unit * 16, tb = row0 % SEQ;
    for (int c = tid; c < 46 * 128; c += NTHR) { const int r = c >> 7, pc = c & 127; const int trel = tb - 30 + r;
        u32x4 v = (u32x4){0u, 0u, 0u, 0u};
        if (trel >= 0) v = *(const u32x4*)(ug + (size_t)(row0 - 30 + r) * DM + pc * 8);
        *(LAS u32x4*)(lds + r * 2048 + pc * 16) = v; }
    __syncthreads();
    unsigned xs[46];
#pragma unroll
    for (int r = 0; r < 46; ++r) xs[r] = *(const LAS unsigned*)(lds + r * 2048 + tid * 4);
    float a0[16], a1[16];
#pragma unroll
    for (int i = 0; i < 16; ++i) { float s0 = b0, s1 = b1;
#pragma unroll
        for (int j = 0; j < 31; ++j) { s0 += w[j][0] * bf_lo(xs[i + j]); s1 += w[j][1] * bf_hi(xs[i + j]); }
        a0[i] = s0; a1[i] = s1; }
    __syncthreads();
    LAS float* red = (LAS float*)lds;
    const int lane = tid & 63, wave = tid >> 6;
#pragma unroll
    for (int i = 0; i < 16; ++i) { const float s = wave_sum(a0[i] + a1[i]), q = wave_sum(a0[i] * a0[i] + a1[i] * a1[i]);
        if (lane == 0) { red[wave * 32 + i] = s; red[wave * 32 + 16 + i] = q; } }
    __syncthreads();
    if (tid < 32) { float t = 0.f;
#pragma unroll
        for (int wv = 0; wv < 8; ++wv) t += red[wv * 32 + tid];
        red[256 + tid] = t; }
    __syncthreads();
#pragma unroll
    for (int i = 0; i < 16; ++i) { const float s = red[256 + i], q = red[256 + 16 + i];
        const float mean = s * (1.f / DM), var = fmaxf(q * (1.f / DM) - mean * mean, 0.f), rstd = rsqrtf(var + NORM_EPS);
        const float z0 = (a0[i] - mean) * rstd * g0 + be0, z1 = (a1[i] - mean) * rstd * g1 + be1;
        const float o0 = z0 / (1.f + __expf(-z0)), o1 = z1 / (1.f + __expf(-z1));
        *(unsigned*)(y + (size_t)(row0 + i) * DM + 2 * tid) = cvt_pk_bf16(o0, o1); }
    __syncthreads();
}

#define CE_DESC(a, b) do { const float _h = fmaxf((a), (b)), _l = fminf((a), (b)); (a) = _h; (b) = _l; } while (0)
DI void sort16_desc(float (&a)[16]) {
#pragma unroll
    for (int p = 1; p < 16; p <<= 1)
#pragma unroll
        for (int k = p; k >= 1; k >>= 1)
#pragma unroll
            for (int j = k % p; j <= 15 - k; j += 2 * k)
#pragma unroll
                for (int i = 0; i <= (k - 1 < 15 - j - k ? k - 1 : 15 - j - k); ++i)
                    if ((i + j) / (2 * p) == (i + j + k) / (2 * p)) CE_DESC(a[i + j], a[i + j + k]);
}
DI void merge16_desc(float (&a)[16], const float (&b)[16]) {
#pragma unroll
    for (int i = 0; i < 16; ++i) a[i] = fmaxf(a[i], b[15 - i]);
#pragma unroll
    for (int j = 8; j > 0; j >>= 1)
#pragma unroll
        for (int i = 0; i < 16; ++i) { const int p = i ^ j; if (p > i) CE_DESC(a[i], a[p]); }
}
DI void top16_of_64(float (&g0)[16], float (&g1)[16], float (&g2)[16], float (&g3)[16]) {
    sort16_desc(g0); sort16_desc(g1); sort16_desc(g2); sort16_desc(g3);
    merge16_desc(g0, g1); merge16_desc(g2, g3); merge16_desc(g0, g2);
}
DI float pack_key(float v, unsigned code, unsigned mask) { return __builtin_bit_cast(float, (__builtin_bit_cast(unsigned, v) & ~mask) | code); }

DI void peer_topk_unit(const LAS unsigned char* sk, LAS unsigned* dec  , const bf16_t* q2, int tile, int h, int* idx, float* gate, int lane) {
    const int r32 = lane & 31, hi = lane >> 5; const int tok = tile * 32 + r32;
    float L[2][16];
#pragma unroll
    for (int c = 0; c < 2; ++c) {
        bf16x8 qf[8];
        const bf16_t* qrow = q2 + (size_t)tok * 2048 + (h * 2 + c) * 128 + hi * 8;
#pragma unroll
        for (int ks = 0; ks < 8; ++ks) qf[ks] = *(const bf16x8*)(qrow + ks * 16);
        f32x16 acc[4];
#pragma unroll
        for (int kt = 0; kt < 4; ++kt) { acc[kt] = f32x16{};
#pragma unroll
            for (int ks = 0; ks < 8; ++ks) { const bf16x8 a = *(const LAS bf16x8*)(sk + c * 32768 + (2 * ks + hi) * 2048 + (32 * kt + r32) * 16); acc[kt] = MFMA32(a, qf[ks], acc[kt]); } }
        float g[4][16];
#pragma unroll
        for (int kt = 0; kt < 4; ++kt)
#pragma unroll
            for (int r = 0; r < 16; ++r) { const int key = 32 * kt + (r & 3) + 8 * (r >> 2) + 4 * hi; float sc_ = acc[kt][r]; if (DBG_PEER_NOISE > 0.f) sc_ += DBG_PEER_NOISE * 1.7320508f * hash_noise((unsigned)(((tok * 8 + h) * 2 + c) * 128 + key));
                g[kt][r] = pack_key(sc_, 127u - (unsigned)key, 127u); }
        top16_of_64(g[0], g[1], g[2], g[3]);
        float other[16];
#pragma unroll
        for (int i = 0; i < 16; ++i) other[i] = xchg32(g[0][i], lane < 32);
        merge16_desc(g[0], other);
#pragma unroll
        for (int i = 0; i < 16; ++i) L[c][i] = g[0][i];
    }
#pragma unroll
    for (int c = 0; c < 2; ++c)
#pragma unroll
        for (int q = 0; q < 4; ++q) { unsigned w = 0u;
#pragma unroll
            for (int e = 0; e < 4; ++e) w |= (127u - (__builtin_bit_cast(unsigned, L[c][4 * q + e]) & 127u)) << (8 * e);
            dec[(c * 4 + q) * 64 + lane] = w; }
    const float PAD = -3.0e38f;
    float c0[16], c1[16], c2[16], c3[16];
#define CAND(i, j) pack_key(L[0][i] + L[1][j], 255u - (unsigned)(16 * (i) + (j)), 255u)
#pragma unroll
    for (int j = 0; j < 16; ++j) c0[j] = CAND(0, j);
#pragma unroll
    for (int j = 0; j < 8; ++j) c1[j] = CAND(1, j);
#pragma unroll
    for (int j = 0; j < 5; ++j) c1[8 + j] = CAND(2, j);
    c1[13] = PAD; c1[14] = PAD; c1[15] = PAD;
#pragma unroll
    for (int j = 0; j < 4; ++j) c2[j] = CAND(3, j);
#pragma unroll
    for (int j = 0; j < 3; ++j) c2[4 + j] = CAND(4, j);
    c2[7] = CAND(5, 0); c2[8] = CAND(5, 1); c2[9] = CAND(6, 0); c2[10] = CAND(6, 1); c2[11] = CAND(7, 0); c2[12] = CAND(7, 1);
    c2[13] = PAD; c2[14] = PAD; c2[15] = PAD;
#pragma unroll
    for (int i = 0; i < 8; ++i) { c3[i] = CAND(8 + i, 0); c3[8 + i] = PAD; }
#undef CAND
    sort16_desc(c1); sort16_desc(c2);
    merge16_desc(c0, c1); merge16_desc(c2, c3); merge16_desc(c0, c2);
    float e[16], sum = 0.f;
#pragma unroll
    for (int k = 0; k < 16; ++k) { e[k] = __builtin_amdgcn_exp2f((c0[k] - c0[0]) * LOG2E); sum += e[k]; }
    const float rs = 1.f / sum;
    LDS_WAIT();
    int ids[16];
#pragma unroll
    for (int k = 0; k < 16; ++k) { const unsigned code = 255u - (__builtin_bit_cast(unsigned, c0[k]) & 255u); const unsigned i = code >> 4, j = code & 15u;
        const unsigned w1 = dec[(i >> 2) * 64 + lane], w2 = dec[(4 + (j >> 2)) * 64 + lane];
        ids[k] = (int)(((w1 >> (8 * (i & 3))) & 127u) * 128u + ((w2 >> (8 * (j & 3))) & 127u)); }
    if (hi == 0) {
        int* ip = idx + (size_t)tok * 128 + h * 16; float* gp = gate + (size_t)tok * 128 + h * 16;
#pragma unroll
        for (int q = 0; q < 4; ++q) { *(int4*)(ip + 4 * q) = make_int4(ids[4 * q], ids[4 * q + 1], ids[4 * q + 2], ids[4 * q + 3]);
            *(f32x4*)(gp + 4 * q) = (f32x4){e[4 * q] * rs, e[4 * q + 1] * rs, e[4 * q + 2] * rs, e[4 * q + 3] * rs}; }
    }
    LDS_WAIT();
}

DI int wave_red63_i(int v) {
    v += __builtin_amdgcn_update_dpp(0, v, 0xB1, 0xF, 0xF, false);
    v += __builtin_amdgcn_update_dpp(0, v, 0x4E, 0xF, 0xF, false);
    v += __builtin_amdgcn_update_dpp(0, v, 0x141, 0xF, 0xF, false);
    v += __builtin_amdgcn_update_dpp(0, v, 0x140, 0xF, 0xF, false);
    v += __builtin_amdgcn_update_dpp(0, v, 0x142, 0xA, 0xF, false);
    v += __builtin_amdgcn_update_dpp(0, v, 0x143, 0xC, 0xF, false);
    return __builtin_amdgcn_readlane(v, 63);
}
template <int NR>
DI void quant_rows(const float* src, unsigned char* dst, float* scale_out, int off, int lane, bool colslice, int erow) {
    f32x4 v[NR][4];
#pragma unroll
    for (int r = 0; r < NR; ++r)
#pragma unroll
        for (int q = 0; q < 4; ++q) v[r][q] = __builtin_nontemporal_load((const GAS f32x4*)(src + (size_t)r * 1024 + 256 * q + 4 * lane));
#pragma unroll
    for (int r = 0; r < NR; ++r) {
        float am = 0.f;
#pragma unroll
        for (int q = 0; q < 4; ++q)
#pragma unroll
            for (int e = 0; e < 4; ++e) am = fmaxf(am, fabsf(v[r][q][e]));
        am = wave_max_all(am);
        const float inv = am > 0.f ? 127.f / am : 0.f;
#pragma unroll
        for (int q = 0; q < 4; ++q) { const unsigned o = pack4_i8(v[r][q][0], v[r][q][1], v[r][q][2], v[r][q][3], inv, off);
            if (colslice) *(GAS unsigned*)(dst + ((size_t)(2 * q + (lane >> 5)) * 16384 + (size_t)(erow + r)) * 128 + 4 * (lane & 31)) = o;
            else *(GAS unsigned*)(dst + (size_t)r * 1024 + 256 * q + 4 * lane) = o; }
        if (lane == 0) scale_out[r] = am * (1.f / 127.f);
    }
}

DI void peer_build_lists(int tok0, const int* idx, unsigned* ent, unsigned* cnt, volatile LAS unsigned* wtot, int wave, int lane, const float* hrows, const float* gain, unsigned char* xq, float* sx) {
    int id0[8], id1[8], r0[8], r1[8], c0s[8], c1s[8], st[8]; int tot = 0;
#pragma unroll
    for (int i = 0; i < 8; ++i) { id0[i] = ldg_i(idx + (size_t)(tok0 + i) * 128 + lane); id1[i] = ldg_i(idx + (size_t)(tok0 + i) * 128 + 64 + lane); }
#pragma unroll
    for (int i = 0; i < 8; ++i) { const int x0 = id0[i] >> 11, x1 = id1[i] >> 11; r0[i] = 0; r1[i] = 0; c0s[i] = 0; c1s[i] = 0; st[i] = tot;
#pragma unroll
        for (int x = 0; x < 8; ++x) { const unsigned long long m0 = __ballot(x0 == x), m1 = __ballot(x1 == x);
            const int c0 = __builtin_popcountll(m0), c1 = __builtin_popcountll(m1);
            const int b0 = (int)__builtin_amdgcn_mbcnt_hi((unsigned)(m0 >> 32), __builtin_amdgcn_mbcnt_lo((unsigned)m0, 0u));
            const int b1 = (int)__builtin_amdgcn_mbcnt_hi((unsigned)(m1 >> 32), __builtin_amdgcn_mbcnt_lo((unsigned)m1, 0u));
            if (x0 == x) { r0[i] = b0; c0s[i] = c0 + c1; } if (x1 == x) { r1[i] = c0 + b1; c1s[i] = c0 + c1; } if (lane == x) tot += (c0 + c1 + 3) & ~3; } }
#pragma unroll 4
    for (int i = 0; i < 8; ++i) { const float* xr = hrows + (size_t)(tok0 + i) * DM; f32x4 v[4]; float sq = 0.f;
#pragma unroll
        for (int jj = 0; jj < 4; ++jj) { v[jj] = ldg_f4(xr + 4 * lane + 256 * jj); sq += (v[jj].x * v[jj].x + v[jj].y * v[jj].y) + (v[jj].z * v[jj].z + v[jj].w * v[jj].w); }
        const float r = rsqrtf(wave_sum(sq) * (1.f / DM) + NORM_EPS); float am = 0.f;
#pragma unroll
        for (int jj = 0; jj < 4; ++jj) { v[jj] = v[jj] * r * ldg_f4(gain + 4 * lane + 256 * jj); am = fmaxf(fmaxf(am, fabsf(v[jj].x)), fmaxf(fmaxf(fabsf(v[jj].y), fabsf(v[jj].z)), fabsf(v[jj].w))); }
        am = wave_max_all(am); const float inv = am > 0.f ? 127.f / am : 0.f;
#pragma unroll
        for (int jj = 0; jj < 4; ++jj) *(GAS unsigned*)(xq + (size_t)(tok0 + i) * 1024 + 4 * lane + 256 * jj) = pack4_i8(v[jj].x, v[jj].y, v[jj].z, v[jj].w, inv, 0);
        if (lane == 0) sx[tok0 + i] = am * (1.f / 127.f); }
    unsigned base = 0u;
    if (lane < 8) wtot[wave * 8 + lane] = (unsigned)tot;
    __syncthreads();
    if (wave == 0 && lane < 8) { unsigned sum = 0u;
#pragma unroll
        for (int w = 0; w < NWAVES; ++w) sum += wtot[w * 8 + lane];
        wtot[64 + lane] = __hip_atomic_fetch_add(cnt + lane * 64, sum, __ATOMIC_RELAXED, __HIP_MEMORY_SCOPE_AGENT); }
    __syncthreads();
    if (lane < 8) { base = wtot[64 + lane];
        for (int w = 0; w < wave; ++w) base += wtot[w * 8 + lane]; }
    __syncthreads();
#pragma unroll
    for (int i = 0; i < 8; ++i) { const int x0 = id0[i] >> 11, x1 = id1[i] >> 11; const int bs = (int)base + st[i];
        const unsigned g0 = (unsigned)bperm(bs, x0), g1 = (unsigned)bperm(bs, x1);
        const unsigned w0 = ((unsigned)(tok0 + i) << 18) | ((unsigned)lane << 11) | ((unsigned)id0[i] & 2047u), w1 = ((unsigned)(tok0 + i) << 18) | ((unsigned)(64 + lane) << 11) | ((unsigned)id1[i] & 2047u);
        GAS unsigned* e0 = (GAS unsigned*)(ent + (size_t)x0 * ENT_CAP + g0); GAS unsigned* e1 = (GAS unsigned*)(ent + (size_t)x1 * ENT_CAP + g1);
        e0[r0[i]] = w0; e1[r1[i]] = w1;
        { const int c = c0s[i], np = ((c + 3) & ~3) - c; for (int k = r0[i]; k < np; k += c) e0[c + k] = w0; }
        { const int c = c1s[i], np = ((c + 3) & ~3) - c; for (int k = r1[i]; k < np; k += c) e1[c + k] = w1; } }
}
DI int xsum16_32_i(int v) {
    auto a = __builtin_amdgcn_permlane16_swap((unsigned)v, (unsigned)v, false, false); const unsigned a0 = a[0], a1 = a[1];
    v = (int)a0 + (int)a1;
    auto b = __builtin_amdgcn_permlane32_swap((unsigned)v, (unsigned)v, false, false); const unsigned b0 = b[0], b1 = b[1];
    return (int)b0 + (int)b1;
}
DI void peer_u_slice(const unsigned* ent, int e_lo, int e_hi, const unsigned char* U8s, const float* sus, const float* svs, const float* gate, const unsigned char* XQ, const float* SX, float* WV, int lane_in) {
    int lane = lane_in; asm volatile("" : "+v"(lane));
    const __amdgpu_buffer_rsrc_t urs = mk_rsrc(U8s), xrs = mk_rsrc(XQ);
    for (int sb = e_lo; sb < e_hi; sb += 64) {
        const int myi = sb + lane; const bool valid = myi < e_hi;
        const unsigned ew = valid ? *(const GAS unsigned*)(ent + myi) : 0u;
        const int mt = (int)(ew >> 18), me = (int)(ew & 2047u);
        const float sc = ldg_f(sus + me) * ldg_f(SX + mt);
        const float gsv = ldg_f(gate + (size_t)mt * 128 + ((ew >> 11) & 127u)) * ldg_f(svs + me);
        float res = 0.f;
        u32x4 Au[4], Bu[4], Ax, Bx; const bool b0 = lane & 1, b1 = lane & 2; const int lane16 = 16 * lane;
#define PU_LOAD(bu, bx, k) do { _Pragma("unroll") for (int i_ = 0; i_ < 4; ++i_) { const unsigned w_ = (unsigned)__builtin_amdgcn_readlane((int)ew, 4 * (k) + i_); \
            bu[i_] = ldb_u4s(urs, lane16, (int)((w_ & 2047u) << 10)); if (i_ == 0) bx = ldb_u4s(xrs, lane16, (int)((w_ >> 18) << 10)); } } while (0)
#define PU_COMP(bu, bx, k) do { int d_[4]; _Pragma("unroll") for (int i_ = 0; i_ < 4; ++i_) { int t_ = 0; \
            t_ = __builtin_amdgcn_sdot4((int)bu[i_].x, (int)bx.x, t_, false); t_ = __builtin_amdgcn_sdot4((int)bu[i_].y, (int)bx.y, t_, false); \
            t_ = __builtin_amdgcn_sdot4((int)bu[i_].z, (int)bx.z, t_, false); t_ = __builtin_amdgcn_sdot4((int)bu[i_].w, (int)bx.w, t_, false); d_[i_] = t_; } \
              \
            const int k01_ = b0 ? d_[1] : d_[0], s01_ = b0 ? d_[0] : d_[1], k23_ = b0 ? d_[3] : d_[2], s23_ = b0 ? d_[2] : d_[3]; \
            const int p01_ = k01_ + __builtin_amdgcn_update_dpp(0, s01_, 0xB1, 0xF, 0xF, false), p23_ = k23_ + __builtin_amdgcn_update_dpp(0, s23_, 0xB1, 0xF, 0xF, false); \
            const int kq_ = b1 ? p23_ : p01_, sq_ = b1 ? p01_ : p23_; \
            int v_ = kq_ + __builtin_amdgcn_update_dpp(0, sq_, 0x4E, 0xF, 0xF, false); \
            v_ += __builtin_amdgcn_update_dpp(0, v_, 0x124, 0xF, 0xF, false);     \
            v_ += __builtin_amdgcn_update_dpp(0, v_, 0x128, 0xF, 0xF, false);     \
            v_ = xsum16_32_i(v_); \
            if ((lane >> 2) == (k)) res = (float)v_; } while (0)
        PU_LOAD(Au, Ax, 0);
#pragma nounroll
        for (int k = 0; k < 16; k += 2) {
            PU_LOAD(Bu, Bx, k + 1);
            __builtin_amdgcn_sched_barrier(0);
            PU_COMP(Au, Ax, k);
            __builtin_amdgcn_sched_barrier(0);
            const int kn = (k + 2 < 16) ? k + 2 : 15;
            PU_LOAD(Au, Ax, kn);
            __builtin_amdgcn_sched_barrier(0);
            PU_COMP(Bu, Bx, k + 1);
            __builtin_amdgcn_sched_barrier(0);
        }
#undef PU_LOAD
#undef PU_COMP
        if (valid) { const float a_ = res * sc; *(GAS float*)(WV + (size_t)mt * 128 + ((ew >> 11) & 127u)) = gsv * 0.5f * a_ * (1.f + erff(a_ * 0.70710678118654752f)); }
    }
}
DI void ubfma4(float (&o)[16], int base, unsigned w, float wt) {
    o[base + 0] += wt * (float)(w & 255u); o[base + 1] += wt * (float)((w >> 8) & 255u); o[base + 2] += wt * (float)((w >> 16) & 255u); o[base + 3] += wt * (float)(w >> 24);
}
DI float xsum16_32(float v) {
    auto a = __builtin_amdgcn_permlane16_swap(__float_as_uint(v), __float_as_uint(v), false, false);
    const unsigned a0 = a[0], a1 = a[1];
    v = __uint_as_float(a0) + __uint_as_float(a1);
    auto b = __builtin_amdgcn_permlane32_swap(__float_as_uint(v), __float_as_uint(v), false, false);
    const unsigned b0 = b[0], b1 = b[1];
    return __uint_as_float(b0) + __uint_as_float(b1);
}
#define DPP_ADD(v, ctrl) ((v) + __builtin_bit_cast(float, __builtin_amdgcn_update_dpp(0, __builtin_bit_cast(int, (v)), (ctrl), 0xF, 0xF, false)))
DI float wave_sum_valu(float v) {
    v = DPP_ADD(v, 0xB1); v = DPP_ADD(v, 0x4E); v = DPP_ADD(v, 0x141); v = DPP_ADD(v, 0x140);
    return xsum16_32(v);
}
DI void tdot4(int (&acc)[16], int base, unsigned r0, unsigned r1, unsigned r2, unsigned r3, int P) {
    const unsigned t01l = __builtin_amdgcn_perm(r1, r0, 0x05010400u), t01h = __builtin_amdgcn_perm(r1, r0, 0x07030602u);
    const unsigned t23l = __builtin_amdgcn_perm(r3, r2, 0x05010400u), t23h = __builtin_amdgcn_perm(r3, r2, 0x07030602u);
    acc[base + 0] = __builtin_amdgcn_sdot4((int)__builtin_amdgcn_perm(t23l, t01l, 0x05040100u), P, acc[base + 0], false);
    acc[base + 1] = __builtin_amdgcn_sdot4((int)__builtin_amdgcn_perm(t23l, t01l, 0x07060302u), P, acc[base + 1], false);
    acc[base + 2] = __builtin_amdgcn_sdot4((int)__builtin_amdgcn_perm(t23h, t01h, 0x05040100u), P, acc[base + 2], false);
    acc[base + 3] = __builtin_amdgcn_sdot4((int)__builtin_amdgcn_perm(t23h, t01h, 0x07060302u), P, acc[base + 3], false);
}
DI void peer_v_cols(int x, int t0, int tstep, const int* IDX, const float* WV, const unsigned char* Vx, const float* hin, float* hout, bf16_t* hb, float* ss, int lane_in) {
    int lane = lane_in; asm volatile("" : "+v"(lane));
    const int j = lane >> 3, c = lane & 7;
    if (t0 >= TT) return;
    int a0, a1, b0 = 0, b1 = 0, n0 = 0, n1 = 0; float aw0, aw1, bw0 = 0.f, bw1 = 0.f, nw0 = 0.f, nw1 = 0.f;
    u32x4 RA[16], RB[16]; f32x2 H;
    const __amdgpu_buffer_rsrc_t vrs = mk_rsrc(Vx);
    const bool j0 = lane & 8, j1 = lane & 16, j2 = lane & 32;
    const int mycol = 128 * x + 16 * c + (j0 ? 8 : 0) + (j1 ? 4 : 0) + (j2 ? 2 : 0);
#define PV_IDX(t, i0, i1, w0, w1) do { i0 = ldg_i(IDX + (size_t)(t) * 128 + lane); i1 = ldg_i(IDX + (size_t)(t) * 128 + 64 + lane); w0 = ldg_f(WV + (size_t)(t) * 128 + lane); w1 = ldg_f(WV + (size_t)(t) * 128 + 64 + lane); } while (0)
#define PV_ROWS(R, i0, i1) do { _Pragma("unroll") for (int i_ = 0; i_ < 16; ++i_) { const int e_ = bperm(i_ < 8 ? i0 : i1, 32 * ((i_ >> 2) & 1) + 4 * j + (i_ & 3)); R[i_] = ldb_u4(vrs, e_ * 128 + 16 * c); } } while (0)
#define PV_HLD(t) do { H = *(const GAS f32x2*)(hin + (size_t)(t) * DM + mycol); } while (0)
#define PV_TOKEN(R, w0, w1, t) do { int acc[16]; _Pragma("unroll") for (int k_ = 0; k_ < 16; ++k_) acc[k_] = 0; \
        float wm = fmaxf(fabsf(w0), fabsf(w1)); \
        wm = fmaxf(wm, __builtin_bit_cast(float, __builtin_amdgcn_update_dpp(0, __builtin_bit_cast(int, wm), 0xB1, 0xF, 0xF, false))); \
        wm = fmaxf(wm, __builtin_bit_cast(float, __builtin_amdgcn_update_dpp(0, __builtin_bit_cast(int, wm), 0x4E, 0xF, 0xF, false))); \
        wm = fmaxf(wm, __builtin_bit_cast(float, __builtin_amdgcn_update_dpp(0, __builtin_bit_cast(int, wm), 0x141, 0xF, 0xF, false))); \
        wm = fmaxf(wm, __builtin_bit_cast(float, __builtin_amdgcn_update_dpp(0, __builtin_bit_cast(int, wm), 0x140, 0xF, 0xF, false))); \
        { auto pa_ = __builtin_amdgcn_permlane16_swap(__float_as_uint(wm), __float_as_uint(wm), false, false); const unsigned p0_ = pa_[0], p1_ = pa_[1]; wm = fmaxf(__uint_as_float(p0_), __uint_as_float(p1_)); \
          auto pb_ = __builtin_amdgcn_permlane32_swap(__float_as_uint(wm), __float_as_uint(wm), false, false); const unsigned q0_ = pb_[0], q1_ = pb_[1]; wm = fmaxf(__uint_as_float(q0_), __uint_as_float(q1_)); } \
        const float winv_ = wm > 0.f ? 127.f / wm : 0.f, wsc_ = wm * (1.f / 127.f); \
        const int qq0_ = __float2int_rn(w0 * winv_) & 255, qq1_ = __float2int_rn(w1 * winv_) & 255; \
        const int D0_ = __builtin_amdgcn_update_dpp(0, qq0_, 0x00, 0xF, 0xF, false) | (__builtin_amdgcn_update_dpp(0, qq0_, 0x55, 0xF, 0xF, false) << 8) | (__builtin_amdgcn_update_dpp(0, qq0_, 0xAA, 0xF, 0xF, false) << 16) | (__builtin_amdgcn_update_dpp(0, qq0_, 0xFF, 0xF, 0xF, false) << 24); \
        const int D1_ = __builtin_amdgcn_update_dpp(0, qq1_, 0x00, 0xF, 0xF, false) | (__builtin_amdgcn_update_dpp(0, qq1_, 0x55, 0xF, 0xF, false) << 8) | (__builtin_amdgcn_update_dpp(0, qq1_, 0xAA, 0xF, 0xF, false) << 16) | (__builtin_amdgcn_update_dpp(0, qq1_, 0xFF, 0xF, 0xF, false) << 24); \
        _Pragma("unroll") for (int g_ = 0; g_ < 4; ++g_) { const int P_ = bperm(g_ < 2 ? D0_ : D1_, 32 * (g_ & 1) + 4 * j); \
            tdot4(acc, 0, R[4 * g_].x, R[4 * g_ + 1].x, R[4 * g_ + 2].x, R[4 * g_ + 3].x, P_); tdot4(acc, 4, R[4 * g_].y, R[4 * g_ + 1].y, R[4 * g_ + 2].y, R[4 * g_ + 3].y, P_); \
            tdot4(acc, 8, R[4 * g_].z, R[4 * g_ + 1].z, R[4 * g_ + 2].z, R[4 * g_ + 3].z, P_); tdot4(acc, 12, R[4 * g_].w, R[4 * g_ + 1].w, R[4 * g_ + 2].w, R[4 * g_ + 3].w, P_); } \
          \
        int k8_[8]; _Pragma("unroll") for (int i_ = 0; i_ < 8; ++i_) { const int kp_ = j0 ? acc[8 + i_] : acc[i_], sd_ = j0 ? acc[i_] : acc[8 + i_]; k8_[i_] = kp_ + __builtin_amdgcn_update_dpp(0, sd_, 0x128, 0xF, 0xF, false); } \
        int k4_[4]; _Pragma("unroll") for (int i_ = 0; i_ < 4; ++i_) { const int kp_ = j1 ? k8_[4 + i_] : k8_[i_], sd_ = j1 ? k8_[i_] : k8_[4 + i_]; \
            auto sw_ = __builtin_amdgcn_permlane16_swap((unsigned)sd_, (unsigned)sd_, false, false); const unsigned e0_ = sw_[0], e1_ = sw_[1]; k4_[i_] = kp_ + (int)(j1 ? e0_ : e1_); } \
        int k2_[2]; _Pragma("unroll") for (int i_ = 0; i_ < 2; ++i_) { const int kp_ = j2 ? k4_[2 + i_] : k4_[i_], sd_ = j2 ? k4_[i_] : k4_[2 + i_]; \
            auto sw_ = __builtin_amdgcn_permlane32_swap((unsigned)sd_, (unsigned)sd_, false, false); const unsigned e0_ = sw_[0], e1_ = sw_[1]; k2_[i_] = kp_ + (int)(j2 ? e0_ : e1_); } \
        f32x2 hn_; hn_.x = H.x + (float)k2_[0] * wsc_; hn_.y = H.y + (float)k2_[1] * wsc_; \
        const float sq_ = wave_sum_valu(hn_.x * hn_.x + hn_.y * hn_.y); \
        { const size_t off_ = (size_t)(t) * DM + mycol; *(GAS f32x2*)(hout + off_) = hn_; *(GAS unsigned*)(hb + off_) = cvt_pk_bf16(hn_.x, hn_.y); \
          if (lane == 0) *(GAS float*)(ss + (size_t)(t) * 8 + x) = sq_; } } while (0)
#define PV_TC(tt) ((tt) < TT ? (tt) : t0)
    int t = t0;
    PV_IDX(t, a0, a1, aw0, aw1);
    PV_IDX(PV_TC(t + tstep), b0, b1, bw0, bw1);
    PV_ROWS(RA, a0, a1);
    PV_HLD(t);
#pragma nounroll
    for (; t < TT; t += 2 * tstep) {
        const int tB = t + tstep, tA2 = t + 2 * tstep, tB2 = t + 3 * tstep;
        PV_ROWS(RB, b0, b1);
        PV_IDX(PV_TC(tA2), n0, n1, nw0, nw1);
        __builtin_amdgcn_sched_barrier(0);
        PV_TOKEN(RA, aw0, aw1, t);
        __builtin_amdgcn_sched_barrier(0);
        PV_HLD(PV_TC(tB));
        a0 = n0; a1 = n1; aw0 = nw0; aw1 = nw1; PV_ROWS(RA, a0, a1);
        PV_IDX(PV_TC(tB2), n0, n1, nw0, nw1);
        __builtin_amdgcn_sched_barrier(0);
        if (tB < TT) PV_TOKEN(RB, bw0, bw1, tB);
        __builtin_amdgcn_sched_barrier(0);
        PV_HLD(PV_TC(tA2));
        b0 = n0; b1 = n1; bw0 = nw0; bw1 = nw1;
    }
#undef PV_TC
#undef PV_IDX
#undef PV_ROWS
#undef PV_HLD
#undef PV_TOKEN
}
DI void final_norm_row(int row, const float* h, const float* ss, const float* gain, float* out, int lane, float pscale, float poff) {
    const float r = row_rms_scale(ss, row);
#pragma unroll
    for (int q = 0; q < 4; ++q) { f32x4 v = ldg_f4(h + (size_t)row * DM + 4 * lane + 256 * q) * r * ldg_f4(gain + 4 * lane + 256 * q) * pscale;
        if (q == 0 && row == 0 && lane == 0) v[0] += poff; stg_f4(out + (size_t)row * DM + 4 * lane + 256 * q, v); }
}

#define PHASE_BEGIN() \
    int tid = threadIdx.x; asm volatile("" : "+v"(tid)); \
    const int lane = tid & 63; const int wave = __builtin_amdgcn_readfirstlane(tid >> 6); \
    unsigned char* ws = p.ws; asm volatile("" : "+s"(ws)); \
    const int gw = vcu * NWAVES + wave, NGW = G * NWAVES; (void)lane; (void)gw; (void)NGW
__global__ void __launch_bounds__(NTHR, 2) fwd_kernel(Params p) {
    extern __shared__ __attribute__((aligned(16))) unsigned char lds_raw[];
    LAS unsigned char* lds = (LAS unsigned char*)lds_raw;
    const int G = gridDim.x; int bx = blockIdx.x; int vcu = (G % 8 == 0) ? (bx % 8) * (G / 8) + bx / 8 : bx;
    bool xloc = false; unsigned xl_n = 1u, xl_gen = 0u;
    for (int u = threadIdx.x; u < (LDS_BYTES - RING_BYTES) / 4; u += NTHR) ((LAS unsigned*)(lds + RING_BYTES))[u] = 0u;
    __syncthreads();
    XcdBarrier bar; bar.bar = (unsigned*)(p.ws + WS_CTL) + CW_BAR; bar.x = 0; bar.st = nullptr;
    const int lo = p.ph_lo, hi = p.ph_hi;
    if ((hi - lo) > 1) bar = xcd_barrier_post((unsigned*)(p.ws + WS_CTL) + CW_BAR, (volatile LAS unsigned*)(lds + MISC_OFF) + 8);
    int ph = 0;
    if (PROBE_ON && blockIdx.x == 0 && threadIdx.x == 0) ((unsigned long long*)((unsigned*)(p.ws + WS_CTL) + CW_TS))[0] = __builtin_amdgcn_s_memrealtime();
#define IN(k) (lo <= (k) && (k) < hi)
#define SEAM() do { if (IN(ph) && IN(ph + 1)) xcd_barrier(bar); ++ph; \
    if (PROBE_ON && blockIdx.x == 0 && threadIdx.x == 0) ((unsigned long long*)((unsigned*)(p.ws + WS_CTL) + CW_TS))[ph] = __builtin_amdgcn_s_memrealtime(); } while (0)
#define SEAM_X() do { if (IN(ph) && IN(ph + 1)) { if (xloc) xcd_local_barrier(bar, xl_n, ++xl_gen); else xcd_barrier(bar); } ++ph; \
    if (PROBE_ON && blockIdx.x == 0 && threadIdx.x == 0) ((unsigned long long*)((unsigned*)(p.ws + WS_CTL) + CW_TS))[ph] = __builtin_amdgcn_s_memrealtime(); } while (0)

    if (PH_ON(0) && IN(ph)) {
        PHASE_BEGIN();
        LAS float* scr = (LAS float*)(lds + wave * 16384);
        constexpr int I_IN = 16 * 69, I_UQ = 6 * 24, I_UKV = 4 * 32, I_SQ = 16 * 32, I_CIN = 16 * 64, I_PQ = 16 * 64;
        constexpr int PER2 = I_IN + I_UQ + I_UKV + I_SQ + I_CIN + I_SQ;
        constexpr int NITEMS = 2 * PER2 + 4 * I_PQ;
        for (int it = gw; it < NITEMS; it += NGW) {
            if (it < 2 * PER2) { const int i = it / PER2; int r = it % PER2;
                if (r < I_IN) { transpose_item<0>(p.in[5] + (size_t)i * 1024 * NPROJ, 1024, NPROJ, (bf16_t*)(ws + WS_WIN) + (size_t)i * NPROJP * 1024, scr, r, lane, p.in[2] + (2 * i) * DM); continue; } r -= I_IN;
                if (r < I_UQ) { transpose_item<0>(p.in[7] + (size_t)i * 384 * 768, 384, 768, (bf16_t*)(ws + WS_WUQ) + (size_t)i * 768 * 384, scr, r, lane); continue; } r -= I_UQ;
                if (r < I_UKV) { transpose_item<0>(p.in[9] + (size_t)i * 256 * 1024, 256, 1024, (bf16_t*)(ws + WS_WUKV) + (size_t)i * 1024 * 256, scr, r, lane); continue; } r -= I_UKV;
                if (r < I_SQ) { transpose_item<0>(p.in[10] + (size_t)i * 1024 * 1024, 1024, 1024, (bf16_t*)(ws + WS_WOUT) + (size_t)i * 1024 * 1024, scr, r, lane); continue; } r -= I_SQ;
                if (r < I_CIN) { transpose_item<1>(p.in[11] + (size_t)i * 1024 * 2048, 1024, 2048, (bf16_t*)(ws + WS_WCIN) + (size_t)i * 2048 * 1024, scr, r, lane, p.in[2] + (2 * i + 1) * DM); continue; } r -= I_CIN;
                transpose_item<0>(p.in[17] + (size_t)i * 1024 * 1024, 1024, 1024, (bf16_t*)(ws + WS_WCOUT) + (size_t)i * 1024 * 1024, scr, r, lane);
            } else { const int r2 = it - 2 * PER2, l = r2 / I_PQ, r = r2 % I_PQ;
                transpose_item<0>(p.in[19] + (size_t)l * 1024 * 2048, 1024, 2048, (bf16_t*)(ws + WS_WPQ) + (size_t)l * 2048 * 1024, scr, r, lane, p.in[3] + l * DM); }
        }
        { const size_t gt = (size_t)vcu * NTHR + tid, NGT = (size_t)G * NTHR; const size_t n_sub = (size_t)4 * 8 * 2 * 128 * 128 / 8;
          for (size_t i = gt; i < n_sub; i += NGT) { const float* src = p.in[20]; bf16_t* dst = (bf16_t*)(ws + WS_SUBK);
              const f32x4 a = *(const f32x4*)(src + i * 8), b = *(const f32x4*)(src + i * 8 + 4);
              u32x4 o; o.x = cvt_pk_bf16(a[0], a[1]); o.y = cvt_pk_bf16(a[2], a[3]); o.z = cvt_pk_bf16(b[0], b[1]); o.w = cvt_pk_bf16(b[2], b[3]);
              *(u32x4*)(dst + i * 8) = o; } }
        for (int row = 4 * gw; row < 131072; row += 4 * NGW) {
            if (row < 65536) quant_rows<4>(p.in[21] + (size_t)row * 1024, ws + WS_U8 + (size_t)row * 1024, (float*)(ws + WS_SU) + row, 0, lane, false, 0);
            else { const int r2 = row - 65536; quant_rows<4>(p.in[22] + (size_t)r2 * 1024, ws + WS_V8 + (size_t)(r2 >> 14) * 16384 * 1024, (float*)(ws + WS_SV) + r2, 0, lane, true, r2 & 16383); }
        }
        { const int* positions = (const int*)p.in[1];
          float* cosr = (float*)(ws + WS_COSR); float* sinr = (float*)(ws + WS_SINR); float* cosm = (float*)(ws + WS_COSM); float* sinm = (float*)(ws + WS_SINM);
          const int gt = vcu * NTHR + tid, NGT = G * NTHR;
          for (int i = gt; i < TT * 8; i += NGT) { const int row = i & (TT - 1), kg = __builtin_amdgcn_readfirstlane(i >> 14); const double pos = (double)positions[row];
              for (int j = 0; j < 6; ++j) { const int k = kg * 6 + j; const double inv = (k < 16) ? p.inv_r[k & 15] : p.inv_m[(k - 16) & 31];
                  double rev = pos * inv * 0.15915494309189533577; rev -= floor(rev);
                  const float rf = (float)rev; const float c = __builtin_amdgcn_cosf(rf), sn = __builtin_amdgcn_sinf(rf);
                  if (k < 16) { cosr[row * 16 + k] = c; sinr[row * 16 + k] = sn; } else { cosm[row * 32 + (k - 16)] = c; sinm[row * 32 + (k - 16)] = sn; } } } }
        for (int m = gw; m < TT; m += NGW) { const float* xr = p.in[0] + (size_t)m * DM; bf16_t* hb = (bf16_t*)(ws + WS_HB) + (size_t)m * DM; float sq = 0.f;
#pragma unroll
            for (int j = 0; j < 4; ++j) { const f32x4 v = ldg_f4(xr + 4 * lane + 256 * j); sq += (v.x * v.x + v.y * v.y) + (v.z * v.z + v.w * v.w);
                u32x2 o; o.x = cvt_pk_bf16(v.x, v.y); o.y = cvt_pk_bf16(v.z, v.w); *(GAS u32x2*)(hb + 4 * lane + 256 * j) = o; }
            sq = wave_sum(sq); if (lane < 8) ((float*)(ws + WS_SS))[(size_t)m * 8 + lane] = (lane == 0) ? sq : 0.f; }
    }
    SEAM();
    if ((hi - lo) > 1 && IN(0) && IN(1)) {
        volatile LAS unsigned* st = (volatile LAS unsigned*)(lds + MISC_OFF) + 8;
        const unsigned nl = st[0], rk = st[2], un = st[3];
        if (un != 0u && (G % 8) == 0) { const int xcc = (int)bar.x; bx = (int)rk * 8 + xcc; vcu = xcc * (G / 8) + (int)rk; xloc = true; xl_n = nl; }
        bx = __builtin_amdgcn_readfirstlane(bx); vcu = __builtin_amdgcn_readfirstlane(vcu);
    }

    for (int layer = 0; layer < 4; ++layer) {
        const int li = layer >> 1;
        if ((layer & 1) == 0) {
            if (PH_ON(1) && IN(ph)) { PHASE_BEGIN();
                pg8::Gemm g{(const bf16_t*)(ws + WS_HB), (const bf16_t*)(ws + WS_WIN) + (size_t)li * NPROJP * 1024, TT, NPROJP, 1024}; pg8::StaticOrder S; S.init(TT, NPROJP, G, bx);
                EpiPlain E{(bf16_t*)(ws + WS_PROJ), NPROJP, (const float*)(ws + WS_SS), 8}; pg8::gemm_phase<EpiPlain, pg8::StaticOrder, true, true>(lds, g, S, E); }
            SEAM_X();
            if (PH_ON(2) && IN(ph)) { PHASE_BEGIN();
                for (int u = vcu; u < TT / 64; u += G)
                    token_prep_unit(lds, u, (const bf16_t*)(ws + WS_PROJ), p.in[6] + li * 384, p.in[8] + li * 256, (const float*)(ws + WS_COSR), (const float*)(ws + WS_SINR), (const float*)(ws + WS_COSM), (const float*)(ws + WS_SINM),
                                    (bf16_t*)(ws + WS_CQN), (bf16_t*)(ws + WS_CKVN), (bf16_t*)(ws + WS_KM), (bf16_t*)(ws + WS_MQ), (bf16_t*)(ws + WS_MK), (float*)(ws + WS_KPART), wave, lane); }
            SEAM();
            if (PH_ON(3) && IN(ph)) { PHASE_BEGIN();
#if MOBA_GATHER
                for (int u0 = 8 * vcu; u0 < 2048; u0 += 8 * G)
                    moba_select_wg(lds, u0, (const bf16_t*)(ws + WS_MQ), (const float*)(ws + WS_KPART), (unsigned*)(ws + WS_MSEL), (unsigned*)(ws + WS_MENT), (unsigned*)(ws + WS_CTL) + CW_MCNT + li * 512, tid, wave, lane);
#endif
#if !defined(E3_SKIP_A)
                { pg8::Gemm g{(const bf16_t*)(ws + WS_CQN), (const bf16_t*)(ws + WS_WUQ) + (size_t)li * 768 * 384, TT, 768, 384}; pg8::StaticOrder S; S.init(TT, 768, G, bx);
                  EpiQup E{(bf16_t*)(ws + WS_QM), (const float*)(ws + WS_COSR), (const float*)(ws + WS_SINR), 0.10206207261596577f * LOG2E}; pg8::gemm_phase<EpiQup, pg8::StaticOrder, true, true>(lds, g, S, E); }
#endif
#if !defined(E3_SKIP_B)
                { pg8::Gemm g{(const bf16_t*)(ws + WS_CKVN), (const bf16_t*)(ws + WS_WUKV) + (size_t)li * 1024 * 256, TT, 1024, 256}; pg8::StaticOrder S; S.init(TT, 1024, G, bx);
                  EpiKVup E{(bf16_t*)(ws + WS_KM), (bf16_t*)(ws + WS_VM)}; pg8::gemm_phase<EpiKVup, pg8::StaticOrder, true, true>(lds, g, S, E); }
#endif
            }
            SEAM();
            if (PH_ON(4) && IN(ph)) { PHASE_BEGIN();
                bf16_t* QM = (bf16_t*)(ws + WS_QM); bf16_t* KM = (bf16_t*)(ws + WS_KM); bf16_t* VM = (bf16_t*)(ws + WS_VM); bf16_t* MQ = (bf16_t*)(ws + WS_MQ); bf16_t* MK = (bf16_t*)(ws + WS_MK);
                bf16_t* OB = (bf16_t*)(ws + WS_OB); const bf16_t* PROJ = (const bf16_t*)(ws + WS_PROJ); const float* kpart = (const float*)(ws + WS_KPART);
                for (int v = vcu; v < 256; v += G) { const int bh = v >> 4, s = v & 15, b = bh >> 3, h = bh & 7; const size_t rb = (size_t)b * SEQ;
                    for (int k = 0; k < 2; ++k) { const int qb = k ? 31 - s : s;
#if ATTN_SP
                        attn_unit_sp<96>(lds, QM + rb * 768 + h * 96, 768, KM + rb * 768 + h * 96, 768, VM + rb * 512 + h * 64, 512, OB + rb * 1024 + h * 64, 1024, qb);
#else
                        attn_unit<96, false>(lds, QM + rb * 768 + h * 96, 768, KM + rb * 768 + h * 96, 768, VM + rb * 512 + h * 64, 512, OB + rb * 1024 + h * 64, 1024, qb, nullptr);
#endif
#if MOBA_GATHER
                        { unsigned ew_d = 0u; bf16x8 qf_d[4] = {bf16x8{}, bf16x8{}, bf16x8{}, bf16x8{}}; moba_part_unit<false>(lds, bh, qb, nullptr, 0, 0, MQ, MK, PROJ, (f32x2*)(ws + WS_PM), (bf16_t*)(ws + WS_PO), false, ew_d, qf_d, nullptr, 0, 0, 0); }
#if DBG_MOBA_CHECK
                        attn_unit<64, true>(lds, MQ + rb * 512 + h * 64, 512, MK + rb * 512 + h * 64, 512, PROJ + rb * NPROJP + 1696 + h * 64, NPROJP, (bf16_t*)(ws + WS_ENT) + rb * 1024 + 512 + h * 64, 1024, qb,
                                            kpart + (size_t)b * 32 * 4 * 512 + h * 64);
#endif
#else
                        attn_unit<64, true>(lds, MQ + rb * 512 + h * 64, 512, MK + rb * 512 + h * 64, 512, PROJ + rb * NPROJP + 1696 + h * 64, NPROJP, OB + rb * 1024 + 512 + h * 64, 1024, qb,
                                            kpart + (size_t)b * 32 * 4 * 512 + h * 64);
#endif
                    } }
#if MOBA_GATHER
                { LAS unsigned* pre = (LAS unsigned*)(lds + 65536);
                  const unsigned* mc = (const unsigned*)(ws + WS_CTL) + CW_MCNT + li * 512;
                  __syncthreads();
                  LAS unsigned* cn = pre + 520;
                  if (tid < 512) { const unsigned c_ = __hip_atomic_load(mc + tid, __ATOMIC_RELAXED, __HIP_MEMORY_SCOPE_AGENT); cn[tid] = c_; pre[tid + 1] = (c_ + 255u) >> 8; }
                  if (tid == 0) pre[0] = 0u;
                  __syncthreads();
                  if (tid == 0) { unsigned acc = 0u; for (int i = 1; i <= 512; ++i) { acc += pre[i]; pre[i] = acc; } }
                  __syncthreads();
                  const int nunits = (int)pre[512];
#define MU_FIND(u_, L_, ch_) do { int lo_ = 0, hi_ = 512; while (hi_ - lo_ > 1) { const int mid = (lo_ + hi_) >> 1; if ((int)pre[mid] <= (u_)) lo_ = mid; else hi_ = mid; } L_ = lo_; ch_ = (u_) - (int)pre[lo_]; } while (0)
                  unsigned ew_c = 0u; bf16x8 qf_c[4] = {bf16x8{}, bf16x8{}, bf16x8{}, bf16x8{}}; bool have = false;
                  for (int u = vcu; u < nunits; u += G) { int L, chunk, L2, chunk2; MU_FIND(u, L, chunk);
                      const bool has_nx = u + G < nunits; const int u2 = has_nx ? u + G : u; MU_FIND(u2, L2, chunk2);
                      const int cnt = (int)cn[L], cnt2 = (int)cn[L2];
                      moba_part_unit<true>(lds, L >> 5, L & 31, (const unsigned*)(ws + WS_MENT) + (size_t)L * 8192, chunk * 256, cnt, MQ, MK, PROJ, (f32x2*)(ws + WS_PM), (bf16_t*)(ws + WS_PO),
                                           have, ew_c, qf_c, (const unsigned*)(ws + WS_MENT) + (size_t)L2 * 8192, chunk2 * 256, cnt2, L2 >> 5);
                      have = has_nx; } }
#undef MU_FIND
#endif
            }
            SEAM();
#if MOBA_GATHER
            if (PH_ON(4) && IN(ph)) { PHASE_BEGIN();
                for (int gi = vcu * NTHR + tid; gi < 16 * SEQ * 8; gi += G * NTHR) moba_merge(gi, (const unsigned*)(ws + WS_MSEL), (const f32x2*)(ws + WS_PM), (const bf16_t*)(ws + WS_PO), (bf16_t*)(ws + WS_OB));
            }
            SEAM();
#endif
            if (PH_ON(5) && IN(ph)) { PHASE_BEGIN();
#if DBG_NAIVE_CHECK
                for (int smp = gw; smp < 2048; smp += NGW) { const float dm = naive_attn_sample(smp, DBG_NAIVE_CHECK, (const bf16_t*)(ws + WS_QM), (const bf16_t*)(ws + WS_KM), (const bf16_t*)(ws + WS_VM), (const bf16_t*)(ws + WS_MQ),
                        (const bf16_t*)(ws + WS_MK), (const bf16_t*)(ws + WS_PROJ), (const float*)(ws + WS_KPART), (const bf16_t*)(ws + WS_OB), lane);
                    if (lane == 0) atomicMax((unsigned*)(ws + WS_CTL) + CW_DIFF, __float_as_uint(dm)); }
#endif
#if DBG_MOBA_CHECK
                { float dmax = 0.f; const bf16_t* OBc = (const bf16_t*)(ws + WS_OB); const bf16_t* OB2 = (const bf16_t*)(ws + WS_ENT);
                  for (size_t e = (size_t)vcu * NTHR + tid; e < (size_t)TT * 512; e += (size_t)G * NTHR) { const size_t off = (e >> 9) * 1024 + 512 + (e & 511);
                      const float df = fabsf(bf1(OBc[off]) - bf1(OB2[off]) * DBG_CTRL_SCALE); dmax = (df == df) ? fmaxf(dmax, df) : 1e30f; }
                  dmax = wave_max_all(dmax); if (lane == 0) atomicMax((unsigned*)(ws + WS_CTL) + CW_DIFF, __float_as_uint(dmax)); }
#endif
                pg8::Gemm g{(const bf16_t*)(ws + WS_OB), (const bf16_t*)(ws + WS_WOUT) + (size_t)li * 1024 * 1024, TT, 1024, 1024}; pg8::StaticOrder S; S.init(TT, 1024, G, bx);
                EpiResid E{layer == 0 ? p.in[0] : (const float*)(ws + WS_H1), (float*)(ws + WS_H0), nullptr, DBG_SKIP_ATTN, (bf16_t*)(ws + WS_HN), (float*)(ws + WS_SS16)}; pg8::gemm_phase<EpiResid, pg8::StaticOrder, true, true>(lds, g, S, E); }
            SEAM_X();
        } else {
            if (PH_ON(6) && IN(ph)) { PHASE_BEGIN();
                pg8::Gemm g{(const bf16_t*)(ws + WS_HB), (const bf16_t*)(ws + WS_WCIN) + (size_t)li * 2048 * 1024, TT, 2048, 1024}; pg8::StaticOrder S; S.init(TT, 2048, G, bx);
                EpiGlu E{(bf16_t*)(ws + WS_UG), p.in[12] + li * 2048, (const float*)(ws + WS_SS)}; pg8::gemm_phase<EpiGlu, pg8::StaticOrder, true, true>(lds, g, S, E); }
            SEAM();
            if (PH_ON(7) && IN(ph)) { PHASE_BEGIN();
                float w[31][2];
                const float* wd = p.in[13] + (size_t)li * 31 * 1024;
#pragma unroll
                for (int j = 0; j < 31; ++j) { const f32x2 t2 = *(const f32x2*)(wd + j * 1024 + 2 * tid); w[j][0] = t2.x; w[j][1] = t2.y; }
                const f32x2 bb = *(const f32x2*)(p.in[14] + li * 1024 + 2 * tid), gg = *(const f32x2*)(p.in[15] + li * 1024 + 2 * tid), be = *(const f32x2*)(p.in[16] + li * 1024 + 2 * tid);
                { const int nu = (TT / 16 + G - 1) / G;
                  for (int u = vcu * nu; u < (vcu + 1) * nu && u < TT / 16; ++u) dwconv_unit(lds, u, (const bf16_t*)(ws + WS_UG), w, bb.x, bb.y, gg.x, gg.y, be.x, be.y, (bf16_t*)(ws + WS_YB), tid); }
            }
            SEAM_X();
            if (PH_ON(8) && IN(ph)) { PHASE_BEGIN();
                pg8::Gemm g{(const bf16_t*)(ws + WS_YB), (const bf16_t*)(ws + WS_WCOUT) + (size_t)li * 1024 * 1024, TT, 1024, 1024}; pg8::StaticOrder S; S.init(TT, 1024, G, bx);
                EpiResid E{(const float*)(ws + WS_H1), (float*)(ws + WS_H0), p.in[18] + li * 1024, DBG_SKIP_CONV, (bf16_t*)(ws + WS_HN), (float*)(ws + WS_SS16)}; pg8::gemm_phase<EpiResid, pg8::StaticOrder, true, true>(lds, g, S, E); }
            SEAM_X();
        }
        if (PH_ON(10) && IN(ph)) { PHASE_BEGIN();
            pg8::Gemm g{(const bf16_t*)(ws + WS_HN), (const bf16_t*)(ws + WS_WPQ) + (size_t)layer * 2048 * 1024, TT, 2048, 1024}; pg8::StaticOrder S; S.init(TT, 2048, G, bx);
            EpiPlain E{(bf16_t*)(ws + WS_Q2), 2048, (const float*)(ws + WS_SS16), 16}; pg8::gemm_phase<EpiPlain, pg8::StaticOrder, true, true>(lds, g, S, E); }
        SEAM_X();
        if (PH_ON(11) && IN(ph)) { PHASE_BEGIN();
            const bf16_t* subk = (const bf16_t*)(ws + WS_SUBK) + (size_t)layer * 8 * 2 * 128 * 128;
            LAS unsigned* dec = (LAS unsigned*)(lds + 65536 + wave * 2048);
            for (int v = vcu; v < 256; v += G) { const int h = v & 7, tg = v >> 3;
                for (int e = tid; e < 2 * 128 * 16; e += NTHR) { const int c = e >> 11, key = (e >> 4) & 127, ch = e & 15;
                    *(LAS u32x4*)(lds + c * 32768 + ch * 2048 + key * 16) = *(const u32x4*)(subk + ((size_t)(h * 2 + c) * 128 + key) * 128 + ch * 8); }
                __syncthreads();
                for (int i = 0; i < 2; ++i) peer_topk_unit(lds, dec, (const bf16_t*)(ws + WS_Q2), tg * 16 + wave * 2 + i, h, (int*)(ws + WS_IDX), (float*)(ws + WS_GATE), lane);
                __syncthreads();
            }
        }
        SEAM_X();
        if (PH_ON(13) && IN(ph)) { PHASE_BEGIN();
            for (int tok = 8 * gw; tok < TT; tok += 8 * NGW) peer_build_lists(tok, (const int*)(ws + WS_IDX), (unsigned*)(ws + WS_ENT), (unsigned*)(ws + WS_CTL) + CW_CNT + layer * 8 * 64, (volatile LAS unsigned*)lds, wave, lane, (const float*)(ws + WS_H0), p.in[3] + layer * DM, ws + WS_XQ, (float*)(ws + WS_SX)); }
        SEAM();
        if (PH_ON(14) && IN(ph)) { PHASE_BEGIN();
            const int x = bx & 7, rank = bx >> 3, nrank = (G - x + 7) >> 3;
            const int n = (int)__hip_atomic_load((unsigned*)(ws + WS_CTL) + CW_CNT + (layer * 8 + x) * 64, __ATOMIC_RELAXED, __HIP_MEMORY_SCOPE_AGENT);
            const int nws = nrank * NWAVES, wsl = rank * NWAVES + wave;
            const int per = (((n + nws - 1) / nws) + 63) & ~63;
            const int e_lo = wsl * per, e_hi = (e_lo + per < n) ? e_lo + per : n;
            for (int rep = 0; rep < REP_U; ++rep) if (e_lo < n) peer_u_slice((const unsigned*)(ws + WS_ENT) + (size_t)x * ENT_CAP, e_lo, e_hi, ws + WS_U8 + ((size_t)layer * 16384 + (size_t)x * 2048) * 1024,
                                       (const float*)(ws + WS_SU) + layer * 16384 + x * 2048, (const float*)(ws + WS_SV) + layer * 16384 + x * 2048, (const float*)(ws + WS_GATE), ws + WS_XQ, (const float*)(ws + WS_SX), (float*)(ws + WS_ACT), lane);
        }
        SEAM();
        if (PH_ON(12) && IN(ph)) { PHASE_BEGIN();
            const int x = bx & 7, rank = bx >> 3, nrank = (G - x + 7) >> 3;
            for (int rep = 0; rep < REP_V; ++rep) peer_v_cols(x, rank * NWAVES + wave, nrank * NWAVES, (const int*)(ws + WS_IDX), (const float*)(ws + WS_ACT), ws + WS_V8 + ((size_t)layer * 8 + x) * 16384 * 128,
                        (const float*)(ws + WS_H0), (float*)(ws + WS_H1), (bf16_t*)(ws + WS_HB), (float*)(ws + WS_SS), lane);
        }
        SEAM();
    }
    if (PH_ON(15) && IN(ph)) { PHASE_BEGIN();
        float pscale = 1.f, poff = 0.f;
        if (PROBE_ON) { const unsigned long long* ts = (const unsigned long long*)((const unsigned*)(ws + WS_CTL) + CW_TS); unsigned long long ta = 0ull, tb = 0ull;
            for (int k = 0; k < 38; ++k) { const unsigned long long d = ts[k + 1] - ts[k]; if ((PROBE_SELA >> k) & 1ull) ta += d; if ((PROBE_SELB >> k) & 1ull) tb += d; }
            pscale = 1.f + sqrtf((float)ta * 1e-8f);
            poff = (float)tb * 1e-4f; }
        if (DBG_MOBA_CHECK || DBG_NAIVE_CHECK) poff = 1000.f * __uint_as_float(__hip_atomic_load((unsigned*)(ws + WS_CTL) + CW_DIFF, __ATOMIC_RELAXED, __HIP_MEMORY_SCOPE_AGENT));
        for (int m = gw; m < TT; m += NGW) final_norm_row(m, (const float*)(ws + WS_H1), (const float*)(ws + WS_SS), p.in[4], p.out, lane, pscale, poff);
    }
    SEAM();
#undef IN
#undef SEAM
}

extern "C" void kernel_launch(void* const* d_in, const int* in_sizes, int n_in, void* d_out, int out_size, void* d_ws, size_t ws_size, hipStream_t stream) {
    static int grid = 0;
    if (grid == 0) {
        if (n_in != 23 || out_size != TT * DM || ws_size < WS_END) { fprintf(stderr, "kernel_launch: unexpected shapes (n_in %d out %d ws %zu)\n", n_in, out_size, ws_size); grid = -1; return; }
        int dev = 0, cus = 0, per_cu = 0;
        if (hipGetDevice(&dev) != hipSuccess || hipDeviceGetAttribute(&cus, hipDeviceAttributeMultiprocessorCount, dev) != hipSuccess) { grid = -1; return; }
        if (hipFuncSetAttribute((const void*)fwd_kernel, hipFuncAttributeMaxDynamicSharedMemorySize, LDS_BYTES) != hipSuccess) { fprintf(stderr, "kernel_launch: hipFuncSetAttribute failed\n"); grid = -1; return; }
        if (hipOccupancyMaxActiveBlocksPerMultiprocessor(&per_cu, (const void*)fwd_kernel, NTHR, LDS_BYTES) != hipSuccess || per_cu < 1) fprintf(stderr, "kernel_launch: occupancy query says %d\n", per_cu);
        (void)hipGetLastError();
        grid = cus;
    }
    if (grid < 0) return;
    (void)hipMemsetAsync((char*)d_ws + WS_CTL, 0, CTL_ZERO_BYTES, stream);
    Params p;
    memset(&p, 0, sizeof(p));
    for (int i = 0; i < 23; ++i) p.in[i] = (const float*)d_in[i];
    p.out = (float*)d_out; p.ws = (unsigned char*)d_ws;
    for (int k = 0; k < 16; ++k) p.inv_r[k] = pow(10000.0, -(double)(2 * k) / 32.0);
    for (int k = 0; k < 32; ++k) p.inv_m[k] = pow(10000.0, -(double)(2 * k) / 64.0);
#if MK_ONE_LAUNCH
    p.ph_lo = 0; p.ph_hi = 1000;
    hipLaunchKernelGGL(fwd_kernel, dim3(grid), dim3(NTHR), LDS_BYTES, stream, p);
#else
    for (int k = 0; k < 40; ++k) { p.ph_lo = k; p.ph_hi = k + 1; hipLaunchKernelGGL(fwd_kernel, dim3(grid), dim3(NTHR), LDS_BYTES, stream, p); }
#endif
}
```
